# Optimizing an MI355X kernel written in HIP

```python
import jax, jax.numpy as jnp
from jax import lax
import numpy as np

D_MODEL = 2048
BATCH = 16
SEQ = 256
DEPTH = 4
DEC_BATCH = 8
DEC_SEQ = 4096
PAST_LEN = 512

GRID_W = 64
D_MIX = D_MODEL
D_CONV = D_MIX // 2
D_RNN = D_MIX - D_CONV
N_RNN_HEADS = 16
RNN_HEAD_DIM = D_RNN // N_RNN_HEADS
CONV_A_W = 3
RNN_CONV_W = 4
FFN_CONV_W = 3
D_FF = 3 * D_MODEL
RGLRU_C = 8.0
D_IN = 3 * D_CONV + 2 * D_RNN
N_MOD = 6
EPS = 1e-6

kernel_name = "hybrid_shortconv_rglru_diffusion_step"


def rmsnorm(x, g):
    xf = x.astype(jnp.float32)
    var = jnp.mean(xf * xf, axis=-1, keepdims=True)
    return (xf * lax.rsqrt(var + EPS) * g.astype(jnp.float32)).astype(x.dtype)


def centred_dwconv(x, w):
    k = w.shape[0]
    p = k // 2
    length = x.shape[1]
    xp = jnp.pad(x, ((0, 0), (p, p), (0, 0)))
    return sum(xp[:, i:i + length] * w[i] for i in range(k))


def directional_dwconv(x, w, b):
    k = w.shape[0]
    length = x.shape[1]
    xp = jnp.pad(x, ((0, 0), (k - 1, 0), (0, 0)))
    return sum(xp[:, i:i + length] * w[i] for i in range(k)) + b


def _linear_combine(left, right):
    a1, b1 = left
    a2, b2 = right
    return a1 * a2, a2 * b1 + b2


def rglru_direction(x, conv_w, conv_b, w_a, b_a, w_x, b_x, lam, h0):
    bsz, length, _ = x.shape
    xc = directional_dwconv(x, conv_w, conv_b)
    xh = xc.reshape(bsz, length, N_RNN_HEADS, RNN_HEAD_DIM)
    r = jax.nn.sigmoid(jnp.einsum("blhi,hij->blhj", xh, w_a).reshape(bsz, length, D_RNN) + b_a)
    i = jax.nn.sigmoid(jnp.einsum("blhi,hij->blhj", xh, w_x).reshape(bsz, length, D_RNN) + b_x)
    log_a = -RGLRU_C * r.astype(jnp.float32) * jax.nn.softplus(-lam.astype(jnp.float32))
    a = jnp.exp(log_a)
    v = jnp.sqrt(-jnp.expm1(2.0 * log_a)) * (i * xc).astype(jnp.float32)
    a_cum, h_from_zero = lax.associative_scan(_linear_combine, (a, v), axis=1)
    h = h_from_zero + a_cum * h0.astype(jnp.float32)[:, None, :]
    return h.astype(x.dtype), h[:, -1].astype(x.dtype)


def token_mixers(u, h0, w_in, conv_a_w, rnn_conv_w, rnn_conv_b, rnn_w_a, rnn_b_a,
                 rnn_w_x, rnn_b_x, rnn_lam, w_out):
    proj = u @ w_in
    bg, cg, xa, xr, gr = jnp.split(
        proj, [D_CONV, 2 * D_CONV, 3 * D_CONV, 3 * D_CONV + D_RNN], axis=-1)
    y_a = bg * centred_dwconv(cg * xa, conv_a_w)
    h_f, last_f = rglru_direction(xr, rnn_conv_w[0], rnn_conv_b[0], rnn_w_a[0], rnn_b_a[0],
                                  rnn_w_x[0], rnn_b_x[0], rnn_lam[0], h0[:, 0])
    h_b, last_b = rglru_direction(xr[:, ::-1], rnn_conv_w[1], rnn_conv_b[1], rnn_w_a[1], rnn_b_a[1],
                                  rnn_w_x[1], rnn_b_x[1], rnn_lam[1], h0[:, 1])
    y_b = (h_f + h_b[:, ::-1]) * jax.nn.gelu(gr)
    y = jnp.concatenate([y_a, y_b], axis=-1) @ w_out
    return y, jnp.stack([last_f, last_b], axis=1)


def conv_ffn(u, w_up, conv_w, w_down):
    h = centred_dwconv(u @ w_up, conv_w)
    g, v = jnp.split(h, 2, axis=-1)
    return (jax.nn.gelu(g) * v) @ w_down


def to_col_major(x, rows):
    b, length, d = x.shape
    return x.reshape(b, rows, GRID_W, d).transpose(0, 2, 1, 3).reshape(b, length, d)


def to_row_major(x, rows):
    b, length, d = x.shape
    return x.reshape(b, GRID_W, rows, d).transpose(0, 2, 1, 3).reshape(b, length, d)


def trunk_layer(x, mod, h0, col_rows, norm_g, w_in, conv_a_w, rnn_conv_w, rnn_conv_b,
                rnn_w_a, rnn_b_a, rnn_w_x, rnn_b_x, rnn_lam, w_out, ffn_up, ffn_conv_w, ffn_down):
    sh1, sc1, g1, sh2, sc2, g2 = jnp.split(mod, N_MOD, axis=-1)
    u = rmsnorm(x, norm_g[0]) * (1.0 + sc1) + sh1
    if col_rows is not None:
        u = to_col_major(u, col_rows)
    y, h_last = token_mixers(u, h0, w_in, conv_a_w, rnn_conv_w, rnn_conv_b, rnn_w_a, rnn_b_a,
                             rnn_w_x, rnn_b_x, rnn_lam, w_out)
    if col_rows is not None:
        y = to_row_major(y, col_rows)
    x = x + g1 * rmsnorm(y, norm_g[1])
    u = rmsnorm(x, norm_g[2]) * (1.0 + sc2) + sh2
    x = x + g2 * rmsnorm(conv_ffn(u, ffn_up, ffn_conv_w, ffn_down), norm_g[3])
    return x, h_last


def setup_inputs(seed: int = 0) -> dict:
    key = jax.random.key(seed)
    ks = jax.random.split(key, 24)
    f32 = jnp.float32
    nrm = lambda k, shape, s: jax.random.normal(k, shape, f32) * s
    a0 = jax.random.uniform(ks[16], (DEPTH, 2, D_RNN), f32, 0.9, 0.999)
    return {
        "x_prompt": nrm(ks[0], (BATCH, SEQ, D_MODEL), 1.0),
        "x_sample": nrm(ks[1], (DEC_BATCH, DEC_SEQ, D_MODEL), 1.0),
        "state_h": nrm(ks[2], (DEC_BATCH, DEPTH, 2, D_RNN), 0.5),
        "c": nrm(ks[3], (DEC_BATCH, D_MODEL), 1.0),
        "c_ctx": nrm(ks[4], (D_MODEL,), 1.0),
        "w_ada": nrm(ks[5], (DEPTH, D_MODEL, N_MOD * D_MODEL), 0.5 * D_MODEL ** -0.5),
        "b_ada": nrm(ks[6], (DEPTH, N_MOD * D_MODEL), 0.01),
        "norm_g": 1.0 + nrm(ks[7], (DEPTH, 4, D_MODEL), 0.05),
        "w_in": nrm(ks[8], (DEPTH, D_MODEL, D_IN), D_MODEL ** -0.5),
        "conv_a_w": nrm(ks[9], (DEPTH, CONV_A_W, D_CONV), CONV_A_W ** -0.5),
        "rnn_conv_w": nrm(ks[10], (DEPTH, 2, RNN_CONV_W, D_RNN), RNN_CONV_W ** -0.5),
        "rnn_conv_b": nrm(ks[11], (DEPTH, 2, D_RNN), 0.01),
        "rnn_w_a": nrm(ks[12], (DEPTH, 2, N_RNN_HEADS, RNN_HEAD_DIM, RNN_HEAD_DIM), RNN_HEAD_DIM ** -0.5),
        "rnn_b_a": nrm(ks[13], (DEPTH, 2, D_RNN), 0.01),
        "rnn_w_x": nrm(ks[14], (DEPTH, 2, N_RNN_HEADS, RNN_HEAD_DIM, RNN_HEAD_DIM), RNN_HEAD_DIM ** -0.5),
        "rnn_b_x": nrm(ks[15], (DEPTH, 2, D_RNN), 0.01),
        "rnn_lam": jnp.log(a0) - jnp.log1p(-a0),
        "w_out": nrm(ks[17], (DEPTH, D_MIX, D_MODEL), D_MIX ** -0.5),
        "ffn_up": nrm(ks[18], (DEPTH, D_MODEL, 2 * D_FF), D_MODEL ** -0.5),
        "ffn_conv_w": nrm(ks[19], (DEPTH, FFN_CONV_W, 2 * D_FF), FFN_CONV_W ** -0.5),
        "ffn_down": nrm(ks[20], (DEPTH, D_FF, D_MODEL), D_FF ** -0.5),
    }


def reference(x_prompt, x_sample, state_h, c, c_ctx, w_ada, b_ada, norm_g, w_in, conv_a_w,
              rnn_conv_w, rnn_conv_b, rnn_w_a, rnn_b_a, rnn_w_x, rnn_b_x, rnn_lam, w_out,
              ffn_up, ffn_conv_w, ffn_down):
    rows = x_sample.shape[1] // GRID_W
    h_zero = jnp.zeros((x_prompt.shape[0], 2, D_RNN), x_prompt.dtype)
    xp, xs = x_prompt, x_sample
    ctx_states = []
    for l in range(DEPTH):
        lw = (norm_g[l], w_in[l], conv_a_w[l], rnn_conv_w[l], rnn_conv_b[l], rnn_w_a[l], rnn_b_a[l],
              rnn_w_x[l], rnn_b_x[l], rnn_lam[l], w_out[l], ffn_up[l], ffn_conv_w[l], ffn_down[l])
        mod_ctx = (jax.nn.silu(c_ctx) @ w_ada[l] + b_ada[l])[None, None, :]
        mod_lat = (jax.nn.silu(c) @ w_ada[l] + b_ada[l])[:, None, :]
        xp, h_ctx = trunk_layer(xp, mod_ctx, h_zero, None, *lw)
        ctx_states.append(h_ctx)
        xs, _ = trunk_layer(xs, mod_lat, state_h[:, l], rows if l % 2 == 1 else None, *lw)
    new_state_h = jnp.stack(ctx_states, axis=1)
    return (xp, xs, new_state_h)
```

```cpp
#include <hip/hip_runtime.h>
#include <cstdio>
#include <cstdint>

#ifndef MK_SINGLE
#define MK_SINGLE 0
#endif

namespace pg8 {
#define PG8_LAS __attribute__((address_space(3)))
typedef unsigned short bf16_t;
typedef short bf16x8 __attribute__((ext_vector_type(8)));
typedef float f32x4 __attribute__((ext_vector_type(4)));
typedef unsigned u32x4 __attribute__((ext_vector_type(4)));
constexpr int BM = 256, BK = 64, HALF = 128, HTB = HALF * BK * 2, STAGE_BYTES = 8 * HTB, NXCD = 8, WGM = 8;

__host__ __device__ __forceinline__ int lds_byte(int r, int c) { const int st = (r >> 4) * 2 + (c >> 5), rr = r & 15, cc = c & 31, ob = rr * 64 + cc * 2; return st * 1024 + (ob ^ (((ob >> 9) & 1) << 5)); }
__host__ __device__ __forceinline__ void stage_rc(int b, int& R, int& C) { const int st = b / 1024, sb = b % 1024, swz = sb ^ (((sb >> 9) & 1) << 5); R = (st >> 1) * 16 + swz / 64; C = (st & 1) * 32 + (swz % 64) / 2; }
__host__ __device__ __forceinline__ int perm32(int rho) { const int n = rho >> 4, i = rho & 15; return 8 * (i >> 2) + 4 * n + (i & 3); }

struct Unit { int pm, pn; };
struct Gemm { const bf16_t* A; const bf16_t* Bt; int M, N, K; };

struct StaticOrder {
    int nM, nN, nwg, G, c;
    __host__ __device__ void init(int M, int N, int G_, int c_) { nM = M / BM; nN = N / BM; nwg = nM * nN; G = G_; c = c_; }
    __host__ __device__ bool next(int i, Unit& u) const {
        const long L = (long)i * G + c; if (L >= nwg) return false;
        int wgid = (int)L; { const int q = nwg / NXCD, r = nwg % NXCD, xcd = wgid % NXCD, off = wgid / NXCD; wgid = (xcd < r ? xcd * (q + 1) : r * (q + 1) + (xcd - r) * q) + off; }
        const int nig = WGM * nN, gid = wgid / nig, fm = gid * WGM, gsz = (nM - fm) < WGM ? (nM - fm) : WGM;
        u.pm = fm + ((wgid % nig) % gsz); u.pn = (wgid % nig) / gsz; return true;
    }
    __device__ __forceinline__ void a_ready(const Unit&) const {}
    __device__ __forceinline__ void done(const Unit&) const {}
};

__device__ __forceinline__ unsigned cvt_pk_bf16(float lo, float hi) { unsigned r; asm volatile("v_cvt_pk_bf16_f32 %0, %1, %2" : "=v"(r) : "v"(lo), "v"(hi)); return r; }

struct EpiBf16Store {
    static constexpr bool PERM = true, AFTER_DRAIN = false;
    bf16_t* O; int ldc;
    __device__ __forceinline__ void operator()(const f32x4 (&acc)[2][2][4][2], const Unit& u, int wr, int wc, int fr, int fq, PG8_LAS unsigned char*) const {
        const int row0 = u.pm * BM + wr * 64 + fr, col0 = u.pn * BM + wc * 32 + 8 * fq;
#pragma unroll
        for (int ai = 0; ai < 2; ++ai)
#pragma unroll
            for (int m = 0; m < 4; ++m) { bf16_t* rowp = O + (size_t)(row0 + ai * HALF + m * 16) * ldc + col0;
#pragma unroll
                for (int bj = 0; bj < 2; ++bj) { const f32x4 v0 = acc[ai][bj][m][0], v1 = acc[ai][bj][m][1];
                    u32x4 w; w.x = cvt_pk_bf16(v0[0], v0[1]); w.y = cvt_pk_bf16(v0[2], v0[3]); w.z = cvt_pk_bf16(v1[0], v1[1]); w.w = cvt_pk_bf16(v1[2], v1[3]);
                    *(u32x4*)(rowp + bj * HALF) = w; } }
    }
};
struct EpiF32Store {
    static constexpr bool PERM = false, AFTER_DRAIN = false;
    float* C; int ldc;
    __device__ __forceinline__ void operator()(const f32x4 (&acc)[2][2][4][2], const Unit& u, int wr, int wc, int fr, int fq, PG8_LAS unsigned char*) const {
        const int row0 = u.pm * BM + wr * 64 + fr, col0 = u.pn * BM + wc * 32 + 4 * fq;
#pragma unroll
        for (int ai = 0; ai < 2; ++ai)
#pragma unroll
            for (int m = 0; m < 4; ++m) { float* rowp = C + (size_t)(row0 + ai * HALF + m * 16) * ldc + col0;
#pragma unroll
                for (int bj = 0; bj < 2; ++bj)
#pragma unroll
                    for (int n = 0; n < 2; ++n) *(f32x4*)(rowp + bj * HALF + n * 16) = acc[ai][bj][m][n]; }
    }
};

template <class Epi, class Sched, bool ALIGN_EPI = false, bool SP2 = false>
__device__ __forceinline__ void gemm_phase(PG8_LAS unsigned char* lds, PG8_LAS unsigned char* xlds, const Gemm g, const Sched& S, const Epi& E) {
    int tid = threadIdx.x; asm volatile("" : "+v"(tid));
    const int wid = __builtin_amdgcn_readfirstlane(tid >> 6), lane = tid & 63, wr = wid >> 2, wc = wid & 3, fr = lane & 15, fq = lane >> 4;
    const int K = g.K, nt = K / BK;
    unsigned voffA[2], voffB[2];
#pragma unroll
    for (int i = 0; i < 2; ++i) { int R, C; stage_rc(tid * 16 + i * 8192, R, C); const int Rb = Epi::PERM ? ((R & ~31) + perm32(R & 31)) : R;
        voffA[i] = (unsigned)(R * K + C) * 2u; voffB[i] = (unsigned)(Rb * K + C) * 2u; }
    const size_t kstep = (size_t)(BK * 2);
    const size_t hstep = (size_t)HALF * K * 2;
    const size_t tstep = 2 * hstep;
    const unsigned ldsw = (unsigned)wid * 1024u;
    const int aoff = lds_byte(wr * 64 + fr, fq * 8), boff = lds_byte(wc * 32 + fr, fq * 8);
#define PG8_SA(b, h) (((b) * 2 + (h)) * HTB)
#define PG8_SB(b, h) ((4 + (b) * 2 + (h)) * HTB)
#define PG8_STAGE(bufoff, gbase, voff) do { _Pragma("unroll") for (int _i = 0; _i < 2; ++_i) \
        __builtin_amdgcn_global_load_lds((const unsigned*)((const char*)(gbase) + (voff)[_i]), (PG8_LAS unsigned*)(lds + (bufoff) + ldsw + _i * 8192), 16, 0, 0); } while (0)
#define PG8_LDA(dst, b, h) do { _Pragma("unroll") for (int m = 0; m < 4; ++m) _Pragma("unroll") for (int k = 0; k < 2; ++k) dst[m][k] = *(const PG8_LAS bf16x8*)(lds + PG8_SA(b, h) + aoff + m * 2048 + k * 1024); } while (0)
#define PG8_LDB(dst, b, h) do { _Pragma("unroll") for (int n = 0; n < 2; ++n) _Pragma("unroll") for (int k = 0; k < 2; ++k) dst[n][k] = *(const PG8_LAS bf16x8*)(lds + PG8_SB(b, h) + boff + n * 2048 + k * 1024); } while (0)
#define PG8_MMA(ai, bj, At, Bt) do { __builtin_amdgcn_s_setprio(1); _Pragma("unroll") for (int m = 0; m < 4; ++m) _Pragma("unroll") for (int n = 0; n < 2; ++n) _Pragma("unroll") for (int k = 0; k < 2; ++k) \
        acc[ai][bj][m][n] = __builtin_amdgcn_mfma_f32_16x16x32_bf16(Bt[n][k], At[m][k], acc[ai][bj][m][n], 0, 0, 0); __builtin_amdgcn_s_setprio(0); } while (0)
#define PG8_WAIT_V(n) asm volatile("s_waitcnt vmcnt(" #n ")" ::: "memory")
#define PG8_WAIT_L(n) asm volatile("s_waitcnt lgkmcnt(" #n ")" ::: "memory")
#define PG8_BAR __builtin_amdgcn_s_barrier()
#define PG8_SCHED __builtin_amdgcn_sched_barrier(0)
    Unit cur, nxt; int ui = 0;
    if (!S.next(0, cur)) return;
    f32x4 acc[2][2][4][2];
#pragma unroll
    for (int a = 0; a < 2; ++a)
#pragma unroll
        for (int b = 0; b < 2; ++b)
#pragma unroll
            for (int m = 0; m < 4; ++m)
#pragma unroll
                for (int n = 0; n < 2; ++n) acc[a][b][m][n] = (f32x4){0.f, 0.f, 0.f, 0.f};
    bf16x8 At[4][2], B0[2][2], B1[2][2];
    const char* cA = (const char*)g.A + (size_t)cur.pm * tstep; const char* cB = (const char*)g.Bt + (size_t)cur.pn * tstep;
    S.a_ready(cur);
    if constexpr (SP2) {
        PG8_STAGE(PG8_SB(0, 0), cB, voffB); PG8_STAGE(PG8_SB(0, 1), cB + hstep, voffB); PG8_STAGE(PG8_SA(0, 0), cA, voffA); PG8_STAGE(PG8_SA(0, 1), cA + hstep, voffA);
        if (wr == 1) PG8_BAR;
        PG8_WAIT_V(2); PG8_BAR;
        PG8_STAGE(PG8_SB(1, 0), cB + kstep, voffB); PG8_STAGE(PG8_SA(1, 0), cA + kstep, voffA); PG8_STAGE(PG8_SB(1, 1), cB + hstep + kstep, voffB);
        PG8_WAIT_V(6); PG8_BAR;
    } else {
        PG8_STAGE(PG8_SB(0, 0), cB, voffB); PG8_STAGE(PG8_SA(0, 0), cA, voffA); PG8_STAGE(PG8_SB(0, 1), cB + hstep, voffB); PG8_STAGE(PG8_SA(0, 1), cA + hstep, voffA);
        if (wr == 1) PG8_BAR;
        PG8_WAIT_V(4); PG8_BAR;
        PG8_STAGE(PG8_SB(1, 0), cB + kstep, voffB); PG8_STAGE(PG8_SA(1, 0), cA + kstep, voffA); PG8_STAGE(PG8_SB(1, 1), cB + hstep + kstep, voffB);
        PG8_WAIT_V(6); PG8_BAR;
    }
    for (;;) {
        const bool has_next = S.next(ui + 1, nxt);
        const char* nA = has_next ? (const char*)g.A + (size_t)nxt.pm * tstep : cA; const char* nB = has_next ? (const char*)g.Bt + (size_t)nxt.pn * tstep : cB;
        for (int t = 0; t < nt; t += 2) {
            const bool last = (t == nt - 2);
            const char* a1 = cA + (size_t)(t + 1) * kstep;
            const char* a2 = last ? nA : cA + (size_t)(t + 2) * kstep; const char* b2 = last ? nB : cB + (size_t)(t + 2) * kstep;
            const char* a3 = a2 + kstep; const char* b3 = b2 + kstep;
            if (last && has_next) S.a_ready(nxt);
            if constexpr (SP2) {
            PG8_LDB(B0, 0, 0); PG8_LDB(B1, 0, 1); PG8_SCHED; PG8_LDA(At, 0, 0); PG8_STAGE(PG8_SA(1, 1), a1 + hstep, voffA);
            PG8_WAIT_V(8); PG8_WAIT_L(0); PG8_BAR; PG8_MMA(0, 0, At, B0); PG8_MMA(0, 1, At, B1); PG8_BAR; PG8_SCHED;
            PG8_LDA(At, 0, 1); PG8_STAGE(PG8_SB(0, 0), b2, voffB); PG8_STAGE(PG8_SB(0, 1), b2 + hstep, voffB); PG8_STAGE(PG8_SA(0, 0), a2, voffA);
            PG8_WAIT_V(8); PG8_WAIT_L(0); PG8_BAR; PG8_MMA(1, 0, At, B0); PG8_MMA(1, 1, At, B1); PG8_BAR; PG8_SCHED;
            PG8_LDB(B0, 1, 0); PG8_LDB(B1, 1, 1); PG8_SCHED; PG8_LDA(At, 1, 0); PG8_STAGE(PG8_SA(0, 1), a2 + hstep, voffA);
            PG8_WAIT_V(8); PG8_WAIT_L(0); PG8_BAR; PG8_MMA(0, 0, At, B0); PG8_MMA(0, 1, At, B1); PG8_BAR; PG8_SCHED;
            PG8_LDA(At, 1, 1); PG8_STAGE(PG8_SB(1, 0), b3, voffB); PG8_STAGE(PG8_SB(1, 1), b3 + hstep, voffB); PG8_STAGE(PG8_SA(1, 0), a3, voffA);
            PG8_WAIT_V(8); PG8_WAIT_L(0); PG8_BAR; PG8_MMA(1, 0, At, B0); PG8_MMA(1, 1, At, B1); PG8_BAR; PG8_SCHED;
            } else {
            PG8_LDB(B0, 0, 0); PG8_SCHED; PG8_LDA(At, 0, 0); PG8_STAGE(PG8_SA(1, 1), a1 + hstep, voffA);
            PG8_WAIT_L(8); PG8_BAR; PG8_WAIT_L(0); PG8_MMA(0, 0, At, B0); PG8_BAR; PG8_SCHED;
            PG8_LDB(B1, 0, 1); PG8_STAGE(PG8_SB(0, 0), b2, voffB);
            PG8_BAR; PG8_WAIT_L(0); PG8_MMA(0, 1, At, B1); PG8_BAR;
            PG8_LDA(At, 0, 1); PG8_STAGE(PG8_SA(0, 0), a2, voffA);
            PG8_BAR; PG8_WAIT_L(0); PG8_MMA(1, 0, At, B0); PG8_BAR; PG8_SCHED;
            PG8_STAGE(PG8_SB(0, 1), b2 + hstep, voffB);
            PG8_WAIT_V(6); PG8_BAR; PG8_MMA(1, 1, At, B1); PG8_BAR;
            PG8_LDB(B0, 1, 0); PG8_SCHED; PG8_LDA(At, 1, 0); PG8_STAGE(PG8_SA(0, 1), a2 + hstep, voffA);
            PG8_WAIT_L(8); PG8_BAR; PG8_WAIT_L(0); PG8_MMA(0, 0, At, B0); PG8_BAR; PG8_SCHED;
            PG8_LDB(B1, 1, 1); PG8_STAGE(PG8_SB(1, 0), b3, voffB);
            PG8_BAR; PG8_WAIT_L(0); PG8_MMA(0, 1, At, B1); PG8_BAR;
            PG8_LDA(At, 1, 1); PG8_STAGE(PG8_SA(1, 0), a3, voffA);
            PG8_BAR; PG8_WAIT_L(0); PG8_MMA(1, 0, At, B0); PG8_BAR; PG8_SCHED;
            PG8_STAGE(PG8_SB(1, 1), b3 + hstep, voffB);
            PG8_WAIT_V(6); PG8_BAR; PG8_MMA(1, 1, At, B1); PG8_BAR;
            }
        }
        if constexpr (ALIGN_EPI) { if (wr == 0) PG8_BAR; }
        if constexpr (!Epi::AFTER_DRAIN) { E(acc, cur, wr, wc, fr, fq, xlds); S.done(cur); }
        if (!has_next) break;
#pragma unroll
        for (int a = 0; a < 2; ++a)
#pragma unroll
            for (int b = 0; b < 2; ++b)
#pragma unroll
                for (int m = 0; m < 4; ++m)
#pragma unroll
                    for (int n = 0; n < 2; ++n) acc[a][b][m][n] = (f32x4){0.f, 0.f, 0.f, 0.f};
        cur = nxt; cA = nA; cB = nB; ++ui;
        if constexpr (ALIGN_EPI) { if (wr == 1) PG8_BAR; }
    }
    PG8_WAIT_V(0);
    if constexpr (!ALIGN_EPI) { if (wr == 0) PG8_BAR; }
    PG8_BAR;
#undef PG8_SA
#undef PG8_SB
#undef PG8_STAGE
#undef PG8_LDA
#undef PG8_LDB
#undef PG8_MMA
#undef PG8_WAIT_V
#undef PG8_WAIT_L
#undef PG8_BAR
#undef PG8_SCHED
}
}

constexpr int NWAVES = 8;
constexpr int D = 2048, DEPTH = 4;
constexpr int NB_CTX = 16, L_CTX = 256, NB_LAT = 8, L_LAT = 4096;
constexpr int M_CTX = NB_CTX * L_CTX, M_LAT = NB_LAT * L_LAT, M = M_CTX + M_LAT;
constexpr int DCONV = 1024, DRNN = 1024, NH = 16, HD = 64, DIN = 5120, DFF = 6144, NUP = 12288;
constexpr int NVEC = 9;
constexpr int NMODC = 6 * D;
constexpr float EPS = 1e-6f;
constexpr int NCHUNK = M / 64;

constexpr size_t MiB = 1u << 20;
constexpr size_t WS_CTL = 0, CTL_ZERO_BYTES = 64 * 1024;
constexpr size_t WS_MODV = 1 * MiB;
constexpr size_t WS_SUMM = 3 * MiB;
constexpr size_t WS_W = 48 * MiB;
constexpr size_t W_LAYER = 100 * MiB, W_IN_OFF = 0, W_OUT_OFF = 20 * MiB, W_UP_OFF = 28 * MiB, W_DOWN_OFF = 76 * MiB;
constexpr size_t WS_A = 448 * MiB;
constexpr size_t WS_BIG = 592 * MiB;
constexpr size_t WS_Y = 1024 * MiB;
constexpr size_t WS_HPRE = 1312 * MiB;
constexpr size_t WS_END = 1408 * MiB;
constexpr int CW_BAR = 1024;

constexpr int RING_BYTES = 131072;
constexpr int MISC_OFF = RING_BYTES + 8192 + 512;
constexpr int LDS_BYTES = 147456;

#define GAS __attribute__((address_space(1)))
#define LAS __attribute__((address_space(3)))
typedef unsigned short bf16;
typedef unsigned v4u __attribute__((ext_vector_type(4)));
typedef unsigned v2u __attribute__((ext_vector_type(2)));
typedef float f32x4 __attribute__((ext_vector_type(4)));
typedef float f32x2 __attribute__((ext_vector_type(2)));
#define LDS_WAIT() asm volatile("s_waitcnt lgkmcnt(0)" ::: "memory")
__device__ __forceinline__ unsigned f2bf(float f) { unsigned u = __builtin_bit_cast(unsigned, f); return (u + 0x7fffu + ((u >> 16) & 1u)) >> 16; }
__device__ __forceinline__ unsigned pk2(float lo, float hi) { return f2bf(lo) | (f2bf(hi) << 16); }
__device__ __forceinline__ float bf2f(unsigned short b) { return __builtin_bit_cast(float, ((unsigned)b) << 16); }
__device__ __forceinline__ float bflo(unsigned w) { return __builtin_bit_cast(float, w << 16); }
__device__ __forceinline__ float bfhi(unsigned w) { return __builtin_bit_cast(float, w & 0xffff0000u); }
__device__ __forceinline__ float sigmoidf_(float x) { return 1.f / (1.f + __expf(-x)); }
__device__ __forceinline__ float gelu_tanh(float x) { const float u = 1.5957691216057308f * (x + 0.044715f * x * x * x); return x / (1.f + __expf(-u)); }
__device__ __forceinline__ float wave_sum(float v) {
#pragma unroll
    for (int o = 1; o < 64; o <<= 1) v += __shfl_xor(v, o);
    return v;
}

#define XB_TMO      128
#define XB_XCNT(j)  (256  + 64 * (j))
#define XB_XSUB(j)  (1280 + 64 * (j))
#define XB_XGEN(j)  (2304 + 64 * (j))
#define XB_TOP      3328
#define XB_TOPGEN   3392
#define XCD_BAR_WORDS 3456
#define XB_SPIN_CAP (1u << 18)
__device__ __forceinline__ unsigned xb_ld(unsigned* p)              { return __hip_atomic_load(p, __ATOMIC_RELAXED, __HIP_MEMORY_SCOPE_AGENT); }
__device__ __forceinline__ unsigned xb_add(unsigned* p, unsigned v) { return __hip_atomic_fetch_add(p, v, __ATOMIC_RELAXED, __HIP_MEMORY_SCOPE_AGENT); }
__device__ __forceinline__ unsigned xb_xcc_id() { return (unsigned)__builtin_amdgcn_s_getreg((3 << 11) | 20) & 0xFu; }
#define XB_SPIN(cond, bar) do { unsigned _sp = 0; while (cond) { __builtin_amdgcn_s_sleep(1); \
    if ((++_sp & 255u) == 0u) { if (xb_ld(&(bar)[XB_TMO])) break; if (_sp > XB_SPIN_CAP) { atomicAdd(&(bar)[XB_TMO], 1u); break; } } } } while (0)
struct XcdBarrier { unsigned* bar; unsigned x; volatile LAS unsigned* st; };
__device__ __forceinline__ XcdBarrier xcd_barrier_post(unsigned* bar, volatile LAS unsigned* st) {
    XcdBarrier b; b.bar = bar; b.x = xb_xcc_id(); b.st = st;
    if (threadIdx.x == 0) (void)xb_add(&bar[XB_XCNT(b.x)], 1u);
    return b;
}
__device__ __forceinline__ void xcd_barrier_complete(unsigned* bar, unsigned x, unsigned& nloc, unsigned& nx) {
    const unsigned G = gridDim.x * gridDim.y * gridDim.z;
    unsigned sum, cnt, mine, sp = 0u;
    for (;;) {
        sum = 0u; cnt = 0u; mine = 0u;
#pragma unroll
        for (unsigned j = 0; j < 16; ++j) { const unsigned c = xb_ld(&bar[XB_XCNT(j)]); sum += c; cnt += (c > 0u) ? 1u : 0u; mine = (j == x) ? c : mine; }
        if (sum == G) break;
        __builtin_amdgcn_s_sleep(1);
        if ((++sp & 255u) == 0u) { if (xb_ld(&bar[XB_TMO])) break; if (sp > XB_SPIN_CAP) { atomicAdd(&bar[XB_TMO], 1u); break; } }
    }
    nloc = mine > 0u ? mine : 1u; nx = cnt > 0u ? cnt : 1u;
}
__device__ __forceinline__ void xcd_barrier(const XcdBarrier& b) {
    asm volatile("s_waitcnt vmcnt(0)" ::: "memory");
    __syncthreads();
    if (threadIdx.x == 0) {
        unsigned* bar = b.bar;
        __builtin_amdgcn_s_waitcnt(0);
        unsigned nloc = b.st[0], nx = b.st[1];
        if (nloc == 0u) { xcd_barrier_complete(bar, b.x, nloc, nx); b.st[0] = nloc; b.st[1] = nx; }
        const unsigned old = xb_add(&bar[XB_XSUB(b.x)], 1u);
        const unsigned gen = old / nloc;
        if (old + 1u == (gen + 1u) * nloc) {
            __builtin_amdgcn_fence(__ATOMIC_RELEASE, "agent");
            asm volatile("s_waitcnt vmcnt(0)" ::: "memory");
            const unsigned og = xb_add(&bar[XB_TOP], 1u);
            const unsigned tg = og / nx;
            if (og + 1u == (tg + 1u) * nx) xb_add(&bar[XB_TOPGEN], 1u);
            else XB_SPIN(xb_ld(&bar[XB_TOPGEN]) == tg, bar);
            __builtin_amdgcn_fence(__ATOMIC_ACQUIRE, "agent");
            xb_add(&bar[XB_XGEN(b.x)], 1u);
            asm volatile("s_waitcnt vmcnt(0)" ::: "memory");
        } else {
            XB_SPIN(xb_ld(&bar[XB_XGEN(b.x)]) == gen, bar);
            __builtin_amdgcn_fence(__ATOMIC_ACQUIRE, "agent");
            asm volatile("s_waitcnt vmcnt(0)" ::: "memory");
        }
    }
    __syncthreads();
}

struct Args {
    const float* in[21];
    float* out; unsigned char* ws;
    int ph_lo, ph_hi;
};
enum { I_XP = 0, I_XS, I_STATE, I_C, I_CCTX, I_WADA, I_BADA, I_NORMG, I_WIN, I_CONVA, I_RCW, I_RCB, I_RWA, I_RBA, I_RWX, I_RBX, I_RLAM, I_WOUT, I_FUP, I_FCW, I_FDOWN };

__device__ __forceinline__ void transpose_item(const float* W, int K, int N, bf16* WT, int k0, int n0, int dst_row0, LAS float* scr, int lane) {
#pragma unroll 8
    for (int i = 0; i < 32; ++i) { const int kk = 2 * i + (lane >> 5); scr[kk * 33 + (lane & 31)] = W[(size_t)(k0 + kk) * N + n0 + (lane & 31)]; }
    LDS_WAIT(); asm volatile("" ::: "memory");
    const int c = lane & 7;
#pragma unroll
    for (int j = 0; j < 4; ++j) { const int n = (lane >> 3) + 8 * j; const LAS float* s = scr + (8 * c) * 33 + n;
        v4u o; o.x = pk2(s[0 * 33], s[1 * 33]); o.y = pk2(s[2 * 33], s[3 * 33]); o.z = pk2(s[4 * 33], s[5 * 33]); o.w = pk2(s[6 * 33], s[7 * 33]);
        *(GAS v4u*)(WT + (size_t)(dst_row0 + n) * K + k0 + 8 * c) = o; }
    LDS_WAIT(); asm volatile("" ::: "memory");
}
constexpr int TI_IN = (D / 64) * (DIN / 32), TI_OUT = (D / 64) * (D / 32), TI_UP = (D / 64) * (NUP / 32), TI_DOWN = (DFF / 64) * (D / 32);
constexpr int TI_LAYER = TI_IN + TI_OUT + TI_UP + TI_DOWN;

__device__ __forceinline__ void pre_transposes(const Args& a, LAS unsigned char* lds, int gw, int NGW, int wave, int lane) {
    LAS float* scr = (LAS float*)(lds + wave * 16384);
    for (int it = gw; it < DEPTH * TI_LAYER; it += NGW) {
        const int l = it / TI_LAYER; int r = it % TI_LAYER;
        bf16* wl = (bf16*)(a.ws + WS_W + (size_t)l * W_LAYER);
        if (r < TI_IN) { const int nblk = DIN / 32, kb = r / nblk, nb = r % nblk;
            transpose_item(a.in[I_WIN] + (size_t)l * D * DIN, D, DIN, (bf16*)((unsigned char*)wl + W_IN_OFF), 64 * kb, 32 * nb, 32 * nb, scr, lane); continue; }
        r -= TI_IN;
        if (r < TI_OUT) { const int nblk = D / 32, kb = r / nblk, nb = r % nblk;
            transpose_item(a.in[I_WOUT] + (size_t)l * D * D, D, D, (bf16*)((unsigned char*)wl + W_OUT_OFF), 64 * kb, 32 * nb, 32 * nb, scr, lane); continue; }
        r -= TI_OUT;
        if (r < TI_UP) { const int nblk = NUP / 32, kb = r / nblk, nb = r % nblk; const int n0 = 32 * nb;
            const int dst = (n0 < DFF) ? ((n0 >> 7) * 256 + (n0 & 127)) : ((((n0 - DFF) >> 7) * 256) + 128 + ((n0 - DFF) & 127));
            transpose_item(a.in[I_FUP] + (size_t)l * D * NUP, D, NUP, (bf16*)((unsigned char*)wl + W_UP_OFF), 64 * kb, n0, dst, scr, lane); continue; }
        r -= TI_UP;
        { const int nblk = D / 32, kb = r / nblk, nb = r % nblk;
            transpose_item(a.in[I_FDOWN] + (size_t)l * DFF * D, DFF, D, (bf16*)((unsigned char*)wl + W_DOWN_OFF), 64 * kb, 32 * nb, 32 * nb, scr, lane); }
    }
}

__device__ __forceinline__ void pre_mod(const Args& a, LAS unsigned char* lds, int tid, int wave, int lane) {
    LAS float* s = (LAS float*)lds;
    LAS float* red = s + NVEC * D;
    for (int i = tid; i < NVEC * D; i += NWAVES * 64) { const int v = i / D, k = i % D; const float c = (v == 0) ? a.in[I_CCTX][k] : a.in[I_C][(v - 1) * D + k]; s[i] = c / (1.f + __expf(-c)); }
    __syncthreads();
    float* modv = (float*)(a.ws + WS_MODV);
    const int cl = tid & 15, ks = tid >> 4;
    for (int item = blockIdx.x; item < DEPTH * (NMODC / 64); item += gridDim.x) {
        const int l = item / (NMODC / 64), n0 = (item % (NMODC / 64)) * 64;
        float acc[NVEC][4];
#pragma unroll
        for (int v = 0; v < NVEC; ++v) { acc[v][0] = 0.f; acc[v][1] = 0.f; acc[v][2] = 0.f; acc[v][3] = 0.f; }
        const float* wp = a.in[I_WADA] + ((size_t)l * D + ks * 64) * NMODC + n0 + 4 * cl;
        const LAS float* sp = s + ks * 64;
#pragma unroll 8
        for (int kk = 0; kk < 64; ++kk) {
            const f32x4 w = *(const f32x4*)(wp + (size_t)kk * NMODC);
#pragma unroll
            for (int v = 0; v < NVEC; ++v) { const float sv = sp[v * D + kk]; acc[v][0] += sv * w[0]; acc[v][1] += sv * w[1]; acc[v][2] += sv * w[2]; acc[v][3] += sv * w[3]; }
        }
#pragma unroll
        for (int v = 0; v < NVEC; ++v)
#pragma unroll
            for (int e = 0; e < 4; ++e) { float t = acc[v][e]; t += __shfl_xor(t, 16); t += __shfl_xor(t, 32); if (lane < 16) red[(wave * 16 + cl) * 36 + v * 4 + e] = t; }
        __syncthreads();
        for (int o = tid; o < NVEC * 64; o += NWAVES * 64) {
            const int v = o >> 6, col = o & 63;
            float sum = 0.f;
#pragma unroll
            for (int w = 0; w < NWAVES; ++w) sum += red[(w * 16 + (col >> 2)) * 36 + v * 4 + (col & 3)];
            const int n = n0 + col, q = n / D, j = n % D;
            const float val = sum + a.in[I_BADA][l * NMODC + n];
            const float* ng = a.in[I_NORMG] + (size_t)l * 4 * D;
            int slot; float r;
            if (q == 0) { slot = 1; r = val; }
            else if (q == 1) { slot = 0; r = ng[0 * D + j] * (1.f + val); }
            else if (q == 2) { slot = 2; r = val * ng[1 * D + j]; }
            else if (q == 3) { slot = 4; r = val; }
            else if (q == 4) { slot = 3; r = ng[2 * D + j] * (1.f + val); }
            else { slot = 5; r = val * ng[3 * D + j]; }
            modv[((size_t)(l * NVEC + v) * 6 + slot) * D + j] = r;
        }
        __syncthreads();
    }
}

template <bool HAS_RES, bool HAS_U>
__device__ __forceinline__ void resnorm_rows(const Args& a, int gw, int NGW, int lane, const float* xsrc_ctx, const float* xsrc_lat, const float* y, int l_res, int slot_res, int l_u) {
    const float* modv = (const float*)(a.ws + WS_MODV);
    bf16* U = (bf16*)(a.ws + WS_A);
    for (int m = gw; m < M; m += NGW) {
        const int v = (m < M_CTX) ? 0 : 1 + ((m - M_CTX) >> 12);
        const float* xs = (m < M_CTX) ? xsrc_ctx + (size_t)m * D : xsrc_lat + (size_t)(m - M_CTX) * D;
        const GAS f32x4* xr = (const GAS f32x4*)xs + lane;
        f32x4 xv[8];
#pragma unroll
        for (int j = 0; j < 8; ++j) xv[j] = xr[64 * j];
        if (HAS_RES) {
            const GAS f32x4* yr = (const GAS f32x4*)(y + (size_t)m * D) + lane;
            const GAS f32x4* gr = (const GAS f32x4*)(modv + ((size_t)(l_res * NVEC + v) * 6 + slot_res) * D) + lane;
            f32x4 yv[8]; float ss = 0.f;
#pragma unroll
            for (int j = 0; j < 8; ++j) { yv[j] = yr[64 * j]; ss += (yv[j].x * yv[j].x + yv[j].y * yv[j].y) + (yv[j].z * yv[j].z + yv[j].w * yv[j].w); }
            const float rstd = 1.f / sqrtf(wave_sum(ss) * (1.f / D) + EPS);
#pragma unroll
            for (int j = 0; j < 8; ++j) { const f32x4 g = gr[64 * j]; xv[j] = xv[j] + g * yv[j] * rstd; }
        }
        GAS f32x4* xo = (GAS f32x4*)(a.out + (size_t)m * D) + lane;
#pragma unroll
        for (int j = 0; j < 8; ++j) xo[64 * j] = xv[j];
        if (HAS_U) {
            float ss = 0.f;
#pragma unroll
            for (int j = 0; j < 8; ++j) ss += (xv[j].x * xv[j].x + xv[j].y * xv[j].y) + (xv[j].z * xv[j].z + xv[j].w * xv[j].w);
            const float rstd = 1.f / sqrtf(wave_sum(ss) * (1.f / D) + EPS);
            const GAS f32x4* gn = (const GAS f32x4*)(modv + ((size_t)(l_u * NVEC + v) * 6 + (l_u == l_res && HAS_RES ? 3 : 0)) * D) + lane;
            const GAS f32x4* bn = (const GAS f32x4*)(modv + ((size_t)(l_u * NVEC + v) * 6 + (l_u == l_res && HAS_RES ? 4 : 1)) * D) + lane;
            GAS v2u* uo = (GAS v2u*)(U + (size_t)m * D) + lane;
#pragma unroll
            for (int j = 0; j < 8; ++j) { const f32x4 g = gn[64 * j], b = bn[64 * j]; const f32x4 t = xv[j] * rstd * g + b; v2u o; o.x = pk2(t.x, t.y); o.y = pk2(t.z, t.w); uo[64 * j] = o; }
        }
    }
}

struct SeqInfo { int base, L, s0, b, cfirst, clast; bool col, ctx; };
__device__ __forceinline__ SeqInfo seq_info(int c, int layer) {
    SeqInfo q;
    if (c < 64) { q.b = c >> 2; q.s0 = (c & 3) * 64; q.L = L_CTX; q.base = q.b * L_CTX; q.col = false; q.ctx = true; q.cfirst = c & ~3; q.clast = q.cfirst + 3; }
    else { const int cc = c - 64; q.b = cc >> 6; q.s0 = (cc & 63) * 64; q.L = L_LAT; q.base = M_CTX + q.b * L_LAT; q.col = (layer & 1) != 0; q.ctx = false; q.cfirst = 64 + (cc & ~63); q.clast = q.cfirst + 63; }
    return q;
}
__device__ __forceinline__ int tok_of(const SeqInfo& q, int s) { return q.base + (q.col ? (((s & 63) << 6) | (s >> 6)) : s); }

__device__ __forceinline__ void gate_step(float xc, const float (&Wa)[64], const float (&Wx)[64], float ba, float bx, float c8, float& a, float& v) {
    float r = ba, g = bx;
    const int xci = __builtin_bit_cast(int, xc);
#pragma unroll
    for (int i = 0; i < 64; ++i) { const float s = __builtin_bit_cast(float, __builtin_amdgcn_readlane(xci, i)); r = fmaf(s, Wa[i], r); g = fmaf(s, Wx[i], g); }
    r = sigmoidf_(r); g = sigmoidf_(g);
    const float la = c8 * r;
    a = __expf(la);
    const float mlt = sqrtf(fmaxf(0.f, -expm1f(2.f * la)));
    v = mlt * g * xc;
}

struct DirParams { float ba, bx, c8, cw0, cw1, cw2, cw3, cb; };
__device__ __forceinline__ void load_dir(const Args& a, int layer, int d, int h, int lane, float (&Wa)[64], float (&Wx)[64], DirParams& p) {
    const int ld = layer * 2 + d, ch = h * 64 + lane;
    const float* wa = a.in[I_RWA] + ((size_t)(ld * NH + h) * 64) * 64 + lane;
    const float* wx = a.in[I_RWX] + ((size_t)(ld * NH + h) * 64) * 64 + lane;
#pragma unroll
    for (int i = 0; i < 64; ++i) { Wa[i] = wa[i * 64]; Wx[i] = wx[i * 64]; }
    p.ba = a.in[I_RBA][ld * DRNN + ch]; p.bx = a.in[I_RBX][ld * DRNN + ch];
    const float lam = a.in[I_RLAM][ld * DRNN + ch];
    p.c8 = -8.f * log1pf(__expf(-lam));
    p.cw0 = a.in[I_RCW][(ld * 4 + 0) * DRNN + ch]; p.cw1 = a.in[I_RCW][(ld * 4 + 1) * DRNN + ch];
    p.cw2 = a.in[I_RCW][(ld * 4 + 2) * DRNN + ch]; p.cw3 = a.in[I_RCW][(ld * 4 + 3) * DRNN + ch];
    p.cb = a.in[I_RCB][ld * DRNN + ch];
}
__device__ __forceinline__ float load_xr(const bf16* xr, const SeqInfo& q, int d, int qq) {
    const int s = d ? (q.s0 + 63 - qq) : (q.s0 + qq);
    return (s >= 0 && s < q.L) ? bf2f(xr[(size_t)tok_of(q, s) * DIN]) : 0.f;
}

__device__ __forceinline__ void scan_summary_item(const Args& a, int layer, int item, int lane) {
    const int d = item & 1, h = (item >> 1) & 15, c = item >> 5;
    const SeqInfo q = seq_info(c, layer);
    float Wa[64], Wx[64]; DirParams p;
    load_dir(a, layer, d, h, lane, Wa, Wx, p);
    const bf16* xr = (const bf16*)(a.ws + WS_BIG) + 3 * DCONV + h * 64 + lane;
    float x3 = load_xr(xr, q, d, -3), x2 = load_xr(xr, q, d, -2), x1 = load_xr(xr, q, d, -1);
    float n0 = load_xr(xr, q, d, 0), n1 = load_xr(xr, q, d, 1), n2 = load_xr(xr, q, d, 2), n3 = load_xr(xr, q, d, 3);
    float hh = 0.f, A = 1.f;
    for (int it = 0; it < 16; ++it) {
        const float c0 = n0, c1 = n1, c2 = n2, c3 = n3;
        if (it < 15) { n0 = load_xr(xr, q, d, 4 * it + 4); n1 = load_xr(xr, q, d, 4 * it + 5); n2 = load_xr(xr, q, d, 4 * it + 6); n3 = load_xr(xr, q, d, 4 * it + 7); }
        float xc, av, vv;
        xc = p.cb + p.cw0 * x3 + p.cw1 * x2 + p.cw2 * x1 + p.cw3 * c0; gate_step(xc, Wa, Wx, p.ba, p.bx, p.c8, av, vv); hh = av * hh + vv; A *= av;
        xc = p.cb + p.cw0 * x2 + p.cw1 * x1 + p.cw2 * c0 + p.cw3 * c1; gate_step(xc, Wa, Wx, p.ba, p.bx, p.c8, av, vv); hh = av * hh + vv; A *= av;
        xc = p.cb + p.cw0 * x1 + p.cw1 * c0 + p.cw2 * c1 + p.cw3 * c2; gate_step(xc, Wa, Wx, p.ba, p.bx, p.c8, av, vv); hh = av * hh + vv; A *= av;
        xc = p.cb + p.cw0 * c0 + p.cw1 * c1 + p.cw2 * c2 + p.cw3 * c3; gate_step(xc, Wa, Wx, p.ba, p.bx, p.c8, av, vv); hh = av * hh + vv; A *= av;
        x3 = c1; x2 = c2; x1 = c3;
    }
    f32x2* summ = (f32x2*)(a.ws + WS_SUMM);
    summ[(size_t)(c * 2 + d) * DRNN + h * 64 + lane] = (f32x2){A, hh};
}

__device__ __forceinline__ float carry_in(const Args& a, const SeqInfo& q, int layer, int c, int d, int ch) {
    const f32x2* summ = (const f32x2*)(a.ws + WS_SUMM);
    float hin = q.ctx ? 0.f : a.in[I_STATE][((size_t)(q.b * DEPTH + layer) * 2 + d) * DRNN + ch];
    const int n = d ? (q.clast - c) : (c - q.cfirst);
    for (int i0 = 0; i0 < n; i0 += 8) {
        f32x2 t[8];
#pragma unroll
        for (int k = 0; k < 8; ++k) { const int i = i0 + k; const int cc = d ? (q.clast - i) : (q.cfirst + i); t[k] = (i < n) ? summ[(size_t)(cc * 2 + d) * DRNN + ch] : (f32x2){1.f, 0.f}; }
#pragma unroll
        for (int k = 0; k < 8; ++k) hin = t[k].x * hin + t[k].y;
    }
    return hin;
}

__device__ __forceinline__ void mixb_item(const Args& a, int layer, int item, int lane, LAS float* hf) {
    const int h = item & 15, c = item >> 4, ch = h * 64 + lane;
    const SeqInfo q = seq_info(c, layer);
    const bf16* proj = (const bf16*)(a.ws + WS_BIG);
    const bf16* xr = proj + 3 * DCONV + ch;
    const bf16* gr = proj + 3 * DCONV + DRNN + ch;
    bf16* ymix = (bf16*)(a.ws + WS_A) + DCONV + ch;
    float* nstate = a.out + (size_t)M * D;
    float Wa[64], Wx[64]; DirParams p;
    {
        load_dir(a, layer, 0, h, lane, Wa, Wx, p);
        float hh = carry_in(a, q, layer, c, 0, ch);
        float x3 = load_xr(xr, q, 0, -3), x2 = load_xr(xr, q, 0, -2), x1 = load_xr(xr, q, 0, -1);
        float n0 = load_xr(xr, q, 0, 0), n1 = load_xr(xr, q, 0, 1), n2 = load_xr(xr, q, 0, 2), n3 = load_xr(xr, q, 0, 3);
        for (int it = 0; it < 16; ++it) {
            const float c0 = n0, c1 = n1, c2 = n2, c3 = n3;
            if (it < 15) { n0 = load_xr(xr, q, 0, 4 * it + 4); n1 = load_xr(xr, q, 0, 4 * it + 5); n2 = load_xr(xr, q, 0, 4 * it + 6); n3 = load_xr(xr, q, 0, 4 * it + 7); }
            float xc, av, vv;
            xc = p.cb + p.cw0 * x3 + p.cw1 * x2 + p.cw2 * x1 + p.cw3 * c0; gate_step(xc, Wa, Wx, p.ba, p.bx, p.c8, av, vv); hh = av * hh + vv; hf[(4 * it + 0) * 64 + lane] = hh;
            xc = p.cb + p.cw0 * x2 + p.cw1 * x1 + p.cw2 * c0 + p.cw3 * c1; gate_step(xc, Wa, Wx, p.ba, p.bx, p.c8, av, vv); hh = av * hh + vv; hf[(4 * it + 1) * 64 + lane] = hh;
            xc = p.cb + p.cw0 * x1 + p.cw1 * c0 + p.cw2 * c1 + p.cw3 * c2; gate_step(xc, Wa, Wx, p.ba, p.bx, p.c8, av, vv); hh = av * hh + vv; hf[(4 * it + 2) * 64 + lane] = hh;
            xc = p.cb + p.cw0 * c0 + p.cw1 * c1 + p.cw2 * c2 + p.cw3 * c3; gate_step(xc, Wa, Wx, p.ba, p.bx, p.c8, av, vv); hh = av * hh + vv; hf[(4 * it + 3) * 64 + lane] = hh;
            x3 = c1; x2 = c2; x1 = c3;
        }
        if (q.ctx && c == q.clast) nstate[((size_t)(q.b * DEPTH + layer) * 2 + 0) * DRNN + ch] = hh;
    }
    {
        load_dir(a, layer, 1, h, lane, Wa, Wx, p);
        float hh = carry_in(a, q, layer, c, 1, ch);
        float x3 = load_xr(xr, q, 1, -3), x2 = load_xr(xr, q, 1, -2), x1 = load_xr(xr, q, 1, -1);
        float n0 = load_xr(xr, q, 1, 0), n1 = load_xr(xr, q, 1, 1), n2 = load_xr(xr, q, 1, 2), n3 = load_xr(xr, q, 1, 3);
        float g0 = load_xr(gr, q, 1, 0), g1 = load_xr(gr, q, 1, 1), g2 = load_xr(gr, q, 1, 2), g3 = load_xr(gr, q, 1, 3);
        for (int it = 0; it < 16; ++it) {
            const float c0 = n0, c1 = n1, c2 = n2, c3 = n3, e0 = g0, e1 = g1, e2 = g2, e3 = g3;
            if (it < 15) { n0 = load_xr(xr, q, 1, 4 * it + 4); n1 = load_xr(xr, q, 1, 4 * it + 5); n2 = load_xr(xr, q, 1, 4 * it + 6); n3 = load_xr(xr, q, 1, 4 * it + 7);
                           g0 = load_xr(gr, q, 1, 4 * it + 4); g1 = load_xr(gr, q, 1, 4 * it + 5); g2 = load_xr(gr, q, 1, 4 * it + 6); g3 = load_xr(gr, q, 1, 4 * it + 7); }
            float xc, av, vv; int qq, s;
            xc = p.cb + p.cw0 * x3 + p.cw1 * x2 + p.cw2 * x1 + p.cw3 * c0; gate_step(xc, Wa, Wx, p.ba, p.bx, p.c8, av, vv); hh = av * hh + vv;
            qq = 4 * it + 0; s = q.s0 + 63 - qq; ymix[(size_t)tok_of(q, s) * D] = (bf16)f2bf((hf[(63 - qq) * 64 + lane] + hh) * gelu_tanh(e0));
            xc = p.cb + p.cw0 * x2 + p.cw1 * x1 + p.cw2 * c0 + p.cw3 * c1; gate_step(xc, Wa, Wx, p.ba, p.bx, p.c8, av, vv); hh = av * hh + vv;
            qq = 4 * it + 1; s = q.s0 + 63 - qq; ymix[(size_t)tok_of(q, s) * D] = (bf16)f2bf((hf[(63 - qq) * 64 + lane] + hh) * gelu_tanh(e1));
            xc = p.cb + p.cw0 * x1 + p.cw1 * c0 + p.cw2 * c1 + p.cw3 * c2; gate_step(xc, Wa, Wx, p.ba, p.bx, p.c8, av, vv); hh = av * hh + vv;
            qq = 4 * it + 2; s = q.s0 + 63 - qq; ymix[(size_t)tok_of(q, s) * D] = (bf16)f2bf((hf[(63 - qq) * 64 + lane] + hh) * gelu_tanh(e2));
            xc = p.cb + p.cw0 * c0 + p.cw1 * c1 + p.cw2 * c2 + p.cw3 * c3; gate_step(xc, Wa, Wx, p.ba, p.bx, p.c8, av, vv); hh = av * hh + vv;
            qq = 4 * it + 3; s = q.s0 + 63 - qq; ymix[(size_t)tok_of(q, s) * D] = (bf16)f2bf((hf[(63 - qq) * 64 + lane] + hh) * gelu_tanh(e3));
            x3 = c1; x2 = c2; x1 = c3;
        }
        if (q.ctx && c == q.cfirst) nstate[((size_t)(q.b * DEPTH + layer) * 2 + 1) * DRNN + ch] = hh;
    }
    LDS_WAIT(); asm volatile("" ::: "memory");
}

__device__ __forceinline__ void mixa_item(const Args& a, int layer, int item, int lane) {
    const int g4 = item & 3, c = item >> 2, ch0 = g4 * 256 + lane * 4;
    const SeqInfo q = seq_info(c, layer);
    const bf16* proj = (const bf16*)(a.ws + WS_BIG);
    bf16* ymix = (bf16*)(a.ws + WS_A);
    const f32x4 w0 = *(const f32x4*)(a.in[I_CONVA] + (size_t)(layer * 3 + 0) * DCONV + ch0);
    const f32x4 w1 = *(const f32x4*)(a.in[I_CONVA] + (size_t)(layer * 3 + 1) * DCONV + ch0);
    const f32x4 w2 = *(const f32x4*)(a.in[I_CONVA] + (size_t)(layer * 3 + 2) * DCONV + ch0);
    auto cx_at = [&](int s) -> f32x4 {
        if (s < 0 || s >= q.L) return (f32x4){0.f, 0.f, 0.f, 0.f};
        const bf16* row = proj + (size_t)tok_of(q, s) * DIN + ch0;
        const v2u cg = *(const v2u*)(row + DCONV), xa = *(const v2u*)(row + 2 * DCONV);
        return (f32x4){bflo(cg.x) * bflo(xa.x), bfhi(cg.x) * bfhi(xa.x), bflo(cg.y) * bflo(xa.y), bfhi(cg.y) * bfhi(xa.y)};
    };
    f32x4 cm = cx_at(q.s0 - 1), cc = cx_at(q.s0);
    for (int blk = 0; blk < 8; ++blk) {
        f32x4 cn[8]; v2u bg[8];
#pragma unroll
        for (int e = 0; e < 8; ++e) { const int s = q.s0 + 8 * blk + e; cn[e] = cx_at(s + 1); bg[e] = *(const v2u*)(proj + (size_t)tok_of(q, s) * DIN + ch0); }
#pragma unroll
        for (int e = 0; e < 8; ++e) {
            const int s = q.s0 + 8 * blk + e;
            const f32x4 hv = w0 * cm + w1 * cc + w2 * cn[e];
            const f32x4 bv = (f32x4){bflo(bg[e].x), bfhi(bg[e].x), bflo(bg[e].y), bfhi(bg[e].y)};
            const f32x4 o = bv * hv;
            v2u ov; ov.x = pk2(o.x, o.y); ov.y = pk2(o.z, o.w);
            *(v2u*)(ymix + (size_t)tok_of(q, s) * D + ch0) = ov;
            cm = cc; cc = cn[e];
        }
    }
}

__device__ __forceinline__ void convgate_item(const Args& a, int layer, int chunk, int item, int lane) {
    const int cgp = item % 12, rb = item / 12, r0 = rb * 8, ch0 = cgp * 512 + lane * 8;
    const int seqlen = (chunk == 0) ? L_CTX : L_LAT;
    const bf16* hp = (const bf16*)(a.ws + WS_HPRE) + (size_t)((ch0 >> 7) * 256 + (ch0 & 127));
    bf16* act = (bf16*)(a.ws + WS_BIG) + (size_t)(chunk * 4096) * DFF + ch0;
    const float* cw = a.in[I_FCW] + (size_t)layer * 3 * NUP;
    float wg[3][8], wv[3][8];
#pragma unroll
    for (int t = 0; t < 3; ++t)
#pragma unroll
        for (int e = 0; e < 8; ++e) { wg[t][e] = cw[t * NUP + ch0 + e]; wv[t][e] = cw[t * NUP + DFF + ch0 + e]; }
    v4u rg[10], rv[10];
#pragma unroll
    for (int i = 0; i < 10; ++i) {
        const int r = r0 - 1 + i;
        const bool ok = (i == 0) ? ((r0 % seqlen) != 0) : (i == 9) ? (((r0 + 8) % seqlen) != 0) : true;
        if (ok) { rg[i] = *(const v4u*)(hp + (size_t)r * NUP); rv[i] = *(const v4u*)(hp + (size_t)r * NUP + 128); }
        else { rg[i] = (v4u){0u, 0u, 0u, 0u}; rv[i] = (v4u){0u, 0u, 0u, 0u}; }
    }
#pragma unroll
    for (int i = 1; i <= 8; ++i) {
        float o[8];
#pragma unroll
        for (int e2 = 0; e2 < 4; ++e2) {
            const unsigned gm = rg[i - 1][e2], gc = rg[i][e2], gn = rg[i + 1][e2], vm = rv[i - 1][e2], vc = rv[i][e2], vn = rv[i + 1][e2];
            const float hg0 = wg[0][2 * e2] * bflo(gm) + wg[1][2 * e2] * bflo(gc) + wg[2][2 * e2] * bflo(gn);
            const float hg1 = wg[0][2 * e2 + 1] * bfhi(gm) + wg[1][2 * e2 + 1] * bfhi(gc) + wg[2][2 * e2 + 1] * bfhi(gn);
            const float hv0 = wv[0][2 * e2] * bflo(vm) + wv[1][2 * e2] * bflo(vc) + wv[2][2 * e2] * bflo(vn);
            const float hv1 = wv[0][2 * e2 + 1] * bfhi(vm) + wv[1][2 * e2 + 1] * bfhi(vc) + wv[2][2 * e2 + 1] * bfhi(vn);
            o[2 * e2] = gelu_tanh(hg0) * hv0; o[2 * e2 + 1] = gelu_tanh(hg1) * hv1;
        }
        v4u ov; ov.x = pk2(o[0], o[1]); ov.y = pk2(o[2], o[3]); ov.z = pk2(o[4], o[5]); ov.w = pk2(o[6], o[7]);
        *(v4u*)(act + (size_t)(r0 + i - 1) * DFF) = ov;
    }
}

constexpr int PH_PRE = 0, PH_NORM0 = 1, PH_LAYER0 = 2, NPL = 25, N_PHASES = PH_LAYER0 + DEPTH * NPL;

__global__ void __launch_bounds__(NWAVES * 64, 2) fwd_kernel(Args args) {
    extern __shared__ __attribute__((aligned(16))) unsigned char lds_raw[];
    LAS unsigned char* lds = (LAS unsigned char*)lds_raw;
    volatile LAS unsigned* MISC = (volatile LAS unsigned*)(lds + MISC_OFF);
    const int G = gridDim.x, NGW = G * NWAVES;
    const int lo = args.ph_lo, hi = args.ph_hi;
#define PHASE_IDS int tid = threadIdx.x; asm volatile("" : "+v"(tid)); const int lane = tid & 63, wave = __builtin_amdgcn_readfirstlane(tid >> 6), gw = blockIdx.x * NWAVES + wave; (void)lane; (void)gw;
    if (threadIdx.x < 32) MISC[threadIdx.x] = 0u;
    __syncthreads();
    XcdBarrier bar; bar.bar = (unsigned*)(args.ws + WS_CTL) + CW_BAR; bar.x = 0; bar.st = nullptr;
    if (hi - lo > 1) bar = xcd_barrier_post((unsigned*)(args.ws + WS_CTL) + CW_BAR, MISC + 8);
#define IN(k) (lo <= (k) && (k) < hi)
#define SEAM(k) do { if (IN(k) && IN((k) + 1)) xcd_barrier(bar); } while (0)
    unsigned char* ws = args.ws;

    if (IN(PH_PRE)) { PHASE_IDS pre_transposes(args, lds, gw, NGW, wave, lane); __syncthreads(); pre_mod(args, lds, tid, wave, lane); }
    SEAM(PH_PRE);
    if (IN(PH_NORM0)) { PHASE_IDS resnorm_rows<false, true>(args, gw, NGW, lane, args.in[I_XP], args.in[I_XS], nullptr, 0, 0, 0); }
    SEAM(PH_NORM0);

    for (int l = 0; l < DEPTH; ++l) {
        const int pb = PH_LAYER0 + l * NPL;
        const bf16* wl = (const bf16*)(ws + WS_W + (size_t)l * W_LAYER);
        if (IN(pb + 0)) {
            pg8::Gemm g{(const bf16*)(ws + WS_A), (const bf16*)((const unsigned char*)wl + W_IN_OFF), M, DIN, D}; pg8::StaticOrder S; S.init(M, DIN, G, (int)blockIdx.x);
            pg8::EpiBf16Store E{(bf16*)(ws + WS_BIG), DIN};
            pg8::gemm_phase<pg8::EpiBf16Store, pg8::StaticOrder, true, true>(lds, lds + RING_BYTES, g, S, E);
        }
        SEAM(pb + 0);
        if (IN(pb + 1)) { PHASE_IDS for (int it = gw; it < NCHUNK * NH * 2; it += NGW) scan_summary_item(args, l, it, lane); }
        SEAM(pb + 1);
        if (IN(pb + 2)) {
            PHASE_IDS
            LAS float* hf = (LAS float*)(lds + wave * 16384);
            for (int it = gw; it < NCHUNK * NH + NCHUNK * 4; it += NGW) { if (it < NCHUNK * NH) mixb_item(args, l, it, lane, hf); else mixa_item(args, l, it - NCHUNK * NH, lane); }
        }
        SEAM(pb + 2);
        if (IN(pb + 3)) {
            pg8::Gemm g{(const bf16*)(ws + WS_A), (const bf16*)((const unsigned char*)wl + W_OUT_OFF), M, D, D}; pg8::StaticOrder S; S.init(M, D, G, (int)blockIdx.x);
            pg8::EpiF32Store E{(float*)(ws + WS_Y), D};
            pg8::gemm_phase<pg8::EpiF32Store, pg8::StaticOrder, true, true>(lds, lds + RING_BYTES, g, S, E);
        }
        SEAM(pb + 3);
        if (IN(pb + 4)) { PHASE_IDS resnorm_rows<true, true>(args, gw, NGW, lane, args.out, args.out + (size_t)M_CTX * D, (const float*)(ws + WS_Y), l, 2, l); }
        SEAM(pb + 4);
        for (int k = 0; k < 9; ++k) {
            if (IN(pb + 5 + 2 * k)) {
                pg8::Gemm g{(const bf16*)(ws + WS_A) + (size_t)k * 4096 * D, (const bf16*)((const unsigned char*)wl + W_UP_OFF), 4096, NUP, D}; pg8::StaticOrder S; S.init(4096, NUP, G, (int)blockIdx.x);
                pg8::EpiBf16Store E{(bf16*)(ws + WS_HPRE), NUP};
                pg8::gemm_phase<pg8::EpiBf16Store, pg8::StaticOrder, true, true>(lds, lds + RING_BYTES, g, S, E);
            }
            SEAM(pb + 5 + 2 * k);
            if (IN(pb + 6 + 2 * k)) { PHASE_IDS for (int it = gw; it < 512 * 12; it += NGW) convgate_item(args, l, k, it, lane); }
            SEAM(pb + 6 + 2 * k);
        }
        if (IN(pb + 23)) {
            pg8::Gemm g{(const bf16*)(ws + WS_BIG), (const bf16*)((const unsigned char*)wl + W_DOWN_OFF), M, D, DFF}; pg8::StaticOrder S; S.init(M, D, G, (int)blockIdx.x);
            pg8::EpiF32Store E{(float*)(ws + WS_Y), D};
            pg8::gemm_phase<pg8::EpiF32Store, pg8::StaticOrder, true, true>(lds, lds + RING_BYTES, g, S, E);
        }
        SEAM(pb + 23);
        if (IN(pb + 24)) {
            PHASE_IDS
            if (l + 1 < DEPTH) resnorm_rows<true, true>(args, gw, NGW, lane, args.out, args.out + (size_t)M_CTX * D, (const float*)(ws + WS_Y), l, 5, l + 1);
            else resnorm_rows<true, false>(args, gw, NGW, lane, args.out, args.out + (size_t)M_CTX * D, (const float*)(ws + WS_Y), l, 5, l);
        }
        if (l + 1 < DEPTH) SEAM(pb + 24);
    }
#undef IN
#undef SEAM
}

extern "C" void kernel_launch(void* const* d_in, const int* in_sizes, int n_in, void* d_out, int out_size, void* d_ws, size_t ws_size, hipStream_t stream) {
    static int grid = 0;
    if (grid == 0) {
        if (n_in != 21 || ws_size < WS_END) { fprintf(stderr, "kernel_launch: expected 21 inputs and >= %zu bytes of workspace; got n_in %d, ws %zu\n", (size_t)WS_END, n_in, ws_size); grid = -1; return; }
        int dev = 0, cus = 0, per_cu = 0;
        if (hipGetDevice(&dev) != hipSuccess || hipDeviceGetAttribute(&cus, hipDeviceAttributeMultiprocessorCount, dev) != hipSuccess) { grid = -1; return; }
        if (hipFuncSetAttribute((const void*)fwd_kernel, hipFuncAttributeMaxDynamicSharedMemorySize, LDS_BYTES) != hipSuccess) { fprintf(stderr, "kernel_launch: hipFuncSetAttribute failed\n"); grid = -1; return; }
        if (hipOccupancyMaxActiveBlocksPerMultiprocessor(&per_cu, (const void*)fwd_kernel, NWAVES * 64, LDS_BYTES) != hipSuccess || per_cu < 1) { fprintf(stderr, "kernel_launch: occupancy query reports %d blocks per CU\n", per_cu); }
        (void)hipGetLastError();
        grid = cus;
    }
    if (grid < 0) return;
    (void)hipMemsetAsync((char*)d_ws + WS_CTL, 0, CTL_ZERO_BYTES, stream);
    Args a{};
    for (int i = 0; i < 21; ++i) a.in[i] = (const float*)d_in[i];
    a.out = (float*)d_out; a.ws = (unsigned char*)d_ws;
#if MK_SINGLE
    a.ph_lo = 0; a.ph_hi = N_PHASES;
    hipLaunchKernelGGL(fwd_kernel, dim3(grid), dim3(NWAVES * 64), LDS_BYTES, stream, a);
#else
    for (int p = 0; p < N_PHASES; ++p) { a.ph_lo = p; a.ph_hi = p + 1; hipLaunchKernelGGL(fwd_kernel, dim3(grid), dim3(NWAVES * 64), LDS_BYTES, stream, a); }
#endif
}
```

```cpp
#include <hip/hip_runtime.h>
#include <cstdio>
#include <cstdint>

#ifndef MK_SINGLE
#define MK_SINGLE 1
#endif

namespace pg8 {
#define PG8_LAS __attribute__((address_space(3)))
typedef unsigned short bf16_t;
typedef short bf16x8 __attribute__((ext_vector_type(8)));
typedef float f32x4 __attribute__((ext_vector_type(4)));
typedef unsigned u32x4 __attribute__((ext_vector_type(4)));
constexpr int BM = 256, BK = 64, HALF = 128, HTB = HALF * BK * 2, STAGE_BYTES = 8 * HTB, NXCD = 8, WGM = 8;

__host__ __device__ __forceinline__ int lds_byte(int r, int c) { const int st = (r >> 4) * 2 + (c >> 5), rr = r & 15, cc = c & 31, ob = rr * 64 + cc * 2; return st * 1024 + (ob ^ (((ob >> 9) & 1) << 5)); }
__host__ __device__ __forceinline__ void stage_rc(int b, int& R, int& C) { const int st = b / 1024, sb = b % 1024, swz = sb ^ (((sb >> 9) & 1) << 5); R = (st >> 1) * 16 + swz / 64; C = (st & 1) * 32 + (swz % 64) / 2; }
__host__ __device__ __forceinline__ int perm32(int rho) { const int n = rho >> 4, i = rho & 15; return 8 * (i >> 2) + 4 * n + (i & 3); }

struct Unit { int pm, pn; };
struct Gemm { const bf16_t* A; const bf16_t* Bt; int M, N, K; };

struct StaticOrder {
    int nM, nN, nwg, G, c;
    __host__ __device__ void init(int M, int N, int G_, int c_) { nM = M / BM; nN = N / BM; nwg = nM * nN; G = G_; c = c_; }
    __host__ __device__ bool next(int i, Unit& u) const {
        const long L = (long)i * G + c; if (L >= nwg) return false;
        int wgid = (int)L; { const int q = nwg / NXCD, r = nwg % NXCD, xcd = wgid % NXCD, off = wgid / NXCD; wgid = (xcd < r ? xcd * (q + 1) : r * (q + 1) + (xcd - r) * q) + off; }
        const int nig = WGM * nN, gid = wgid / nig, fm = gid * WGM, gsz = (nM - fm) < WGM ? (nM - fm) : WGM;
        u.pm = fm + ((wgid % nig) % gsz); u.pn = (wgid % nig) / gsz; return true;
    }
    __device__ __forceinline__ void a_ready(const Unit&) const {}
    __device__ __forceinline__ void done(const Unit&) const {}
};

__device__ __forceinline__ unsigned cvt_pk_bf16(float lo, float hi) { unsigned r; asm volatile("v_cvt_pk_bf16_f32 %0, %1, %2" : "=v"(r) : "v"(lo), "v"(hi)); return r; }

struct EpiBf16Store {
    static constexpr bool PERM = true, AFTER_DRAIN = false;
    bf16_t* O; int ldc;
    __device__ __forceinline__ void operator()(const f32x4 (&acc)[2][2][4][2], const Unit& u, int wr, int wc, int fr, int fq, PG8_LAS unsigned char*) const {
        const int row0 = u.pm * BM + wr * 64 + fr, col0 = u.pn * BM + wc * 32 + 8 * fq;
#pragma unroll
        for (int ai = 0; ai < 2; ++ai)
#pragma unroll
            for (int m = 0; m < 4; ++m) { bf16_t* rowp = O + (size_t)(row0 + ai * HALF + m * 16) * ldc + col0;
#pragma unroll
                for (int bj = 0; bj < 2; ++bj) { const f32x4 v0 = acc[ai][bj][m][0], v1 = acc[ai][bj][m][1];
                    u32x4 w; w.x = cvt_pk_bf16(v0[0], v0[1]); w.y = cvt_pk_bf16(v0[2], v0[3]); w.z = cvt_pk_bf16(v1[0], v1[1]); w.w = cvt_pk_bf16(v1[2], v1[3]);
                    *(u32x4*)(rowp + bj * HALF) = w; } }
    }
};
struct EpiF32Store {
    static constexpr bool PERM = false, AFTER_DRAIN = false;
    float* C; int ldc;
    __device__ __forceinline__ void operator()(const f32x4 (&acc)[2][2][4][2], const Unit& u, int wr, int wc, int fr, int fq, PG8_LAS unsigned char*) const {
        const int row0 = u.pm * BM + wr * 64 + fr, col0 = u.pn * BM + wc * 32 + 4 * fq;
#pragma unroll
        for (int ai = 0; ai < 2; ++ai)
#pragma unroll
            for (int m = 0; m < 4; ++m) { float* rowp = C + (size_t)(row0 + ai * HALF + m * 16) * ldc + col0;
#pragma unroll
                for (int bj = 0; bj < 2; ++bj)
#pragma unroll
                    for (int n = 0; n < 2; ++n) *(f32x4*)(rowp + bj * HALF + n * 16) = acc[ai][bj][m][n]; }
    }
};

template <class Epi, class Sched, bool ALIGN_EPI = false, bool SP2 = false>
__device__ __forceinline__ void gemm_phase(PG8_LAS unsigned char* lds, PG8_LAS unsigned char* xlds, const Gemm g, const Sched& S, const Epi& E) {
    int tid = threadIdx.x; asm volatile("" : "+v"(tid));
    const int wid = __builtin_amdgcn_readfirstlane(tid >> 6), lane = tid & 63, wr = wid >> 2, wc = wid & 3, fr = lane & 15, fq = lane >> 4;
    const int K = g.K, nt = K / BK;
    unsigned voffA[2], voffB[2];
#pragma unroll
    for (int i = 0; i < 2; ++i) { int R, C; stage_rc(tid * 16 + i * 8192, R, C); const int Rb = Epi::PERM ? ((R & ~31) + perm32(R & 31)) : R;
        voffA[i] = (unsigned)(R * K + C) * 2u; voffB[i] = (unsigned)(Rb * K + C) * 2u; }
    const size_t kstep = (size_t)(BK * 2);
    const size_t hstep = (size_t)HALF * K * 2;
    const size_t tstep = 2 * hstep;
    const unsigned ldsw = (unsigned)wid * 1024u;
    const int aoff = lds_byte(wr * 64 + fr, fq * 8), boff = lds_byte(wc * 32 + fr, fq * 8);
#define PG8_SA(b, h) (((b) * 2 + (h)) * HTB)
#define PG8_SB(b, h) ((4 + (b) * 2 + (h)) * HTB)
#define PG8_STAGE(bufoff, gbase, voff) do { _Pragma("unroll") for (int _i = 0; _i < 2; ++_i) \
        __builtin_amdgcn_global_load_lds((const unsigned*)((const char*)(gbase) + (voff)[_i]), (PG8_LAS unsigned*)(lds + (bufoff) + ldsw + _i * 8192), 16, 0, 0); } while (0)
#define PG8_LDA(dst, b, h) do { _Pragma("unroll") for (int m = 0; m < 4; ++m) _Pragma("unroll") for (int k = 0; k < 2; ++k) dst[m][k] = *(const PG8_LAS bf16x8*)(lds + PG8_SA(b, h) + aoff + m * 2048 + k * 1024); } while (0)
#define PG8_LDB(dst, b, h) do { _Pragma("unroll") for (int n = 0; n < 2; ++n) _Pragma("unroll") for (int k = 0; k < 2; ++k) dst[n][k] = *(const PG8_LAS bf16x8*)(lds + PG8_SB(b, h) + boff + n * 2048 + k * 1024); } while (0)
#define PG8_MMA(ai, bj, At, Bt) do { __builtin_amdgcn_s_setprio(1); _Pragma("unroll") for (int m = 0; m < 4; ++m) _Pragma("unroll") for (int n = 0; n < 2; ++n) _Pragma("unroll") for (int k = 0; k < 2; ++k) \
        acc[ai][bj][m][n] = __builtin_amdgcn_mfma_f32_16x16x32_bf16(Bt[n][k], At[m][k], acc[ai][bj][m][n], 0, 0, 0); __builtin_amdgcn_s_setprio(0); } while (0)
#define PG8_WAIT_V(n) asm volatile("s_waitcnt vmcnt(" #n ")" ::: "memory")
#define PG8_WAIT_L(n) asm volatile("s_waitcnt lgkmcnt(" #n ")" ::: "memory")
#define PG8_BAR __builtin_amdgcn_s_barrier()
#define PG8_SCHED __builtin_amdgcn_sched_barrier(0)
    Unit cur, nxt; int ui = 0;
    if (!S.next(0, cur)) return;
    f32x4 acc[2][2][4][2];
#pragma unroll
    for (int a = 0; a < 2; ++a)
#pragma unroll
        for (int b = 0; b < 2; ++b)
#pragma unroll
            for (int m = 0; m < 4; ++m)
#pragma unroll
                for (int n = 0; n < 2; ++n) acc[a][b][m][n] = (f32x4){0.f, 0.f, 0.f, 0.f};
    bf16x8 At[4][2], B0[2][2], B1[2][2];
    const char* cA = (const char*)g.A + (size_t)cur.pm * tstep; const char* cB = (const char*)g.Bt + (size_t)cur.pn * tstep;
    S.a_ready(cur);
    if constexpr (SP2) {
        PG8_STAGE(PG8_SB(0, 0), cB, voffB); PG8_STAGE(PG8_SB(0, 1), cB + hstep, voffB); PG8_STAGE(PG8_SA(0, 0), cA, voffA); PG8_STAGE(PG8_SA(0, 1), cA + hstep, voffA);
        if (wr == 1) PG8_BAR;
        PG8_WAIT_V(2); PG8_BAR;
        PG8_STAGE(PG8_SB(1, 0), cB + kstep, voffB); PG8_STAGE(PG8_SA(1, 0), cA + kstep, voffA); PG8_STAGE(PG8_SB(1, 1), cB + hstep + kstep, voffB);
        PG8_WAIT_V(6); PG8_BAR;
    } else {
        PG8_STAGE(PG8_SB(0, 0), cB, voffB); PG8_STAGE(PG8_SA(0, 0), cA, voffA); PG8_STAGE(PG8_SB(0, 1), cB + hstep, voffB); PG8_STAGE(PG8_SA(0, 1), cA + hstep, voffA);
        if (wr == 1) PG8_BAR;
        PG8_WAIT_V(4); PG8_BAR;
        PG8_STAGE(PG8_SB(1, 0), cB + kstep, voffB); PG8_STAGE(PG8_SA(1, 0), cA + kstep, voffA); PG8_STAGE(PG8_SB(1, 1), cB + hstep + kstep, voffB);
        PG8_WAIT_V(6); PG8_BAR;
    }
    for (;;) {
        const bool has_next = S.next(ui + 1, nxt);
        const char* nA = has_next ? (const char*)g.A + (size_t)nxt.pm * tstep : cA; const char* nB = has_next ? (const char*)g.Bt + (size_t)nxt.pn * tstep : cB;
        for (int t = 0; t < nt; t += 2) {
            const bool last = (t == nt - 2);
            const char* a1 = cA + (size_t)(t + 1) * kstep;
            const char* a2 = last ? nA : cA + (size_t)(t + 2) * kstep; const char* b2 = last ? nB : cB + (size_t)(t + 2) * kstep;
            const char* a3 = a2 + kstep; const char* b3 = b2 + kstep;
            if (last && has_next) S.a_ready(nxt);
            if constexpr (SP2) {
            PG8_LDB(B0, 0, 0); PG8_LDB(B1, 0, 1); PG8_SCHED; PG8_LDA(At, 0, 0); PG8_STAGE(PG8_SA(1, 1), a1 + hstep, voffA);
            PG8_WAIT_V(8); PG8_WAIT_L(0); PG8_BAR; PG8_MMA(0, 0, At, B0); PG8_MMA(0, 1, At, B1); PG8_BAR; PG8_SCHED;
            PG8_LDA(At, 0, 1); PG8_STAGE(PG8_SB(0, 0), b2, voffB); PG8_STAGE(PG8_SB(0, 1), b2 + hstep, voffB); PG8_STAGE(PG8_SA(0, 0), a2, voffA);
            PG8_WAIT_V(8); PG8_WAIT_L(0); PG8_BAR; PG8_MMA(1, 0, At, B0); PG8_MMA(1, 1, At, B1); PG8_BAR; PG8_SCHED;
            PG8_LDB(B0, 1, 0); PG8_LDB(B1, 1, 1); PG8_SCHED; PG8_LDA(At, 1, 0); PG8_STAGE(PG8_SA(0, 1), a2 + hstep, voffA);
            PG8_WAIT_V(8); PG8_WAIT_L(0); PG8_BAR; PG8_MMA(0, 0, At, B0); PG8_MMA(0, 1, At, B1); PG8_BAR; PG8_SCHED;
            PG8_LDA(At, 1, 1); PG8_STAGE(PG8_SB(1, 0), b3, voffB); PG8_STAGE(PG8_SB(1, 1), b3 + hstep, voffB); PG8_STAGE(PG8_SA(1, 0), a3, voffA);
            PG8_WAIT_V(8); PG8_WAIT_L(0); PG8_BAR; PG8_MMA(1, 0, At, B0); PG8_MMA(1, 1, At, B1); PG8_BAR; PG8_SCHED;
            } else {
            PG8_LDB(B0, 0, 0); PG8_SCHED; PG8_LDA(At, 0, 0); PG8_STAGE(PG8_SA(1, 1), a1 + hstep, voffA);
            PG8_WAIT_L(8); PG8_BAR; PG8_WAIT_L(0); PG8_MMA(0, 0, At, B0); PG8_BAR; PG8_SCHED;
            PG8_LDB(B1, 0, 1); PG8_STAGE(PG8_SB(0, 0), b2, voffB);
            PG8_BAR; PG8_WAIT_L(0); PG8_MMA(0, 1, At, B1); PG8_BAR;
            PG8_LDA(At, 0, 1); PG8_STAGE(PG8_SA(0, 0), a2, voffA);
            PG8_BAR; PG8_WAIT_L(0); PG8_MMA(1, 0, At, B0); PG8_BAR; PG8_SCHED;
            PG8_STAGE(PG8_SB(0, 1), b2 + hstep, voffB);
            PG8_WAIT_V(6); PG8_BAR; PG8_MMA(1, 1, At, B1); PG8_BAR;
            PG8_LDB(B0, 1, 0); PG8_SCHED; PG8_LDA(At, 1, 0); PG8_STAGE(PG8_SA(0, 1), a2 + hstep, voffA);
            PG8_WAIT_L(8); PG8_BAR; PG8_WAIT_L(0); PG8_MMA(0, 0, At, B0); PG8_BAR; PG8_SCHED;
            PG8_LDB(B1, 1, 1); PG8_STAGE(PG8_SB(1, 0), b3, voffB);
            PG8_BAR; PG8_WAIT_L(0); PG8_MMA(0, 1, At, B1); PG8_BAR;
            PG8_LDA(At, 1, 1); PG8_STAGE(PG8_SA(1, 0), a3, voffA);
            PG8_BAR; PG8_WAIT_L(0); PG8_MMA(1, 0, At, B0); PG8_BAR; PG8_SCHED;
            PG8_STAGE(PG8_SB(1, 1), b3 + hstep, voffB);
            PG8_WAIT_V(6); PG8_BAR; PG8_MMA(1, 1, At, B1); PG8_BAR;
            }
        }
        if constexpr (ALIGN_EPI) { if (wr == 0) PG8_BAR; }
        if constexpr (!Epi::AFTER_DRAIN) { E(acc, cur, wr, wc, fr, fq, xlds); S.done(cur); }
        if (!has_next) break;
#pragma unroll
        for (int a = 0; a < 2; ++a)
#pragma unroll
            for (int b = 0; b < 2; ++b)
#pragma unroll
                for (int m = 0; m < 4; ++m)
#pragma unroll
                    for (int n = 0; n < 2; ++n) acc[a][b][m][n] = (f32x4){0.f, 0.f, 0.f, 0.f};
        cur = nxt; cA = nA; cB = nB; ++ui;
        if constexpr (ALIGN_EPI) { if (wr == 1) PG8_BAR; }
    }
    PG8_WAIT_V(0);
    if constexpr (!ALIGN_EPI) { if (wr == 0) PG8_BAR; }
    PG8_BAR;
#undef PG8_SA
#undef PG8_SB
#undef PG8_STAGE
#undef PG8_LDA
#undef PG8_LDB
#undef PG8_MMA
#undef PG8_WAIT_V
#undef PG8_WAIT_L
#undef PG8_BAR
#undef PG8_SCHED
}
}

constexpr int NWAVES = 8;
constexpr int D = 2048, DEPTH = 4;
constexpr int NB_CTX = 16, L_CTX = 256, NB_LAT = 8, L_LAT = 4096;
constexpr int M_CTX = NB_CTX * L_CTX, M_LAT = NB_LAT * L_LAT, M = M_CTX + M_LAT;
constexpr int DCONV = 1024, DRNN = 1024, NH = 16, HD = 64, DIN = 5120, DFF = 6144, NUP = 12288;
constexpr int NVEC = 9;
constexpr int NMODC = 6 * D;
constexpr float EPS = 1e-6f;
constexpr int NCHUNK = M / 64;

constexpr size_t MiB = 1u << 20;
constexpr size_t WS_CTL = 0, CTL_ZERO_BYTES = 64 * 1024;
constexpr size_t WS_MODV = 1 * MiB;
constexpr size_t WS_SUMM = 3 * MiB;
constexpr size_t WS_W = 48 * MiB;
constexpr size_t W_LAYER = 100 * MiB, W_IN_OFF = 0, W_OUT_OFF = 20 * MiB, W_UP_OFF = 28 * MiB, W_DOWN_OFF = 76 * MiB;
constexpr size_t WS_A = 448 * MiB;
constexpr size_t WS_BIG = 592 * MiB;
constexpr size_t WS_Y = 1024 * MiB;
constexpr size_t WS_HPRE = 1312 * MiB;
constexpr size_t WS_END = 1408 * MiB;
constexpr int CW_BAR = 1024;

constexpr int RING_BYTES = 131072;
constexpr int MISC_OFF = RING_BYTES + 8192 + 512;
constexpr int LDS_BYTES = 147456;

#define GAS __attribute__((address_space(1)))
#define LAS __attribute__((address_space(3)))
typedef unsigned short bf16;
typedef unsigned v4u __attribute__((ext_vector_type(4)));
typedef unsigned v2u __attribute__((ext_vector_type(2)));
typedef float f32x4 __attribute__((ext_vector_type(4)));
typedef float f32x2 __attribute__((ext_vector_type(2)));
#define LDS_WAIT() asm volatile("s_waitcnt lgkmcnt(0)" ::: "memory")
__device__ __forceinline__ unsigned f2bf(float f) { unsigned u = __builtin_bit_cast(unsigned, f); return (u + 0x7fffu + ((u >> 16) & 1u)) >> 16; }
__device__ __forceinline__ unsigned pk2(float lo, float hi) { return f2bf(lo) | (f2bf(hi) << 16); }
__device__ __forceinline__ float bf2f(unsigned short b) { return __builtin_bit_cast(float, ((unsigned)b) << 16); }
__device__ __forceinline__ float bflo(unsigned w) { return __builtin_bit_cast(float, w << 16); }
__device__ __forceinline__ float bfhi(unsigned w) { return __builtin_bit_cast(float, w & 0xffff0000u); }
__device__ __forceinline__ float sigmoidf_(float x) { return 1.f / (1.f + __expf(-x)); }
__device__ __forceinline__ float gelu_tanh(float x) { const float u = 1.5957691216057308f * (x + 0.044715f * x * x * x); return x / (1.f + __expf(-u)); }
__device__ __forceinline__ float wave_sum(float v) {
#pragma unroll
    for (int o = 1; o < 64; o <<= 1) v += __shfl_xor(v, o);
    return v;
}

#define XB_TMO      128
#define XB_XCNT(j)  (256  + 64 * (j))
#define XB_XSUB(j)  (1280 + 64 * (j))
#define XB_XGEN(j)  (2304 + 64 * (j))
#define XB_TOP      3328
#define XB_TOPGEN   3392
#define XCD_BAR_WORDS 3456
#define XB_SPIN_CAP (1u << 18)
__device__ __forceinline__ unsigned xb_ld(unsigned* p)              { return __hip_atomic_load(p, __ATOMIC_RELAXED, __HIP_MEMORY_SCOPE_AGENT); }
__device__ __forceinline__ unsigned xb_add(unsigned* p, unsigned v) { return __hip_atomic_fetch_add(p, v, __ATOMIC_RELAXED, __HIP_MEMORY_SCOPE_AGENT); }
__device__ __forceinline__ unsigned xb_xcc_id() { return (unsigned)__builtin_amdgcn_s_getreg((3 << 11) | 20) & 0xFu; }
#define XB_SPIN(cond, bar) do { unsigned _sp = 0; while (cond) { __builtin_amdgcn_s_sleep(1); \
    if ((++_sp & 255u) == 0u) { if (xb_ld(&(bar)[XB_TMO])) break; if (_sp > XB_SPIN_CAP) { atomicAdd(&(bar)[XB_TMO], 1u); break; } } } } while (0)
struct XcdBarrier { unsigned* bar; unsigned x; volatile LAS unsigned* st; };
__device__ __forceinline__ XcdBarrier xcd_barrier_post(unsigned* bar, volatile LAS unsigned* st) {
    XcdBarrier b; b.bar = bar; b.x = xb_xcc_id(); b.st = st;
    if (threadIdx.x == 0) (void)xb_add(&bar[XB_XCNT(b.x)], 1u);
    return b;
}
__device__ __forceinline__ void xcd_barrier_complete(unsigned* bar, unsigned x, unsigned& nloc, unsigned& nx) {
    const unsigned G = gridDim.x * gridDim.y * gridDim.z;
    unsigned sum, cnt, mine, sp = 0u;
    for (;;) {
        sum = 0u; cnt = 0u; mine = 0u;
#pragma unroll
        for (unsigned j = 0; j < 16; ++j) { const unsigned c = xb_ld(&bar[XB_XCNT(j)]); sum += c; cnt += (c > 0u) ? 1u : 0u; mine = (j == x) ? c : mine; }
        if (sum == G) break;
        __builtin_amdgcn_s_sleep(1);
        if ((++sp & 255u) == 0u) { if (xb_ld(&bar[XB_TMO])) break; if (sp > XB_SPIN_CAP) { atomicAdd(&bar[XB_TMO], 1u); break; } }
    }
    nloc = mine > 0u ? mine : 1u; nx = cnt > 0u ? cnt : 1u;
}
__device__ __forceinline__ void xcd_barrier(const XcdBarrier& b) {
    asm volatile("s_waitcnt vmcnt(0)" ::: "memory");
    __syncthreads();
    if (threadIdx.x == 0) {
        unsigned* bar = b.bar;
        __builtin_amdgcn_s_waitcnt(0);
        unsigned nloc = b.st[0], nx = b.st[1];
        if (nloc == 0u) { xcd_barrier_complete(bar, b.x, nloc, nx); b.st[0] = nloc; b.st[1] = nx; }
        const unsigned old = xb_add(&bar[XB_XSUB(b.x)], 1u);
        const unsigned gen = old / nloc;
        if (old + 1u == (gen + 1u) * nloc) {
            __builtin_amdgcn_fence(__ATOMIC_RELEASE, "agent");
            asm volatile("s_waitcnt vmcnt(0)" ::: "memory");
            const unsigned og = xb_add(&bar[XB_TOP], 1u);
            const unsigned tg = og / nx;
            if (og + 1u == (tg + 1u) * nx) xb_add(&bar[XB_TOPGEN], 1u);
            else XB_SPIN(xb_ld(&bar[XB_TOPGEN]) == tg, bar);
            __builtin_amdgcn_fence(__ATOMIC_ACQUIRE, "agent");
            xb_add(&bar[XB_XGEN(b.x)], 1u);
            asm volatile("s_waitcnt vmcnt(0)" ::: "memory");
        } else {
            XB_SPIN(xb_ld(&bar[XB_XGEN(b.x)]) == gen, bar);
            __builtin_amdgcn_fence(__ATOMIC_ACQUIRE, "agent");
            asm volatile("s_waitcnt vmcnt(0)" ::: "memory");
        }
    }
    __syncthreads();
}

struct Args {
    const float* in[21];
    float* out; unsigned char* ws;
    int ph_lo, ph_hi;
};
enum { I_XP = 0, I_XS, I_STATE, I_C, I_CCTX, I_WADA, I_BADA, I_NORMG, I_WIN, I_CONVA, I_RCW, I_RCB, I_RWA, I_RBA, I_RWX, I_RBX, I_RLAM, I_WOUT, I_FUP, I_FCW, I_FDOWN };

__device__ __forceinline__ void transpose_item(const float* W, int K, int N, bf16* WT, int k0, int n0, int dst_row0, LAS float* scr, int lane) {
#pragma unroll 8
    for (int i = 0; i < 32; ++i) { const int kk = 2 * i + (lane >> 5); scr[kk * 33 + (lane & 31)] = W[(size_t)(k0 + kk) * N + n0 + (lane & 31)]; }
    LDS_WAIT(); asm volatile("" ::: "memory");
    const int c = lane & 7;
#pragma unroll
    for (int j = 0; j < 4; ++j) { const int n = (lane >> 3) + 8 * j; const LAS float* s = scr + (8 * c) * 33 + n;
        v4u o; o.x = pk2(s[0 * 33], s[1 * 33]); o.y = pk2(s[2 * 33], s[3 * 33]); o.z = pk2(s[4 * 33], s[5 * 33]); o.w = pk2(s[6 * 33], s[7 * 33]);
        *(GAS v4u*)(WT + (size_t)(dst_row0 + n) * K + k0 + 8 * c) = o; }
    LDS_WAIT(); asm volatile("" ::: "memory");
}
constexpr int TI_IN = (D / 64) * (DIN / 32), TI_OUT = (D / 64) * (D / 32), TI_UP = (D / 64) * (NUP / 32), TI_DOWN = (DFF / 64) * (D / 32);
constexpr int TI_LAYER = TI_IN + TI_OUT + TI_UP + TI_DOWN;

__device__ __forceinline__ void pre_transposes(const Args& a, LAS unsigned char* lds, int gw, int NGW, int wave, int lane) {
    LAS float* scr = (LAS float*)(lds + wave * 16384);
    for (int it = gw; it < DEPTH * TI_LAYER; it += NGW) {
        const int l = it / TI_LAYER; int r = it % TI_LAYER;
        bf16* wl = (bf16*)(a.ws + WS_W + (size_t)l * W_LAYER);
        if (r < TI_IN) { const int nblk = DIN / 32, kb = r / nblk, nb = r % nblk;
            transpose_item(a.in[I_WIN] + (size_t)l * D * DIN, D, DIN, (bf16*)((unsigned char*)wl + W_IN_OFF), 64 * kb, 32 * nb, 32 * nb, scr, lane); continue; }
        r -= TI_IN;
        if (r < TI_OUT) { const int nblk = D / 32, kb = r / nblk, nb = r % nblk;
            transpose_item(a.in[I_WOUT] + (size_t)l * D * D, D, D, (bf16*)((unsigned char*)wl + W_OUT_OFF), 64 * kb, 32 * nb, 32 * nb, scr, lane); continue; }
        r -= TI_OUT;
        if (r < TI_UP) { const int nblk = NUP / 32, kb = r / nblk, nb = r % nblk; const int n0 = 32 * nb;
            const int dst = (n0 < DFF) ? ((n0 >> 7) * 256 + (n0 & 127)) : ((((n0 - DFF) >> 7) * 256) + 128 + ((n0 - DFF) & 127));
            transpose_item(a.in[I_FUP] + (size_t)l * D * NUP, D, NUP, (bf16*)((unsigned char*)wl + W_UP_OFF), 64 * kb, n0, dst, scr, lane); continue; }
        r -= TI_UP;
        { const int nblk = D / 32, kb = r / nblk, nb = r % nblk;
            transpose_item(a.in[I_FDOWN] + (size_t)l * DFF * D, DFF, D, (bf16*)((unsigned char*)wl + W_DOWN_OFF), 64 * kb, 32 * nb, 32 * nb, scr, lane); }
    }
}

__device__ __forceinline__ void pre_mod(const Args& a, LAS unsigned char* lds, int tid, int wave, int lane) {
    LAS float* s = (LAS float*)lds;
    LAS float* red = s + NVEC * D;
    for (int i = tid; i < NVEC * D; i += NWAVES * 64) { const int v = i / D, k = i % D; const float c = (v == 0) ? a.in[I_CCTX][k] : a.in[I_C][(v - 1) * D + k]; s[i] = c / (1.f + __expf(-c)); }
    __syncthreads();
    float* modv = (float*)(a.ws + WS_MODV);
    const int cl = tid & 15, ks = tid >> 4;
    for (int item = blockIdx.x; item < DEPTH * (NMODC / 64); item += gridDim.x) {
        const int l = item / (NMODC / 64), n0 = (item % (NMODC / 64)) * 64;
        float acc[NVEC][4];
#pragma unroll
        for (int v = 0; v < NVEC; ++v) { acc[v][0] = 0.f; acc[v][1] = 0.f; acc[v][2] = 0.f; acc[v][3] = 0.f; }
        const float* wp = a.in[I_WADA] + ((size_t)l * D + ks * 64) * NMODC + n0 + 4 * cl;
        const LAS float* sp = s + ks * 64;
#pragma unroll 8
        for (int kk = 0; kk < 64; ++kk) {
            const f32x4 w = *(const f32x4*)(wp + (size_t)kk * NMODC);
#pragma unroll
            for (int v = 0; v < NVEC; ++v) { const float sv = sp[v * D + kk]; acc[v][0] += sv * w[0]; acc[v][1] += sv * w[1]; acc[v][2] += sv * w[2]; acc[v][3] += sv * w[3]; }
        }
#pragma unroll
        for (int v = 0; v < NVEC; ++v)
#pragma unroll
            for (int e = 0; e < 4; ++e) { float t = acc[v][e]; t += __shfl_xor(t, 16); t += __shfl_xor(t, 32); if (lane < 16) red[(wave * 16 + cl) * 36 + v * 4 + e] = t; }
        __syncthreads();
        for (int o = tid; o < NVEC * 64; o += NWAVES * 64) {
            const int v = o >> 6, col = o & 63;
            float sum = 0.f;
#pragma unroll
            for (int w = 0; w < NWAVES; ++w) sum += red[(w * 16 + (col >> 2)) * 36 + v * 4 + (col & 3)];
            const int n = n0 + col, q = n / D, j = n % D;
            const float val = sum + a.in[I_BADA][l * NMODC + n];
            const float* ng = a.in[I_NORMG] + (size_t)l * 4 * D;
            int slot; float r;
            if (q == 0) { slot = 1; r = val; }
            else if (q == 1) { slot = 0; r = ng[0 * D + j] * (1.f + val); }
            else if (q == 2) { slot = 2; r = val * ng[1 * D + j]; }
            else if (q == 3) { slot = 4; r = val; }
            else if (q == 4) { slot = 3; r = ng[2 * D + j] * (1.f + val); }
            else { slot = 5; r = val * ng[3 * D + j]; }
            modv[((size_t)(l * NVEC + v) * 6 + slot) * D + j] = r;
        }
        __syncthreads();
    }
}

template <bool HAS_RES, bool HAS_U>
__device__ __forceinline__ void resnorm_rows(const Args& a, int gw, int NGW, int lane, const float* xsrc_ctx, const float* xsrc_lat, const float* y, int l_res, int slot_res, int l_u) {
    const float* modv = (const float*)(a.ws + WS_MODV);
    bf16* U = (bf16*)(a.ws + WS_A);
    for (int m = gw; m < M; m += NGW) {
        const int v = (m < M_CTX) ? 0 : 1 + ((m - M_CTX) >> 12);
        const float* xs = (m < M_CTX) ? xsrc_ctx + (size_t)m * D : xsrc_lat + (size_t)(m - M_CTX) * D;
        const GAS f32x4* xr = (const GAS f32x4*)xs + lane;
        f32x4 xv[8];
#pragma unroll
        for (int j = 0; j < 8; ++j) xv[j] = xr[64 * j];
        if (HAS_RES) {
            const GAS f32x4* yr = (const GAS f32x4*)(y + (size_t)m * D) + lane;
            const GAS f32x4* gr = (const GAS f32x4*)(modv + ((size_t)(l_res * NVEC + v) * 6 + slot_res) * D) + lane;
            f32x4 yv[8]; float ss = 0.f;
#pragma unroll
            for (int j = 0; j < 8; ++j) { yv[j] = yr[64 * j]; ss += (yv[j].x * yv[j].x + yv[j].y * yv[j].y) + (yv[j].z * yv[j].z + yv[j].w * yv[j].w); }
            const float rstd = 1.f / sqrtf(wave_sum(ss) * (1.f / D) + EPS);
#pragma unroll
            for (int j = 0; j < 8; ++j) { const f32x4 g = gr[64 * j]; xv[j] = xv[j] + g * yv[j] * rstd; }
        }
        GAS f32x4* xo = (GAS f32x4*)(a.out + (size_t)m * D) + lane;
#pragma unroll
        for (int j = 0; j < 8; ++j) xo[64 * j] = xv[j];
        if (HAS_U) {
            float ss = 0.f;
#pragma unroll
            for (int j = 0; j < 8; ++j) ss += (xv[j].x * xv[j].x + xv[j].y * xv[j].y) + (xv[j].z * xv[j].z + xv[j].w * xv[j].w);
            const float rstd = 1.f / sqrtf(wave_sum(ss) * (1.f / D) + EPS);
            const GAS f32x4* gn = (const GAS f32x4*)(modv + ((size_t)(l_u * NVEC + v) * 6 + (l_u == l_res && HAS_RES ? 3 : 0)) * D) + lane;
            const GAS f32x4* bn = (const GAS f32x4*)(modv + ((size_t)(l_u * NVEC + v) * 6 + (l_u == l_res && HAS_RES ? 4 : 1)) * D) + lane;
            GAS v2u* uo = (GAS v2u*)(U + (size_t)m * D) + lane;
#pragma unroll
            for (int j = 0; j < 8; ++j) { const f32x4 g = gn[64 * j], b = bn[64 * j]; const f32x4 t = xv[j] * rstd * g + b; v2u o; o.x = pk2(t.x, t.y); o.y = pk2(t.z, t.w); uo[64 * j] = o; }
        }
    }
}

struct SeqInfo { int base, L, s0, b, cfirst, clast; bool col, ctx; };
__device__ __forceinline__ SeqInfo seq_info(int c, int layer) {
    SeqInfo q;
    if (c < 64) { q.b = c >> 2; q.s0 = (c & 3) * 64; q.L = L_CTX; q.base = q.b * L_CTX; q.col = false; q.ctx = true; q.cfirst = c & ~3; q.clast = q.cfirst + 3; }
    else { const int cc = c - 64; q.b = cc >> 6; q.s0 = (cc & 63) * 64; q.L = L_LAT; q.base = M_CTX + q.b * L_LAT; q.col = (layer & 1) != 0; q.ctx = false; q.cfirst = 64 + (cc & ~63); q.clast = q.cfirst + 63; }
    return q;
}
__device__ __forceinline__ int tok_of(const SeqInfo& q, int s) { return q.base + (q.col ? (((s & 63) << 6) | (s >> 6)) : s); }

__device__ __forceinline__ void gate_step(float xc, const float (&Wa)[64], const float (&Wx)[64], float ba, float bx, float c8, float& a, float& v) {
    float r = ba, g = bx;
    const int xci = __builtin_bit_cast(int, xc);
#pragma unroll
    for (int i = 0; i < 64; ++i) { const float s = __builtin_bit_cast(float, __builtin_amdgcn_readlane(xci, i)); r = fmaf(s, Wa[i], r); g = fmaf(s, Wx[i], g); }
    r = sigmoidf_(r); g = sigmoidf_(g);
    const float la = c8 * r;
    a = __expf(la);
    const float mlt = sqrtf(fmaxf(0.f, -expm1f(2.f * la)));
    v = mlt * g * xc;
}

struct DirParams { float ba, bx, c8, cw0, cw1, cw2, cw3, cb; };
__device__ __forceinline__ void load_dir(const Args& a, int layer, int d, int h, int lane, float (&Wa)[64], float (&Wx)[64], DirParams& p) {
    const int ld = layer * 2 + d, ch = h * 64 + lane;
    const float* wa = a.in[I_RWA] + ((size_t)(ld * NH + h) * 64) * 64 + lane;
    const float* wx = a.in[I_RWX] + ((size_t)(ld * NH + h) * 64) * 64 + lane;
#pragma unroll
    for (int i = 0; i < 64; ++i) { Wa[i] = wa[i * 64]; Wx[i] = wx[i * 64]; }
    p.ba = a.in[I_RBA][ld * DRNN + ch]; p.bx = a.in[I_RBX][ld * DRNN + ch];
    const float lam = a.in[I_RLAM][ld * DRNN + ch];
    p.c8 = -8.f * log1pf(__expf(-lam));
    p.cw0 = a.in[I_RCW][(ld * 4 + 0) * DRNN + ch]; p.cw1 = a.in[I_RCW][(ld * 4 + 1) * DRNN + ch];
    p.cw2 = a.in[I_RCW][(ld * 4 + 2) * DRNN + ch]; p.cw3 = a.in[I_RCW][(ld * 4 + 3) * DRNN + ch];
    p.cb = a.in[I_RCB][ld * DRNN + ch];
}
__device__ __forceinline__ float load_xr(const bf16* xr, const SeqInfo& q, int d, int qq) {
    const int s = d ? (q.s0 + 63 - qq) : (q.s0 + qq);
    return (s >= 0 && s < q.L) ? bf2f(xr[(size_t)tok_of(q, s) * DIN]) : 0.f;
}

__device__ __forceinline__ void scan_summary_item(const Args& a, int layer, int item, int lane) {
    const int d = item & 1, h = (item >> 1) & 15, c = item >> 5;
    const SeqInfo q = seq_info(c, layer);
    float Wa[64], Wx[64]; DirParams p;
    load_dir(a, layer, d, h, lane, Wa, Wx, p);
    const bf16* xr = (const bf16*)(a.ws + WS_BIG) + 3 * DCONV + h * 64 + lane;
    float x3 = load_xr(xr, q, d, -3), x2 = load_xr(xr, q, d, -2), x1 = load_xr(xr, q, d, -1);
    float n0 = load_xr(xr, q, d, 0), n1 = load_xr(xr, q, d, 1), n2 = load_xr(xr, q, d, 2), n3 = load_xr(xr, q, d, 3);
    float hh = 0.f, A = 1.f;
    for (int it = 0; it < 16; ++it) {
        const float c0 = n0, c1 = n1, c2 = n2, c3 = n3;
        if (it < 15) { n0 = load_xr(xr, q, d, 4 * it + 4); n1 = load_xr(xr, q, d, 4 * it + 5); n2 = load_xr(xr, q, d, 4 * it + 6); n3 = load_xr(xr, q, d, 4 * it + 7); }
        float xc, av, vv;
        xc = p.cb + p.cw0 * x3 + p.cw1 * x2 + p.cw2 * x1 + p.cw3 * c0; gate_step(xc, Wa, Wx, p.ba, p.bx, p.c8, av, vv); hh = av * hh + vv; A *= av;
        xc = p.cb + p.cw0 * x2 + p.cw1 * x1 + p.cw2 * c0 + p.cw3 * c1; gate_step(xc, Wa, Wx, p.ba, p.bx, p.c8, av, vv); hh = av * hh + vv; A *= av;
        xc = p.cb + p.cw0 * x1 + p.cw1 * c0 + p.cw2 * c1 + p.cw3 * c2; gate_step(xc, Wa, Wx, p.ba, p.bx, p.c8, av, vv); hh = av * hh + vv; A *= av;
        xc = p.cb + p.cw0 * c0 + p.cw1 * c1 + p.cw2 * c2 + p.cw3 * c3; gate_step(xc, Wa, Wx, p.ba, p.bx, p.c8, av, vv); hh = av * hh + vv; A *= av;
        x3 = c1; x2 = c2; x1 = c3;
    }
    f32x2* summ = (f32x2*)(a.ws + WS_SUMM);
    summ[(size_t)(c * 2 + d) * DRNN + h * 64 + lane] = (f32x2){A, hh};
}

__device__ __forceinline__ float carry_in(const Args& a, const SeqInfo& q, int layer, int c, int d, int ch) {
    const f32x2* summ = (const f32x2*)(a.ws + WS_SUMM);
    float hin = q.ctx ? 0.f : a.in[I_STATE][((size_t)(q.b * DEPTH + layer) * 2 + d) * DRNN + ch];
    const int n = d ? (q.clast - c) : (c - q.cfirst);
    for (int i0 = 0; i0 < n; i0 += 8) {
        f32x2 t[8];
#pragma unroll
        for (int k = 0; k < 8; ++k) { const int i = i0 + k; const int cc = d ? (q.clast - i) : (q.cfirst + i); t[k] = (i < n) ? summ[(size_t)(cc * 2 + d) * DRNN + ch] : (f32x2){1.f, 0.f}; }
#pragma unroll
        for (int k = 0; k < 8; ++k) hin = t[k].x * hin + t[k].y;
    }
    return hin;
}

__device__ __forceinline__ void mixb_item(const Args& a, int layer, int item, int lane, LAS float* hf) {
    const int h = item & 15, c = item >> 4, ch = h * 64 + lane;
    const SeqInfo q = seq_info(c, layer);
    const bf16* proj = (const bf16*)(a.ws + WS_BIG);
    const bf16* xr = proj + 3 * DCONV + ch;
    const bf16* gr = proj + 3 * DCONV + DRNN + ch;
    bf16* ymix = (bf16*)(a.ws + WS_A) + DCONV + ch;
    float* nstate = a.out + (size_t)M * D;
    float Wa[64], Wx[64]; DirParams p;
    {
        load_dir(a, layer, 0, h, lane, Wa, Wx, p);
        float hh = carry_in(a, q, layer, c, 0, ch);
        float x3 = load_xr(xr, q, 0, -3), x2 = load_xr(xr, q, 0, -2), x1 = load_xr(xr, q, 0, -1);
        float n0 = load_xr(xr, q, 0, 0), n1 = load_xr(xr, q, 0, 1), n2 = load_xr(xr, q, 0, 2), n3 = load_xr(xr, q, 0, 3);
        for (int it = 0; it < 16; ++it) {
            const float c0 = n0, c1 = n1, c2 = n2, c3 = n3;
            if (it < 15) { n0 = load_xr(xr, q, 0, 4 * it + 4); n1 = load_xr(xr, q, 0, 4 * it + 5); n2 = load_xr(xr, q, 0, 4 * it + 6); n3 = load_xr(xr, q, 0, 4 * it + 7); }
            float xc, av, vv;
            xc = p.cb + p.cw0 * x3 + p.cw1 * x2 + p.cw2 * x1 + p.cw3 * c0; gate_step(xc, Wa, Wx, p.ba, p.bx, p.c8, av, vv); hh = av * hh + vv; hf[(4 * it + 0) * 64 + lane] = hh;
            xc = p.cb + p.cw0 * x2 + p.cw1 * x1 + p.cw2 * c0 + p.cw3 * c1; gate_step(xc, Wa, Wx, p.ba, p.bx, p.c8, av, vv); hh = av * hh + vv; hf[(4 * it + 1) * 64 + lane] = hh;
            xc = p.cb + p.cw0 * x1 + p.cw1 * c0 + p.cw2 * c1 + p.cw3 * c2; gate_step(xc, Wa, Wx, p.ba, p.bx, p.c8, av, vv); hh = av * hh + vv; hf[(4 * it + 2) * 64 + lane] = hh;
            xc = p.cb + p.cw0 * c0 + p.cw1 * c1 + p.cw2 * c2 + p.cw3 * c3; gate_step(xc, Wa, Wx, p.ba, p.bx, p.c8, av, vv); hh = av * hh + vv; hf[(4 * it + 3) * 64 + lane] = hh;
            x3 = c1; x2 = c2; x1 = c3;
        }
        if (q.ctx && c == q.clast) nstate[((size_t)(q.b * DEPTH + layer) * 2 + 0) * DRNN + ch] = hh;
    }
    {
        load_dir(a, layer, 1, h, lane, Wa, Wx, p);
        float hh = carry_in(a, q, layer, c, 1, ch);
        float x3 = load_xr(xr, q, 1, -3), x2 = load_xr(xr, q, 1, -2), x1 = load_xr(xr, q, 1, -1);
        float n0 = load_xr(xr, q, 1, 0), n1 = load_xr(xr, q, 1, 1), n2 = load_xr(xr, q, 1, 2), n3 = load_xr(xr, q, 1, 3);
        float g0 = load_xr(gr, q, 1, 0), g1 = load_xr(gr, q, 1, 1), g2 = load_xr(gr, q, 1, 2), g3 = load_xr(gr, q, 1, 3);
        for (int it = 0; it < 16; ++it) {
            const float c0 = n0, c1 = n1, c2 = n2, c3 = n3, e0 = g0, e1 = g1, e2 = g2, e3 = g3;
            if (it < 15) { n0 = load_xr(xr, q, 1, 4 * it + 4); n1 = load_xr(xr, q, 1, 4 * it + 5); n2 = load_xr(xr, q, 1, 4 * it + 6); n3 = load_xr(xr, q, 1, 4 * it + 7);
                           g0 = load_xr(gr, q, 1, 4 * it + 4); g1 = load_xr(gr, q, 1, 4 * it + 5); g2 = load_xr(gr, q, 1, 4 * it + 6); g3 = load_xr(gr, q, 1, 4 * it + 7); }
            float xc, av, vv; int qq, s;
            xc = p.cb + p.cw0 * x3 + p.cw1 * x2 + p.cw2 * x1 + p.cw3 * c0; gate_step(xc, Wa, Wx, p.ba, p.bx, p.c8, av, vv); hh = av * hh + vv;
            qq = 4 * it + 0; s = q.s0 + 63 - qq; ymix[(size_t)tok_of(q, s) * D] = (bf16)f2bf((hf[(63 - qq) * 64 + lane] + hh) * gelu_tanh(e0));
            xc = p.cb + p.cw0 * x2 + p.cw1 * x1 + p.cw2 * c0 + p.cw3 * c1; gate_step(xc, Wa, Wx, p.ba, p.bx, p.c8, av, vv); hh = av * hh + vv;
            qq = 4 * it + 1; s = q.s0 + 63 - qq; ymix[(size_t)tok_of(q, s) * D] = (bf16)f2bf((hf[(63 - qq) * 64 + lane] + hh) * gelu_tanh(e1));
            xc = p.cb + p.cw0 * x1 + p.cw1 * c0 + p.cw2 * c1 + p.cw3 * c2; gate_step(xc, Wa, Wx, p.ba, p.bx, p.c8, av, vv); hh = av * hh + vv;
            qq = 4 * it + 2; s = q.s0 + 63 - qq; ymix[(size_t)tok_of(q, s) * D] = (bf16)f2bf((hf[(63 - qq) * 64 + lane] + hh) * gelu_tanh(e2));
            xc = p.cb + p.cw0 * c0 + p.cw1 * c1 + p.cw2 * c2 + p.cw3 * c3; gate_step(xc, Wa, Wx, p.ba, p.bx, p.c8, av, vv); hh = av * hh + vv;
            qq = 4 * it + 3; s = q.s0 + 63 - qq; ymix[(size_t)tok_of(q, s) * D] = (bf16)f2bf((hf[(63 - qq) * 64 + lane] + hh) * gelu_tanh(e3));
            x3 = c1; x2 = c2; x1 = c3;
        }
        if (q.ctx && c == q.cfirst) nstate[((size_t)(q.b * DEPTH + layer) * 2 + 1) * DRNN + ch] = hh;
    }
    LDS_WAIT(); asm volatile("" ::: "memory");
}

__device__ __forceinline__ void mixa_item(const Args& a, int layer, int item, int lane) {
    const int g4 = item & 3, c = item >> 2, ch0 = g4 * 256 + lane * 4;
    const SeqInfo q = seq_info(c, layer);
    const bf16* proj = (const bf16*)(a.ws + WS_BIG);
    bf16* ymix = (bf16*)(a.ws + WS_A);
    const f32x4 w0 = *(const f32x4*)(a.in[I_CONVA] + (size_t)(layer * 3 + 0) * DCONV + ch0);
    const f32x4 w1 = *(const f32x4*)(a.in[I_CONVA] + (size_t)(layer * 3 + 1) * DCONV + ch0);
    const f32x4 w2 = *(const f32x4*)(a.in[I_CONVA] + (size_t)(layer * 3 + 2) * DCONV + ch0);
    auto cx_at = [&](int s) -> f32x4 {
        if (s < 0 || s >= q.L) return (f32x4){0.f, 0.f, 0.f, 0.f};
        const bf16* row = proj + (size_t)tok_of(q, s) * DIN + ch0;
        const v2u cg = *(const v2u*)(row + DCONV), xa = *(const v2u*)(row + 2 * DCONV);
        return (f32x4){bflo(cg.x) * bflo(xa.x), bfhi(cg.x) * bfhi(xa.x), bflo(cg.y) * bflo(xa.y), bfhi(cg.y) * bfhi(xa.y)};
    };
    f32x4 cm = cx_at(q.s0 - 1), cc = cx_at(q.s0);
    for (int blk = 0; blk < 8; ++blk) {
        f32x4 cn[8]; v2u bg[8];
#pragma unroll
        for (int e = 0; e < 8; ++e) { const int s = q.s0 + 8 * blk + e; cn[e] = cx_at(s + 1); bg[e] = *(const v2u*)(proj + (size_t)tok_of(q, s) * DIN + ch0); }
#pragma unroll
        for (int e = 0; e < 8; ++e) {
            const int s = q.s0 + 8 * blk + e;
            const f32x4 hv = w0 * cm + w1 * cc + w2 * cn[e];
            const f32x4 bv = (f32x4){bflo(bg[e].x), bfhi(bg[e].x), bflo(bg[e].y), bfhi(bg[e].y)};
            const f32x4 o = bv * hv;
            v2u ov; ov.x = pk2(o.x, o.y); ov.y = pk2(o.z, o.w);
            *(v2u*)(ymix + (size_t)tok_of(q, s) * D + ch0) = ov;
            cm = cc; cc = cn[e];
        }
    }
}

__device__ __forceinline__ void convgate_item(const Args& a, int layer, int chunk, int item, int lane) {
    const int cgp = item % 12, rb = item / 12, r0 = rb * 8, ch0 = cgp * 512 + lane * 8;
    const int seqlen = (chunk == 0) ? L_CTX : L_LAT;
    const bf16* hp = (const bf16*)(a.ws + WS_HPRE) + (size_t)((ch0 >> 7) * 256 + (ch0 & 127));
    bf16* act = (bf16*)(a.ws + WS_BIG) + (size_t)(chunk * 4096) * DFF + ch0;
    const float* cw = a.in[I_FCW] + (size_t)layer * 3 * NUP;
    float wg[3][8], wv[3][8];
#pragma unroll
    for (int t = 0; t < 3; ++t)
#pragma unroll
        for (int e = 0; e < 8; ++e) { wg[t][e] = cw[t * NUP + ch0 + e]; wv[t][e] = cw[t * NUP + DFF + ch0 + e]; }
    v4u rg[10], rv[10];
#pragma unroll
    for (int i = 0; i < 10; ++i) {
        const int r = r0 - 1 + i;
        const bool ok = (i == 0) ? ((r0 % seqlen) != 0) : (i == 9) ? (((r0 + 8) % seqlen) != 0) : true;
        if (ok) { rg[i] = *(const v4u*)(hp + (size_t)r * NUP); rv[i] = *(const v4u*)(hp + (size_t)r * NUP + 128); }
        else { rg[i] = (v4u){0u, 0u, 0u, 0u}; rv[i] = (v4u){0u, 0u, 0u, 0u}; }
    }
#pragma unroll
    for (int i = 1; i <= 8; ++i) {
        float o[8];
#pragma unroll
        for (int e2 = 0; e2 < 4; ++e2) {
            const unsigned gm = rg[i - 1][e2], gc = rg[i][e2], gn = rg[i + 1][e2], vm = rv[i - 1][e2], vc = rv[i][e2], vn = rv[i + 1][e2];
            const float hg0 = wg[0][2 * e2] * bflo(gm) + wg[1][2 * e2] * bflo(gc) + wg[2][2 * e2] * bflo(gn);
            const float hg1 = wg[0][2 * e2 + 1] * bfhi(gm) + wg[1][2 * e2 + 1] * bfhi(gc) + wg[2][2 * e2 + 1] * bfhi(gn);
            const float hv0 = wv[0][2 * e2] * bflo(vm) + wv[1][2 * e2] * bflo(vc) + wv[2][2 * e2] * bflo(vn);
            const float hv1 = wv[0][2 * e2 + 1] * bfhi(vm) + wv[1][2 * e2 + 1] * bfhi(vc) + wv[2][2 * e2 + 1] * bfhi(vn);
            o[2 * e2] = gelu_tanh(hg0) * hv0; o[2 * e2 + 1] = gelu_tanh(hg1) * hv1;
        }
        v4u ov; ov.x = pk2(o[0], o[1]); ov.y = pk2(o[2], o[3]); ov.z = pk2(o[4], o[5]); ov.w = pk2(o[6], o[7]);
        *(v4u*)(act + (size_t)(r0 + i - 1) * DFF) = ov;
    }
}

constexpr int PH_PRE = 0, PH_NORM0 = 1, PH_LAYER0 = 2, NPL = 25, N_PHASES = PH_LAYER0 + DEPTH * NPL;

__global__ void __launch_bounds__(NWAVES * 64, 2) fwd_kernel(Args args) {
    extern __shared__ __attribute__((aligned(16))) unsigned char lds_raw[];
    LAS unsigned char* lds = (LAS unsigned char*)lds_raw;
    volatile LAS unsigned* MISC = (volatile LAS unsigned*)(lds + MISC_OFF);
    const int G = gridDim.x, NGW = G * NWAVES;
    const int lo = args.ph_lo, hi = args.ph_hi;
#define PHASE_IDS int tid = threadIdx.x; asm volatile("" : "+v"(tid)); const int lane = tid & 63, wave = __builtin_amdgcn_readfirstlane(tid >> 6), gw = blockIdx.x * NWAVES + wave; (void)lane; (void)gw;
    if (threadIdx.x < 32) MISC[threadIdx.x] = 0u;
    __syncthreads();
    XcdBarrier bar; bar.bar = (unsigned*)(args.ws + WS_CTL) + CW_BAR; bar.x = 0; bar.st = nullptr;
    if (hi - lo > 1) bar = xcd_barrier_post((unsigned*)(args.ws + WS_CTL) + CW_BAR, MISC + 8);
#define IN(k) (lo <= (k) && (k) < hi)
#define SEAM(k) do { if (IN(k) && IN((k) + 1)) xcd_barrier(bar); } while (0)
    unsigned char* ws = args.ws;

    if (IN(PH_PRE)) { PHASE_IDS pre_transposes(args, lds, gw, NGW, wave, lane); __syncthreads(); pre_mod(args, lds, tid, wave, lane); }
    SEAM(PH_PRE);
    if (IN(PH_NORM0)) { PHASE_IDS resnorm_rows<false, true>(args, gw, NGW, lane, args.in[I_XP], args.in[I_XS], nullptr, 0, 0, 0); }
    SEAM(PH_NORM0);

    for (int l = 0; l < DEPTH; ++l) {
        const int pb = PH_LAYER0 + l * NPL;
        const bf16* wl = (const bf16*)(ws + WS_W + (size_t)l * W_LAYER);
        if (IN(pb + 0)) {
            pg8::Gemm g{(const bf16*)(ws + WS_A), (const bf16*)((const unsigned char*)wl + W_IN_OFF), M, DIN, D}; pg8::StaticOrder S; S.init(M, DIN, G, (int)blockIdx.x);
            pg8::EpiBf16Store E{(bf16*)(ws + WS_BIG), DIN};
            pg8::gemm_phase<pg8::EpiBf16Store, pg8::StaticOrder, true, true>(lds, lds + RING_BYTES, g, S, E);
        }
        SEAM(pb + 0);
        if (IN(pb + 1)) { PHASE_IDS for (int it = gw; it < NCHUNK * NH * 2; it += NGW) scan_summary_item(args, l, it, lane); }
        SEAM(pb + 1);
        if (IN(pb + 2)) {
            PHASE_IDS
            LAS float* hf = (LAS float*)(lds + wave * 16384);
            for (int it = gw; it < NCHUNK * NH + NCHUNK * 4; it += NGW) { if (it < NCHUNK * NH) mixb_item(args, l, it, lane, hf); else mixa_item(args, l, it - NCHUNK * NH, lane); }
        }
        SEAM(pb + 2);
        if (IN(pb + 3)) {
            pg8::Gemm g{(const bf16*)(ws + WS_A), (const bf16*)((const unsigned char*)wl + W_OUT_OFF), M, D, D}; pg8::StaticOrder S; S.init(M, D, G, (int)blockIdx.x);
            pg8::EpiF32Store E{(float*)(ws + WS_Y), D};
            pg8::gemm_phase<pg8::EpiF32Store, pg8::StaticOrder, true, true>(lds, lds + RING_BYTES, g, S, E);
        }
        SEAM(pb + 3);
        if (IN(pb + 4)) { PHASE_IDS resnorm_rows<true, true>(args, gw, NGW, lane, args.out, args.out + (size_t)M_CTX * D, (const float*)(ws + WS_Y), l, 2, l); }
        SEAM(pb + 4);
        for (int k = 0; k < 9; ++k) {
            if (IN(pb + 5 + 2 * k)) {
                pg8::Gemm g{(const bf16*)(ws + WS_A) + (size_t)k * 4096 * D, (const bf16*)((const unsigned char*)wl + W_UP_OFF), 4096, NUP, D}; pg8::StaticOrder S; S.init(4096, NUP, G, (int)blockIdx.x);
                pg8::EpiBf16Store E{(bf16*)(ws + WS_HPRE), NUP};
                pg8::gemm_phase<pg8::EpiBf16Store, pg8::StaticOrder, true, true>(lds, lds + RING_BYTES, g, S, E);
            }
            SEAM(pb + 5 + 2 * k);
            if (IN(pb + 6 + 2 * k)) { PHASE_IDS for (int it = gw; it < 512 * 12; it += NGW) convgate_item(args, l, k, it, lane); }
            SEAM(pb + 6 + 2 * k);
        }
        if (IN(pb + 23)) {
            pg8::Gemm g{(const bf16*)(ws + WS_BIG), (const bf16*)((const unsigned char*)wl + W_DOWN_OFF), M, D, DFF}; pg8::StaticOrder S; S.init(M, D, G, (int)blockIdx.x);
            pg8::EpiF32Store E{(float*)(ws + WS_Y), D};
            pg8::gemm_phase<pg8::EpiF32Store, pg8::StaticOrder, true, true>(lds, lds + RING_BYTES, g, S, E);
        }
        SEAM(pb + 23);
        if (IN(pb + 24)) {
            PHASE_IDS
            if (l + 1 < DEPTH) resnorm_rows<true, true>(args, gw, NGW, lane, args.out, args.out + (size_t)M_CTX * D, (const float*)(ws + WS_Y), l, 5, l + 1);
            else resnorm_rows<true, false>(args, gw, NGW, lane, args.out, args.out + (size_t)M_CTX * D, (const float*)(ws + WS_Y), l, 5, l);
        }
        if (l + 1 < DEPTH) SEAM(pb + 24);
    }
#undef IN
#undef SEAM
}

extern "C" void kernel_launch(void* const* d_in, const int* in_sizes, int n_in, void* d_out, int out_size, void* d_ws, size_t ws_size, hipStream_t stream) {
    static int grid = 0;
    if (grid == 0) {
        if (n_in != 21 || ws_size < WS_END) { fprintf(stderr, "kernel_launch: expected 21 inputs and >= %zu bytes of workspace; got n_in %d, ws %zu\n", (size_t)WS_END, n_in, ws_size); grid = -1; return; }
        int dev = 0, cus = 0, per_cu = 0;
        if (hipGetDevice(&dev) != hipSuccess || hipDeviceGetAttribute(&cus, hipDeviceAttributeMultiprocessorCount, dev) != hipSuccess) { grid = -1; return; }
        if (hipFuncSetAttribute((const void*)fwd_kernel, hipFuncAttributeMaxDynamicSharedMemorySize, LDS_BYTES) != hipSuccess) { fprintf(stderr, "kernel_launch: hipFuncSetAttribute failed\n"); grid = -1; return; }
        if (hipOccupancyMaxActiveBlocksPerMultiprocessor(&per_cu, (const void*)fwd_kernel, NWAVES * 64, LDS_BYTES) != hipSuccess || per_cu < 1) { fprintf(stderr, "kernel_launch: occupancy query reports %d blocks per CU\n", per_cu); }
        (void)hipGetLastError();
        grid = cus;
    }
    if (grid < 0) return;
    (void)hipMemsetAsync((char*)d_ws + WS_CTL, 0, CTL_ZERO_BYTES, stream);
    Args a{};
    for (int i = 0; i < 21; ++i) a.in[i] = (const float*)d_in[i];
    a.out = (float*)d_out; a.ws = (unsigned char*)d_ws;
#if MK_SINGLE
    a.ph_lo = 0; a.ph_hi = N_PHASES;
    hipLaunchKernelGGL(fwd_kernel, dim3(grid), dim3(NWAVES * 64), LDS_BYTES, stream, a);
#else
    for (int p = 0; p < N_PHASES; ++p) { a.ph_lo = p; a.ph_hi = p + 1; hipLaunchKernelGGL(fwd_kernel, dim3(grid), dim3(NWAVES * 64), LDS_BYTES, stream, a); }
#endif
}
```

```cpp
#include <hip/hip_runtime.h>
#include <cstdio>
#include <cstdint>

#ifndef PROBE_DUP
#define PROBE_DUP 0
#endif
#ifndef MK_SINGLE
#define MK_SINGLE 1
#endif

namespace pg8 {
#define PG8_LAS __attribute__((address_space(3)))
typedef unsigned short bf16_t;
typedef short bf16x8 __attribute__((ext_vector_type(8)));
typedef float f32x4 __attribute__((ext_vector_type(4)));
typedef unsigned u32x4 __attribute__((ext_vector_type(4)));
constexpr int BM = 256, BK = 64, HALF = 128, HTB = HALF * BK * 2, STAGE_BYTES = 8 * HTB, NXCD = 8, WGM = 8;

__host__ __device__ __forceinline__ int lds_byte(int r, int c) { const int st = (r >> 4) * 2 + (c >> 5), rr = r & 15, cc = c & 31, ob = rr * 64 + cc * 2; return st * 1024 + (ob ^ (((ob >> 9) & 1) << 5)); }
__host__ __device__ __forceinline__ void stage_rc(int b, int& R, int& C) { const int st = b / 1024, sb = b % 1024, swz = sb ^ (((sb >> 9) & 1) << 5); R = (st >> 1) * 16 + swz / 64; C = (st & 1) * 32 + (swz % 64) / 2; }
__host__ __device__ __forceinline__ int perm32(int rho) { const int n = rho >> 4, i = rho & 15; return 8 * (i >> 2) + 4 * n + (i & 3); }

struct Unit { int pm, pn; };
struct Gemm { const bf16_t* A; const bf16_t* Bt; int M, N, K; };

struct StaticOrder {
    int nM, nN, nwg, G, c;
    __host__ __device__ void init(int M, int N, int G_, int c_) { nM = M / BM; nN = N / BM; nwg = nM * nN; G = G_; c = c_; }
    __host__ __device__ bool next(int i, Unit& u) const {
        const long L = (long)i * G + c; if (L >= nwg) return false;
        int wgid = (int)L; { const int q = nwg / NXCD, r = nwg % NXCD, xcd = wgid % NXCD, off = wgid / NXCD; wgid = (xcd < r ? xcd * (q + 1) : r * (q + 1) + (xcd - r) * q) + off; }
        const int nig = WGM * nN, gid = wgid / nig, fm = gid * WGM, gsz = (nM - fm) < WGM ? (nM - fm) : WGM;
        u.pm = fm + ((wgid % nig) % gsz); u.pn = (wgid % nig) / gsz; return true;
    }
    __device__ __forceinline__ void a_ready(const Unit&) const {}
    __device__ __forceinline__ void done(const Unit&) const {}
};

__device__ __forceinline__ unsigned cvt_pk_bf16(float lo, float hi) { unsigned r; asm volatile("v_cvt_pk_bf16_f32 %0, %1, %2" : "=v"(r) : "v"(lo), "v"(hi)); return r; }

struct EpiBf16Store {
    static constexpr bool PERM = true, AFTER_DRAIN = false;
    bf16_t* O; int ldc;
    __device__ __forceinline__ void operator()(const f32x4 (&acc)[2][2][4][2], const Unit& u, int wr, int wc, int fr, int fq, PG8_LAS unsigned char*) const {
        const int row0 = u.pm * BM + wr * 64 + fr, col0 = u.pn * BM + wc * 32 + 8 * fq;
#pragma unroll
        for (int ai = 0; ai < 2; ++ai)
#pragma unroll
            for (int m = 0; m < 4; ++m) { bf16_t* rowp = O + (size_t)(row0 + ai * HALF + m * 16) * ldc + col0;
#pragma unroll
                for (int bj = 0; bj < 2; ++bj) { const f32x4 v0 = acc[ai][bj][m][0], v1 = acc[ai][bj][m][1];
                    u32x4 w; w.x = cvt_pk_bf16(v0[0], v0[1]); w.y = cvt_pk_bf16(v0[2], v0[3]); w.z = cvt_pk_bf16(v1[0], v1[1]); w.w = cvt_pk_bf16(v1[2], v1[3]);
                    *(u32x4*)(rowp + bj * HALF) = w; } }
    }
};
struct EpiF32Store {
    static constexpr bool PERM = false, AFTER_DRAIN = false;
    float* C; int ldc;
    __device__ __forceinline__ void operator()(const f32x4 (&acc)[2][2][4][2], const Unit& u, int wr, int wc, int fr, int fq, PG8_LAS unsigned char*) const {
        const int row0 = u.pm * BM + wr * 64 + fr, col0 = u.pn * BM + wc * 32 + 4 * fq;
#pragma unroll
        for (int ai = 0; ai < 2; ++ai)
#pragma unroll
            for (int m = 0; m < 4; ++m) { float* rowp = C + (size_t)(row0 + ai * HALF + m * 16) * ldc + col0;
#pragma unroll
                for (int bj = 0; bj < 2; ++bj)
#pragma unroll
                    for (int n = 0; n < 2; ++n) *(f32x4*)(rowp + bj * HALF + n * 16) = acc[ai][bj][m][n]; }
    }
};

template <class Epi, class Sched, bool ALIGN_EPI = false, bool SP2 = false>
__device__ __forceinline__ void gemm_phase(PG8_LAS unsigned char* lds, PG8_LAS unsigned char* xlds, const Gemm g, const Sched& S, const Epi& E) {
    int tid = threadIdx.x; asm volatile("" : "+v"(tid));
    const int wid = __builtin_amdgcn_readfirstlane(tid >> 6), lane = tid & 63, wr = wid >> 2, wc = wid & 3, fr = lane & 15, fq = lane >> 4;
    const int K = g.K, nt = K / BK;
    unsigned voffA[2], voffB[2];
#pragma unroll
    for (int i = 0; i < 2; ++i) { int R, C; stage_rc(tid * 16 + i * 8192, R, C); const int Rb = Epi::PERM ? ((R & ~31) + perm32(R & 31)) : R;
        voffA[i] = (unsigned)(R * K + C) * 2u; voffB[i] = (unsigned)(Rb * K + C) * 2u; }
    const size_t kstep = (size_t)(BK * 2);
    const size_t hstep = (size_t)HALF * K * 2;
    const size_t tstep = 2 * hstep;
    const unsigned ldsw = (unsigned)wid * 1024u;
    const int aoff = lds_byte(wr * 64 + fr, fq * 8), boff = lds_byte(wc * 32 + fr, fq * 8);
#define PG8_SA(b, h) (((b) * 2 + (h)) * HTB)
#define PG8_SB(b, h) ((4 + (b) * 2 + (h)) * HTB)
#define PG8_STAGE(bufoff, gbase, voff) do { _Pragma("unroll") for (int _i = 0; _i < 2; ++_i) \
        __builtin_amdgcn_global_load_lds((const unsigned*)((const char*)(gbase) + (voff)[_i]), (PG8_LAS unsigned*)(lds + (bufoff) + ldsw + _i * 8192), 16, 0, 0); } while (0)
#define PG8_LDA(dst, b, h) do { _Pragma("unroll") for (int m = 0; m < 4; ++m) _Pragma("unroll") for (int k = 0; k < 2; ++k) dst[m][k] = *(const PG8_LAS bf16x8*)(lds + PG8_SA(b, h) + aoff + m * 2048 + k * 1024); } while (0)
#define PG8_LDB(dst, b, h) do { _Pragma("unroll") for (int n = 0; n < 2; ++n) _Pragma("unroll") for (int k = 0; k < 2; ++k) dst[n][k] = *(const PG8_LAS bf16x8*)(lds + PG8_SB(b, h) + boff + n * 2048 + k * 1024); } while (0)
#define PG8_MMA(ai, bj, At, Bt) do { __builtin_amdgcn_s_setprio(1); _Pragma("unroll") for (int m = 0; m < 4; ++m) _Pragma("unroll") for (int n = 0; n < 2; ++n) _Pragma("unroll") for (int k = 0; k < 2; ++k) \
        acc[ai][bj][m][n] = __builtin_amdgcn_mfma_f32_16x16x32_bf16(Bt[n][k], At[m][k], acc[ai][bj][m][n], 0, 0, 0); __builtin_amdgcn_s_setprio(0); } while (0)
#define PG8_WAIT_V(n) asm volatile("s_waitcnt vmcnt(" #n ")" ::: "memory")
#define PG8_WAIT_L(n) asm volatile("s_waitcnt lgkmcnt(" #n ")" ::: "memory")
#define PG8_BAR __builtin_amdgcn_s_barrier()
#define PG8_SCHED __builtin_amdgcn_sched_barrier(0)
    Unit cur, nxt; int ui = 0;
    if (!S.next(0, cur)) return;
    f32x4 acc[2][2][4][2];
#pragma unroll
    for (int a = 0; a < 2; ++a)
#pragma unroll
        for (int b = 0; b < 2; ++b)
#pragma unroll
            for (int m = 0; m < 4; ++m)
#pragma unroll
                for (int n = 0; n < 2; ++n) acc[a][b][m][n] = (f32x4){0.f, 0.f, 0.f, 0.f};
    bf16x8 At[4][2], B0[2][2], B1[2][2];
    const char* cA = (const char*)g.A + (size_t)cur.pm * tstep; const char* cB = (const char*)g.Bt + (size_t)cur.pn * tstep;
    S.a_ready(cur);
    if constexpr (SP2) {
        PG8_STAGE(PG8_SB(0, 0), cB, voffB); PG8_STAGE(PG8_SB(0, 1), cB + hstep, voffB); PG8_STAGE(PG8_SA(0, 0), cA, voffA); PG8_STAGE(PG8_SA(0, 1), cA + hstep, voffA);
        if (wr == 1) PG8_BAR;
        PG8_WAIT_V(2); PG8_BAR;
        PG8_STAGE(PG8_SB(1, 0), cB + kstep, voffB); PG8_STAGE(PG8_SA(1, 0), cA + kstep, voffA); PG8_STAGE(PG8_SB(1, 1), cB + hstep + kstep, voffB);
        PG8_WAIT_V(6); PG8_BAR;
    } else {
        PG8_STAGE(PG8_SB(0, 0), cB, voffB); PG8_STAGE(PG8_SA(0, 0), cA, voffA); PG8_STAGE(PG8_SB(0, 1), cB + hstep, voffB); PG8_STAGE(PG8_SA(0, 1), cA + hstep, voffA);
        if (wr == 1) PG8_BAR;
        PG8_WAIT_V(4); PG8_BAR;
        PG8_STAGE(PG8_SB(1, 0), cB + kstep, voffB); PG8_STAGE(PG8_SA(1, 0), cA + kstep, voffA); PG8_STAGE(PG8_SB(1, 1), cB + hstep + kstep, voffB);
        PG8_WAIT_V(6); PG8_BAR;
    }
    for (;;) {
        const bool has_next = S.next(ui + 1, nxt);
        const char* nA = has_next ? (const char*)g.A + (size_t)nxt.pm * tstep : cA; const char* nB = has_next ? (const char*)g.Bt + (size_t)nxt.pn * tstep : cB;
        for (int t = 0; t < nt; t += 2) {
            const bool last = (t == nt - 2);
            const char* a1 = cA + (size_t)(t + 1) * kstep;
            const char* a2 = last ? nA : cA + (size_t)(t + 2) * kstep; const char* b2 = last ? nB : cB + (size_t)(t + 2) * kstep;
            const char* a3 = a2 + kstep; const char* b3 = b2 + kstep;
            if (last && has_next) S.a_ready(nxt);
            if constexpr (SP2) {
            PG8_LDB(B0, 0, 0); PG8_LDB(B1, 0, 1); PG8_SCHED; PG8_LDA(At, 0, 0); PG8_STAGE(PG8_SA(1, 1), a1 + hstep, voffA);
            PG8_WAIT_V(8); PG8_WAIT_L(0); PG8_BAR; PG8_MMA(0, 0, At, B0); PG8_MMA(0, 1, At, B1); PG8_BAR; PG8_SCHED;
            PG8_LDA(At, 0, 1); PG8_STAGE(PG8_SB(0, 0), b2, voffB); PG8_STAGE(PG8_SB(0, 1), b2 + hstep, voffB); PG8_STAGE(PG8_SA(0, 0), a2, voffA);
            PG8_WAIT_V(8); PG8_WAIT_L(0); PG8_BAR; PG8_MMA(1, 0, At, B0); PG8_MMA(1, 1, At, B1); PG8_BAR; PG8_SCHED;
            PG8_LDB(B0, 1, 0); PG8_LDB(B1, 1, 1); PG8_SCHED; PG8_LDA(At, 1, 0); PG8_STAGE(PG8_SA(0, 1), a2 + hstep, voffA);
            PG8_WAIT_V(8); PG8_WAIT_L(0); PG8_BAR; PG8_MMA(0, 0, At, B0); PG8_MMA(0, 1, At, B1); PG8_BAR; PG8_SCHED;
            PG8_LDA(At, 1, 1); PG8_STAGE(PG8_SB(1, 0), b3, voffB); PG8_STAGE(PG8_SB(1, 1), b3 + hstep, voffB); PG8_STAGE(PG8_SA(1, 0), a3, voffA);
            PG8_WAIT_V(8); PG8_WAIT_L(0); PG8_BAR; PG8_MMA(1, 0, At, B0); PG8_MMA(1, 1, At, B1); PG8_BAR; PG8_SCHED;
            } else {
            PG8_LDB(B0, 0, 0); PG8_SCHED; PG8_LDA(At, 0, 0); PG8_STAGE(PG8_SA(1, 1), a1 + hstep, voffA);
            PG8_WAIT_L(8); PG8_BAR; PG8_WAIT_L(0); PG8_MMA(0, 0, At, B0); PG8_BAR; PG8_SCHED;
            PG8_LDB(B1, 0, 1); PG8_STAGE(PG8_SB(0, 0), b2, voffB);
            PG8_BAR; PG8_WAIT_L(0); PG8_MMA(0, 1, At, B1); PG8_BAR;
            PG8_LDA(At, 0, 1); PG8_STAGE(PG8_SA(0, 0), a2, voffA);
            PG8_BAR; PG8_WAIT_L(0); PG8_MMA(1, 0, At, B0); PG8_BAR; PG8_SCHED;
            PG8_STAGE(PG8_SB(0, 1), b2 + hstep, voffB);
            PG8_WAIT_V(6); PG8_BAR; PG8_MMA(1, 1, At, B1); PG8_BAR;
            PG8_LDB(B0, 1, 0); PG8_SCHED; PG8_LDA(At, 1, 0); PG8_STAGE(PG8_SA(0, 1), a2 + hstep, voffA);
            PG8_WAIT_L(8); PG8_BAR; PG8_WAIT_L(0); PG8_MMA(0, 0, At, B0); PG8_BAR; PG8_SCHED;
            PG8_LDB(B1, 1, 1); PG8_STAGE(PG8_SB(1, 0), b3, voffB);
            PG8_BAR; PG8_WAIT_L(0); PG8_MMA(0, 1, At, B1); PG8_BAR;
            PG8_LDA(At, 1, 1); PG8_STAGE(PG8_SA(1, 0), a3, voffA);
            PG8_BAR; PG8_WAIT_L(0); PG8_MMA(1, 0, At, B0); PG8_BAR; PG8_SCHED;
            PG8_STAGE(PG8_SB(1, 1), b3 + hstep, voffB);
            PG8_WAIT_V(6); PG8_BAR; PG8_MMA(1, 1, At, B1); PG8_BAR;
            }
        }
        if constexpr (ALIGN_EPI) { if (wr == 0) PG8_BAR; }
        if constexpr (!Epi::AFTER_DRAIN) { E(acc, cur, wr, wc, fr, fq, xlds); S.done(cur); }
        if (!has_next) break;
#pragma unroll
        for (int a = 0; a < 2; ++a)
#pragma unroll
            for (int b = 0; b < 2; ++b)
#pragma unroll
                for (int m = 0; m < 4; ++m)
#pragma unroll
                    for (int n = 0; n < 2; ++n) acc[a][b][m][n] = (f32x4){0.f, 0.f, 0.f, 0.f};
        cur = nxt; cA = nA; cB = nB; ++ui;
        if constexpr (ALIGN_EPI) { if (wr == 1) PG8_BAR; }
    }
    PG8_WAIT_V(0);
    if constexpr (!ALIGN_EPI) { if (wr == 0) PG8_BAR; }
    PG8_BAR;
#undef PG8_SA
#undef PG8_SB
#undef PG8_STAGE
#undef PG8_LDA
#undef PG8_LDB
#undef PG8_MMA
#undef PG8_WAIT_V
#undef PG8_WAIT_L
#undef PG8_BAR
#undef PG8_SCHED
}
}

constexpr int NWAVES = 8;
constexpr int D = 2048, DEPTH = 4;
constexpr int NB_CTX = 16, L_CTX = 256, NB_LAT = 8, L_LAT = 4096;
constexpr int M_CTX = NB_CTX * L_CTX, M_LAT = NB_LAT * L_LAT, M = M_CTX + M_LAT;
constexpr int DCONV = 1024, DRNN = 1024, NH = 16, HD = 64, DIN = 5120, DFF = 6144, NUP = 12288;
constexpr int NVEC = 9;
constexpr int NMODC = 6 * D;
constexpr float EPS = 1e-6f;
constexpr int NCHUNK = M / 64;

constexpr size_t MiB = 1u << 20;
constexpr size_t WS_CTL = 0, CTL_ZERO_BYTES = 64 * 1024;
constexpr size_t WS_MODV = 1 * MiB;
constexpr size_t WS_SUMM = 3 * MiB;
constexpr size_t WS_GATEW = 13 * MiB;
constexpr size_t WS_W = 48 * MiB;
constexpr size_t W_LAYER = 100 * MiB, W_IN_OFF = 0, W_OUT_OFF = 20 * MiB, W_UP_OFF = 28 * MiB, W_DOWN_OFF = 76 * MiB;
constexpr size_t WS_A = 448 * MiB;
constexpr size_t WS_BIG = 592 * MiB;
constexpr size_t WS_Y = 1024 * MiB;
constexpr size_t WS_HPRE = 1312 * MiB;
constexpr size_t WS_END = 1408 * MiB;
constexpr int CW_BAR = 1024;

constexpr int RING_BYTES = 131072;
constexpr int MISC_OFF = 155648;
constexpr int LDS_BYTES = 156160;

#define GAS __attribute__((address_space(1)))
#define LAS __attribute__((address_space(3)))
typedef unsigned short bf16;
typedef unsigned v4u __attribute__((ext_vector_type(4)));
typedef unsigned v2u __attribute__((ext_vector_type(2)));
typedef float f32x4 __attribute__((ext_vector_type(4)));
typedef float f32x2 __attribute__((ext_vector_type(2)));
#define LDS_WAIT() asm volatile("s_waitcnt lgkmcnt(0)" ::: "memory")
__device__ __forceinline__ unsigned f2bf(float f) { unsigned u = __builtin_bit_cast(unsigned, f); return (u + 0x7fffu + ((u >> 16) & 1u)) >> 16; }
__device__ __forceinline__ unsigned pk2(float lo, float hi) { return f2bf(lo) | (f2bf(hi) << 16); }
__device__ __forceinline__ float bf2f(unsigned short b) { return __builtin_bit_cast(float, ((unsigned)b) << 16); }
__device__ __forceinline__ float bflo(unsigned w) { return __builtin_bit_cast(float, w << 16); }
__device__ __forceinline__ float bfhi(unsigned w) { return __builtin_bit_cast(float, w & 0xffff0000u); }
__device__ __forceinline__ float sigmoidf_(float x) { return 1.f / (1.f + __expf(-x)); }
__device__ __forceinline__ float gelu_tanh(float x) { const float u = 1.5957691216057308f * (x + 0.044715f * x * x * x); return x / (1.f + __expf(-u)); }
__device__ __forceinline__ float wave_sum(float v) {
#pragma unroll
    for (int o = 1; o < 64; o <<= 1) v += __shfl_xor(v, o);
    return v;
}

#define XB_TMO      128
#define XB_XCNT(j)  (256  + 64 * (j))
#define XB_XSUB(j)  (1280 + 64 * (j))
#define XB_XGEN(j)  (2304 + 64 * (j))
#define XB_TOP      3328
#define XB_TOPGEN   3392
#define XCD_BAR_WORDS 3456
#define XB_SPIN_CAP (1u << 18)
__device__ __forceinline__ unsigned xb_ld(unsigned* p)              { return __hip_atomic_load(p, __ATOMIC_RELAXED, __HIP_MEMORY_SCOPE_AGENT); }
__device__ __forceinline__ unsigned xb_add(unsigned* p, unsigned v) { return __hip_atomic_fetch_add(p, v, __ATOMIC_RELAXED, __HIP_MEMORY_SCOPE_AGENT); }
__device__ __forceinline__ unsigned xb_xcc_id() { return (unsigned)__builtin_amdgcn_s_getreg((3 << 11) | 20) & 0xFu; }
#define XB_SPIN(cond, bar) do { unsigned _sp = 0; while (cond) { __builtin_amdgcn_s_sleep(1); \
    if ((++_sp & 255u) == 0u) { if (xb_ld(&(bar)[XB_TMO])) break; if (_sp > XB_SPIN_CAP) { atomicAdd(&(bar)[XB_TMO], 1u); break; } } } } while (0)
struct XcdBarrier { unsigned* bar; unsigned x; volatile LAS unsigned* st; };
__device__ __forceinline__ XcdBarrier xcd_barrier_post(unsigned* bar, volatile LAS unsigned* st) {
    XcdBarrier b; b.bar = bar; b.x = xb_xcc_id(); b.st = st;
    if (threadIdx.x == 0) (void)xb_add(&bar[XB_XCNT(b.x)], 1u);
    return b;
}
__device__ __forceinline__ void xcd_barrier_complete(unsigned* bar, unsigned x, unsigned& nloc, unsigned& nx) {
    const unsigned G = gridDim.x * gridDim.y * gridDim.z;
    unsigned sum, cnt, mine, sp = 0u;
    for (;;) {
        sum = 0u; cnt = 0u; mine = 0u;
#pragma unroll
        for (unsigned j = 0; j < 16; ++j) { const unsigned c = xb_ld(&bar[XB_XCNT(j)]); sum += c; cnt += (c > 0u) ? 1u : 0u; mine = (j == x) ? c : mine; }
        if (sum == G) break;
        __builtin_amdgcn_s_sleep(1);
        if ((++sp & 255u) == 0u) { if (xb_ld(&bar[XB_TMO])) break; if (sp > XB_SPIN_CAP) { atomicAdd(&bar[XB_TMO], 1u); break; } }
    }
    nloc = mine > 0u ? mine : 1u; nx = cnt > 0u ? cnt : 1u;
}
__device__ __forceinline__ void xcd_barrier(const XcdBarrier& b) {
    asm volatile("s_waitcnt vmcnt(0)" ::: "memory");
    __syncthreads();
    if (threadIdx.x == 0) {
        unsigned* bar = b.bar;
        __builtin_amdgcn_s_waitcnt(0);
        unsigned nloc = b.st[0], nx = b.st[1];
        if (nloc == 0u) { xcd_barrier_complete(bar, b.x, nloc, nx); b.st[0] = nloc; b.st[1] = nx; }
        const unsigned old = xb_add(&bar[XB_XSUB(b.x)], 1u);
        const unsigned gen = old / nloc;
        if (old + 1u == (gen + 1u) * nloc) {
            __builtin_amdgcn_fence(__ATOMIC_RELEASE, "agent");
            asm volatile("s_waitcnt vmcnt(0)" ::: "memory");
            const unsigned og = xb_add(&bar[XB_TOP], 1u);
            const unsigned tg = og / nx;
            if (og + 1u == (tg + 1u) * nx) xb_add(&bar[XB_TOPGEN], 1u);
            else XB_SPIN(xb_ld(&bar[XB_TOPGEN]) == tg, bar);
            __builtin_amdgcn_fence(__ATOMIC_ACQUIRE, "agent");
            xb_add(&bar[XB_XGEN(b.x)], 1u);
            asm volatile("s_waitcnt vmcnt(0)" ::: "memory");
        } else {
            XB_SPIN(xb_ld(&bar[XB_XGEN(b.x)]) == gen, bar);
            __builtin_amdgcn_fence(__ATOMIC_ACQUIRE, "agent");
            asm volatile("s_waitcnt vmcnt(0)" ::: "memory");
        }
    }
    __syncthreads();
}

struct Args {
    const float* in[21];
    float* out; unsigned char* ws;
    int ph_lo, ph_hi;
    int rep[6];
};
enum { I_XP = 0, I_XS, I_STATE, I_C, I_CCTX, I_WADA, I_BADA, I_NORMG, I_WIN, I_CONVA, I_RCW, I_RCB, I_RWA, I_RBA, I_RWX, I_RBX, I_RLAM, I_WOUT, I_FUP, I_FCW, I_FDOWN };

__device__ __forceinline__ void transpose_item(const float* W, int K, int N, bf16* WT, int k0, int n0, int dst_row0, LAS float* scr, int lane) {
#pragma unroll 8
    for (int i = 0; i < 32; ++i) { const int kk = 2 * i + (lane >> 5); scr[kk * 33 + (lane & 31)] = W[(size_t)(k0 + kk) * N + n0 + (lane & 31)]; }
    LDS_WAIT(); asm volatile("" ::: "memory");
    const int c = lane & 7;
#pragma unroll
    for (int j = 0; j < 4; ++j) { const int n = (lane >> 3) + 8 * j; const LAS float* s = scr + (8 * c) * 33 + n;
        v4u o; o.x = pk2(s[0 * 33], s[1 * 33]); o.y = pk2(s[2 * 33], s[3 * 33]); o.z = pk2(s[4 * 33], s[5 * 33]); o.w = pk2(s[6 * 33], s[7 * 33]);
        *(GAS v4u*)(WT + (size_t)(dst_row0 + n) * K + k0 + 8 * c) = o; }
    LDS_WAIT(); asm volatile("" ::: "memory");
}
constexpr int TI_IN = (D / 64) * (DIN / 32), TI_OUT = (D / 64) * (D / 32), TI_UP = (D / 64) * (NUP / 32), TI_DOWN = (DFF / 64) * (D / 32);
constexpr int TI_LAYER = TI_IN + TI_OUT + TI_UP + TI_DOWN;

__device__ __forceinline__ void pre_transposes(const Args& a, LAS unsigned char* lds, int gw, int NGW, int wave, int lane) {
    LAS float* scr = (LAS float*)(lds + wave * 16384);
    for (int it = gw; it < DEPTH * 2 * 2 * NH * 2; it += NGW) {
        const int half = it & 1, mat = it >> 1, hd = mat & 15, gate = (mat >> 4) & 1, ld = mat >> 5;
        const float* W = (gate ? a.in[I_RWX] : a.in[I_RWA]) + (size_t)(ld * NH + hd) * 64 * 64;
        transpose_item(W, 64, 64, (bf16*)(a.ws + WS_GATEW) + (size_t)((ld * 2 + gate) * NH + hd) * 64 * 64, 0, 32 * half, 32 * half, scr, lane);
    }
    for (int it = gw; it < DEPTH * TI_LAYER; it += NGW) {
        const int l = it / TI_LAYER; int r = it % TI_LAYER;
        bf16* wl = (bf16*)(a.ws + WS_W + (size_t)l * W_LAYER);
        if (r < TI_IN) { const int nblk = DIN / 32, kb = r / nblk, nb = r % nblk;
            transpose_item(a.in[I_WIN] + (size_t)l * D * DIN, D, DIN, (bf16*)((unsigned char*)wl + W_IN_OFF), 64 * kb, 32 * nb, 32 * nb, scr, lane); continue; }
        r -= TI_IN;
        if (r < TI_OUT) { const int nblk = D / 32, kb = r / nblk, nb = r % nblk;
            transpose_item(a.in[I_WOUT] + (size_t)l * D * D, D, D, (bf16*)((unsigned char*)wl + W_OUT_OFF), 64 * kb, 32 * nb, 32 * nb, scr, lane); continue; }
        r -= TI_OUT;
        if (r < TI_UP) { const int nblk = NUP / 32, kb = r / nblk, nb = r % nblk; const int n0 = 32 * nb;
            const int dst = (n0 < DFF) ? ((n0 >> 7) * 256 + (n0 & 127)) : ((((n0 - DFF) >> 7) * 256) + 128 + ((n0 - DFF) & 127));
            transpose_item(a.in[I_FUP] + (size_t)l * D * NUP, D, NUP, (bf16*)((unsigned char*)wl + W_UP_OFF), 64 * kb, n0, dst, scr, lane); continue; }
        r -= TI_UP;
        { const int nblk = D / 32, kb = r / nblk, nb = r % nblk;
            transpose_item(a.in[I_FDOWN] + (size_t)l * DFF * D, DFF, D, (bf16*)((unsigned char*)wl + W_DOWN_OFF), 64 * kb, 32 * nb, 32 * nb, scr, lane); }
    }
}

__device__ __forceinline__ void pre_mod(const Args& a, LAS unsigned char* lds, int tid, int wave, int lane) {
    LAS float* s = (LAS float*)lds;
    LAS float* red = s + NVEC * D;
    for (int i = tid; i < NVEC * D; i += NWAVES * 64) { const int v = i / D, k = i % D; const float c = (v == 0) ? a.in[I_CCTX][k] : a.in[I_C][(v - 1) * D + k]; s[i] = c / (1.f + __expf(-c)); }
    __syncthreads();
    float* modv = (float*)(a.ws + WS_MODV);
    const int cl = tid & 15, ks = tid >> 4;
    for (int item = blockIdx.x; item < DEPTH * (NMODC / 64); item += gridDim.x) {
        const int l = item / (NMODC / 64), n0 = (item % (NMODC / 64)) * 64;
        float acc[NVEC][4];
#pragma unroll
        for (int v = 0; v < NVEC; ++v) { acc[v][0] = 0.f; acc[v][1] = 0.f; acc[v][2] = 0.f; acc[v][3] = 0.f; }
        const float* wp = a.in[I_WADA] + ((size_t)l * D + ks * 64) * NMODC + n0 + 4 * cl;
        const LAS float* sp = s + ks * 64;
#pragma unroll 8
        for (int kk = 0; kk < 64; ++kk) {
            const f32x4 w = *(const f32x4*)(wp + (size_t)kk * NMODC);
#pragma unroll
            for (int v = 0; v < NVEC; ++v) { const float sv = sp[v * D + kk]; acc[v][0] += sv * w[0]; acc[v][1] += sv * w[1]; acc[v][2] += sv * w[2]; acc[v][3] += sv * w[3]; }
        }
#pragma unroll
        for (int v = 0; v < NVEC; ++v)
#pragma unroll
            for (int e = 0; e < 4; ++e) { float t = acc[v][e]; t += __shfl_xor(t, 16); t += __shfl_xor(t, 32); if (lane < 16) red[(wave * 16 + cl) * 36 + v * 4 + e] = t; }
        __syncthreads();
        for (int o = tid; o < NVEC * 64; o += NWAVES * 64) {
            const int v = o >> 6, col = o & 63;
            float sum = 0.f;
#pragma unroll
            for (int w = 0; w < NWAVES; ++w) sum += red[(w * 16 + (col >> 2)) * 36 + v * 4 + (col & 3)];
            const int n = n0 + col, q = n / D, j = n % D;
            const float val = sum + a.in[I_BADA][l * NMODC + n];
            const float* ng = a.in[I_NORMG] + (size_t)l * 4 * D;
            int slot; float r;
            if (q == 0) { slot = 1; r = val; }
            else if (q == 1) { slot = 0; r = ng[0 * D + j] * (1.f + val); }
            else if (q == 2) { slot = 2; r = val * ng[1 * D + j]; }
            else if (q == 3) { slot = 4; r = val; }
            else if (q == 4) { slot = 3; r = ng[2 * D + j] * (1.f + val); }
            else { slot = 5; r = val * ng[3 * D + j]; }
            modv[((size_t)(l * NVEC + v) * 6 + slot) * D + j] = r;
        }
        __syncthreads();
    }
}

template <bool HAS_RES, bool HAS_U>
__device__ __forceinline__ void resnorm_rows(const Args& a, int gw, int NGW, int lane, const float* xsrc_ctx, const float* xsrc_lat, const float* y, int l_res, int slot_res, int l_u) {
    const float* modv = (const float*)(a.ws + WS_MODV);
    bf16* U = (bf16*)(a.ws + WS_A);
    for (int m = gw; m < M; m += NGW) {
        const int v = (m < M_CTX) ? 0 : 1 + ((m - M_CTX) >> 12);
        const float* xs = (m < M_CTX) ? xsrc_ctx + (size_t)m * D : xsrc_lat + (size_t)(m - M_CTX) * D;
        const GAS f32x4* xr = (const GAS f32x4*)xs + lane;
        f32x4 xv[8];
#pragma unroll
        for (int j = 0; j < 8; ++j) xv[j] = xr[64 * j];
        if (HAS_RES) {
            const GAS f32x4* yr = (const GAS f32x4*)(y + (size_t)m * D) + lane;
            const GAS f32x4* gr = (const GAS f32x4*)(modv + ((size_t)(l_res * NVEC + v) * 6 + slot_res) * D) + lane;
            f32x4 yv[8]; float ss = 0.f;
#pragma unroll
            for (int j = 0; j < 8; ++j) { yv[j] = yr[64 * j]; ss += (yv[j].x * yv[j].x + yv[j].y * yv[j].y) + (yv[j].z * yv[j].z + yv[j].w * yv[j].w); }
            const float rstd = 1.f / sqrtf(wave_sum(ss) * (1.f / D) + EPS);
#pragma unroll
            for (int j = 0; j < 8; ++j) { const f32x4 g = gr[64 * j]; xv[j] = xv[j] + g * yv[j] * rstd; }
        }
        GAS f32x4* xo = (GAS f32x4*)(a.out + (size_t)m * D) + lane;
#pragma unroll
        for (int j = 0; j < 8; ++j) xo[64 * j] = xv[j];
        if (HAS_U) {
            float ss = 0.f;
#pragma unroll
            for (int j = 0; j < 8; ++j) ss += (xv[j].x * xv[j].x + xv[j].y * xv[j].y) + (xv[j].z * xv[j].z + xv[j].w * xv[j].w);
            const float rstd = 1.f / sqrtf(wave_sum(ss) * (1.f / D) + EPS);
            const GAS f32x4* gn = (const GAS f32x4*)(modv + ((size_t)(l_u * NVEC + v) * 6 + (l_u == l_res && HAS_RES ? 3 : 0)) * D) + lane;
            const GAS f32x4* bn = (const GAS f32x4*)(modv + ((size_t)(l_u * NVEC + v) * 6 + (l_u == l_res && HAS_RES ? 4 : 1)) * D) + lane;
            GAS v2u* uo = (GAS v2u*)(U + (size_t)m * D) + lane;
#pragma unroll
            for (int j = 0; j < 8; ++j) { const f32x4 g = gn[64 * j], b = bn[64 * j]; const f32x4 t = xv[j] * rstd * g + b; v2u o; o.x = pk2(t.x, t.y); o.y = pk2(t.z, t.w); uo[64 * j] = o; }
        }
    }
}

struct SeqInfo { int base, L, s0, b, cfirst, clast; bool col, ctx; };
__device__ __forceinline__ SeqInfo seq_info(int c, int layer) {
    SeqInfo q;
    if (c < 64) { q.b = c >> 2; q.s0 = (c & 3) * 64; q.L = L_CTX; q.base = q.b * L_CTX; q.col = false; q.ctx = true; q.cfirst = c & ~3; q.clast = q.cfirst + 3; }
    else { const int cc = c - 64; q.b = cc >> 6; q.s0 = (cc & 63) * 64; q.L = L_LAT; q.base = M_CTX + q.b * L_LAT; q.col = (layer & 1) != 0; q.ctx = false; q.cfirst = 64 + (cc & ~63); q.clast = q.cfirst + 63; }
    return q;
}
__device__ __forceinline__ int tok_of(const SeqInfo& q, int s) { return q.base + (q.col ? (((s & 63) << 6) | (s >> 6)) : s); }

typedef float f32x16 __attribute__((ext_vector_type(16)));
typedef short bf16x8v __attribute__((ext_vector_type(8)));
typedef __bf16 bf16v2 __attribute__((ext_vector_type(2)));
__device__ __forceinline__ unsigned pkbf(float lo, float hi) { const bf16v2 t = __builtin_convertvector((f32x2){lo, hi}, bf16v2); return __builtin_bit_cast(unsigned, t); }
constexpr int XROW = 144;
constexpr int XT_BYTES = 10240;
constexpr int HT_BYTES = 9216;
constexpr int WAVE_LDS = XT_BYTES + HT_BYTES;

__device__ __forceinline__ void stage_tile(const bf16* src, const SeqInfo& q, int pos0, int nrows, LAS unsigned char* xt, int lane) {
    const int sub = lane & 7, rsel = lane >> 3;
#pragma unroll
    for (int r0 = 0; r0 < 72; r0 += 8) {
        const int rr = r0 + rsel, s = pos0 + rr;
        v4u val = (v4u){0u, 0u, 0u, 0u};
        if (rr < nrows && s >= 0 && s < q.L) val = *(const v4u*)(src + (size_t)tok_of(q, s) * DIN + sub * 8);
        if (rr < nrows) *(LAS v4u*)(xt + rr * XROW + sub * 16) = val;
    }
}

template <bool FINAL, int DIR>
__device__ __forceinline__ void scan_dir(const Args& a, int layer, int h, int c, const SeqInfo& q, LAS unsigned char* xt, LAS unsigned char* hft, int lane, float hin0, float hin1) {
    const int ld = layer * 2 + DIR, r = lane & 31, hh = lane >> 5;
    bf16x8v afr[2][4];
#pragma unroll
    for (int ks = 0; ks < 4; ++ks) {
        const int i0 = 16 * ks + 8 * hh;
        const float* cw = a.in[I_RCW] + (size_t)(ld * 4) * DRNN + h * 64 + i0;
        f32x4 w[4][2];
#pragma unroll
        for (int k = 0; k < 4; ++k) { w[k][0] = *(const f32x4*)(cw + k * DRNN); w[k][1] = *(const f32x4*)(cw + k * DRNN + 4); }
        const f32x4 b0 = *(const f32x4*)(a.in[I_RCB] + ld * DRNN + h * 64 + i0), b1 = *(const f32x4*)(a.in[I_RCB] + ld * DRNN + h * 64 + i0 + 4);
#pragma unroll
        for (int tb = 0; tb < 2; ++tb) {
            const int t = tb * 32 + r;
            f32x4 a0 = b0, a1 = b1;
#pragma unroll
            for (int k = 0; k < 4; ++k) {
                const int rr = DIR ? (t + 6 - k) : (t + k);
                const v4u raw = *(const LAS v4u*)(xt + rr * XROW + i0 * 2);
                a0 += w[k][0] * (f32x4){bflo(raw.x), bfhi(raw.x), bflo(raw.y), bfhi(raw.y)};
                a1 += w[k][1] * (f32x4){bflo(raw.z), bfhi(raw.z), bflo(raw.w), bfhi(raw.w)};
            }
            v4u p; p.x = pkbf(a0.x, a0.y); p.y = pkbf(a0.z, a0.w); p.z = pkbf(a1.x, a1.y); p.w = pkbf(a1.z, a1.w);
            afr[tb][ks] = __builtin_bit_cast(bf16x8v, p);
        }
    }
    const bf16* gatew = (const bf16*)(a.ws + WS_GATEW);
    f32x2* summ = (f32x2*)(a.ws + WS_SUMM);
    float* nstate = a.out + (size_t)M * D;
#pragma unroll
    for (int cb = 0; cb < 2; ++cb) {
        const int chh = cb * 32 + r, ch = h * 64 + chh;
        bf16x8v bfr[2][4];
#pragma unroll
        for (int gate = 0; gate < 2; ++gate)
#pragma unroll
            for (int ks = 0; ks < 4; ++ks) bfr[gate][ks] = *(const bf16x8v*)(gatew + ((size_t)((ld * 2 + gate) * NH + h) * 64 + chh) * 64 + 16 * ks + 8 * hh);
        const float ba = a.in[I_RBA][ld * DRNN + ch], bx = a.in[I_RBX][ld * DRNN + ch];
        const float c8l2 = -8.f * 1.4426950408889634f * log1pf(__expf(-a.in[I_RLAM][ld * DRNN + ch]));
        const float cw0 = a.in[I_RCW][(ld * 4 + 0) * DRNN + ch], cw1 = a.in[I_RCW][(ld * 4 + 1) * DRNN + ch], cw2 = a.in[I_RCW][(ld * 4 + 2) * DRNN + ch], cw3 = a.in[I_RCW][(ld * 4 + 3) * DRNN + ch];
        const float cbias = a.in[I_RCB][ld * DRNN + ch];
        float hstate = FINAL ? (cb ? hin1 : hin0) : 0.f, Atot = 1.f;
        const bool first_mine = (hh == DIR);
#pragma unroll
        for (int tbi = 0; tbi < 2; ++tbi) {
            constexpr int dummy = 0; (void)dummy;
            const int tb = DIR ? 1 - tbi : tbi;
            f32x16 accr, acci;
#pragma unroll
            for (int i = 0; i < 16; ++i) { accr[i] = 0.f; acci[i] = 0.f; }
#pragma unroll
            for (int ks = 0; ks < 4; ++ks) {
                accr = __builtin_amdgcn_mfma_f32_32x32x16_bf16(afr[tb][ks], bfr[0][ks], accr, 0, 0, 0);
                acci = __builtin_amdgcn_mfma_f32_32x32x16_bf16(afr[tb][ks], bfr[1][ks], acci, 0, 0, 0);
            }
            float av[16], vv[16];
#pragma unroll
            for (int gq = 0; gq < 4; ++gq) {
                const int t0 = tb * 32 + 8 * gq + 4 * hh;
                const int rbase = DIR ? t0 + 3 : t0;
                float xw[7];
#pragma unroll
                for (int m = 0; m < 7; ++m) xw[m] = bf2f(*(const LAS unsigned short*)(xt + (rbase + m) * XROW + chh * 2));
#pragma unroll
                for (int e = 0; e < 4; ++e) {
                    const int qi = 4 * gq + e;
                    const float xc = DIR ? (cbias + cw0 * xw[e + 3] + cw1 * xw[e + 2] + cw2 * xw[e + 1] + cw3 * xw[e])
                                         : (cbias + cw0 * xw[e] + cw1 * xw[e + 1] + cw2 * xw[e + 2] + cw3 * xw[e + 3]);
                    const float rg = __builtin_amdgcn_rcpf(1.f + __builtin_amdgcn_exp2f(-1.4426950408889634f * (accr[qi] + ba)));
                    const float ig = __builtin_amdgcn_rcpf(1.f + __builtin_amdgcn_exp2f(-1.4426950408889634f * (acci[qi] + bx)));
                    const float aa = __builtin_amdgcn_exp2f(c8l2 * rg);
                    av[qi] = aa; vv[qi] = __builtin_amdgcn_sqrtf(fmaxf(0.f, 1.f - aa * aa)) * ig * xc;
                }
            }
            float Ao[4], Ho[4], pA[4], pH[4];
#pragma unroll
            for (int gq = 0; gq < 4; ++gq) {
                float A_ = 1.f, H_ = 0.f;
#pragma unroll
                for (int ei = 0; ei < 4; ++ei) { const int qi = 4 * gq + (DIR ? 3 - ei : ei); H_ = av[qi] * H_ + vv[qi]; A_ *= av[qi]; }
                Ao[gq] = A_; Ho[gq] = H_; pA[gq] = __shfl_xor(A_, 32); pH[gq] = __shfl_xor(H_, 32);
            }
#pragma unroll
            for (int gqi = 0; gqi < 4; ++gqi) {
                const int gq = DIR ? 3 - gqi : gqi;
                const float pre = first_mine ? hstate : (pA[gq] * hstate + pH[gq]);
                float post;
                if (FINAL) {
                    float hs = pre;
#pragma unroll
                    for (int ei = 0; ei < 4; ++ei) { const int e = DIR ? 3 - ei : ei, qi = 4 * gq + e; hs = av[qi] * hs + vv[qi];
                        LAS unsigned short* hp = (LAS unsigned short*)(hft + (tb * 32 + 8 * gq + 4 * hh + e) * XROW + chh * 2);
                        if (DIR == 0) *hp = (unsigned short)f2bf(hs); else *hp = (unsigned short)f2bf(bf2f(*hp) + hs); }
                    post = hs;
                } else { post = Ao[gq] * pre + Ho[gq]; Atot *= Ao[gq] * pA[gq]; }
                hstate = first_mine ? (pA[gq] * post + pH[gq]) : post;
            }
        }
        if (!FINAL) { if (hh == 0) summ[(size_t)(c * 2 + DIR) * DRNN + ch] = (f32x2){Atot, hstate}; }
        else if (q.ctx && hh == 0 && c == (DIR ? q.cfirst : q.clast)) nstate[((size_t)(q.b * DEPTH + layer) * 2 + DIR) * DRNN + ch] = hstate;
    }
}

__device__ __forceinline__ void scan_summary_item(const Args& a, int layer, int item, int lane, LAS unsigned char* xt) {
    const int d = item & 1, h = (item >> 1) & 15, c = item >> 5;
    const SeqInfo q = seq_info(c, layer);
    stage_tile((const bf16*)(a.ws + WS_BIG) + 3 * DCONV + h * 64, q, q.s0 - 3, 70, xt, lane);
    if (d == 0) scan_dir<false, 0>(a, layer, h, c, q, xt, xt, lane, 0.f, 0.f);
    else scan_dir<false, 1>(a, layer, h, c, q, xt, xt, lane, 0.f, 0.f);
}

__device__ __forceinline__ float carry_in(const Args& a, const SeqInfo& q, int layer, int c, int d, int ch) {
    const f32x2* summ = (const f32x2*)(a.ws + WS_SUMM);
    float hin = q.ctx ? 0.f : a.in[I_STATE][((size_t)(q.b * DEPTH + layer) * 2 + d) * DRNN + ch];
    const int n = d ? (q.clast - c) : (c - q.cfirst);
    for (int i0 = 0; i0 < n; i0 += 8) {
        f32x2 t[8];
#pragma unroll
        for (int k = 0; k < 8; ++k) { const int i = i0 + k; const int cc = d ? (q.clast - i) : (q.cfirst + i); t[k] = (i < n) ? summ[(size_t)(cc * 2 + d) * DRNN + ch] : (f32x2){1.f, 0.f}; }
#pragma unroll
        for (int k = 0; k < 8; ++k) hin = t[k].x * hin + t[k].y;
    }
    return hin;
}

__device__ __forceinline__ void mixb_item(const Args& a, int layer, int item, int lane, LAS unsigned char* xt) {
    const int h = item & 15, c = item >> 4, r = lane & 31, hh = lane >> 5;
    const SeqInfo q = seq_info(c, layer);
    const bf16* proj = (const bf16*)(a.ws + WS_BIG);
    stage_tile(proj + 3 * DCONV + h * 64, q, q.s0 - 3, 70, xt, lane);
    LAS unsigned char* hft = xt + XT_BYTES;
    {
        const float hl = carry_in(a, q, layer, c, 0, h * 64 + lane);
        scan_dir<true, 0>(a, layer, h, c, q, xt, hft, lane, __shfl(hl, r), __shfl(hl, 32 + r));
    }
    {
        const float hl = carry_in(a, q, layer, c, 1, h * 64 + lane);
        scan_dir<true, 1>(a, layer, h, c, q, xt, hft, lane, __shfl(hl, r), __shfl(hl, 32 + r));
    }
    stage_tile(proj + 3 * DCONV + DRNN + h * 64, q, q.s0, 64, xt, lane);
#pragma unroll
    for (int tb = 0; tb < 2; ++tb)
#pragma unroll
        for (int cb = 0; cb < 2; ++cb)
#pragma unroll
            for (int qi = 0; qi < 16; ++qi) {
                const int t = tb * 32 + (qi & 3) + 8 * (qi >> 2) + 4 * hh;
                const int off = t * XROW + (cb * 32 + r) * 2;
                const float g = bf2f(*(const LAS unsigned short*)(xt + off));
                LAS unsigned short* p = (LAS unsigned short*)(hft + off);
                *p = (unsigned short)f2bf(bf2f(*p) * gelu_tanh(g));
            }
    bf16* ymix = (bf16*)(a.ws + WS_A) + DCONV + h * 64;
    const int sub = lane & 7, rsel = lane >> 3;
#pragma unroll
    for (int r0 = 0; r0 < 64; r0 += 8) {
        const int rr = r0 + rsel;
        const v4u val = *(const LAS v4u*)(hft + rr * XROW + sub * 16);
        *(v4u*)(ymix + (size_t)tok_of(q, q.s0 + rr) * D + sub * 8) = val;
    }
}

__device__ __forceinline__ void mixa_item(const Args& a, int layer, int item, int lane) {
    const int g4 = item & 3, c = item >> 2, ch0 = g4 * 256 + lane * 4;
    const SeqInfo q = seq_info(c, layer);
    const bf16* proj = (const bf16*)(a.ws + WS_BIG);
    bf16* ymix = (bf16*)(a.ws + WS_A);
    const f32x4 w0 = *(const f32x4*)(a.in[I_CONVA] + (size_t)(layer * 3 + 0) * DCONV + ch0);
    const f32x4 w1 = *(const f32x4*)(a.in[I_CONVA] + (size_t)(layer * 3 + 1) * DCONV + ch0);
    const f32x4 w2 = *(const f32x4*)(a.in[I_CONVA] + (size_t)(layer * 3 + 2) * DCONV + ch0);
    auto cx_at = [&](int s) -> f32x4 {
        if (s < 0 || s >= q.L) return (f32x4){0.f, 0.f, 0.f, 0.f};
        const bf16* row = proj + (size_t)tok_of(q, s) * DIN + ch0;
        const v2u cg = *(const v2u*)(row + DCONV), xa = *(const v2u*)(row + 2 * DCONV);
        return (f32x4){bflo(cg.x) * bflo(xa.x), bfhi(cg.x) * bfhi(xa.x), bflo(cg.y) * bflo(xa.y), bfhi(cg.y) * bfhi(xa.y)};
    };
    f32x4 cm = cx_at(q.s0 - 1), cc = cx_at(q.s0);
    for (int blk = 0; blk < 8; ++blk) {
        f32x4 cn[8]; v2u bg[8];
#pragma unroll
        for (int e = 0; e < 8; ++e) { const int s = q.s0 + 8 * blk + e; cn[e] = cx_at(s + 1); bg[e] = *(const v2u*)(proj + (size_t)tok_of(q, s) * DIN + ch0); }
#pragma unroll
        for (int e = 0; e < 8; ++e) {
            const int s = q.s0 + 8 * blk + e;
            const f32x4 hv = w0 * cm + w1 * cc + w2 * cn[e];
            const f32x4 bv = (f32x4){bflo(bg[e].x), bfhi(bg[e].x), bflo(bg[e].y), bfhi(bg[e].y)};
            const f32x4 o = bv * hv;
            v2u ov; ov.x = pk2(o.x, o.y); ov.y = pk2(o.z, o.w);
            *(v2u*)(ymix + (size_t)tok_of(q, s) * D + ch0) = ov;
            cm = cc; cc = cn[e];
        }
    }
}

__device__ __forceinline__ void convgate_item(const Args& a, int layer, int chunk, int item, int lane) {
    const int cgp = item % 12, rb = item / 12, r0 = rb * 8, ch0 = cgp * 512 + lane * 8;
    const int seqlen = (chunk == 0) ? L_CTX : L_LAT;
    const bf16* hp = (const bf16*)(a.ws + WS_HPRE) + (size_t)((ch0 >> 7) * 256 + (ch0 & 127));
    bf16* act = (bf16*)(a.ws + WS_BIG) + (size_t)(chunk * 4096) * DFF + ch0;
    const float* cw = a.in[I_FCW] + (size_t)layer * 3 * NUP;
    float wg[3][8], wv[3][8];
#pragma unroll
    for (int t = 0; t < 3; ++t)
#pragma unroll
        for (int e = 0; e < 8; ++e) { wg[t][e] = cw[t * NUP + ch0 + e]; wv[t][e] = cw[t * NUP + DFF + ch0 + e]; }
    v4u rg[10], rv[10];
#pragma unroll
    for (int i = 0; i < 10; ++i) {
        const int r = r0 - 1 + i;
        const bool ok = (i == 0) ? ((r0 % seqlen) != 0) : (i == 9) ? (((r0 + 8) % seqlen) != 0) : true;
        if (ok) { rg[i] = *(const v4u*)(hp + (size_t)r * NUP); rv[i] = *(const v4u*)(hp + (size_t)r * NUP + 128); }
        else { rg[i] = (v4u){0u, 0u, 0u, 0u}; rv[i] = (v4u){0u, 0u, 0u, 0u}; }
    }
#pragma unroll
    for (int i = 1; i <= 8; ++i) {
        float o[8];
#pragma unroll
        for (int e2 = 0; e2 < 4; ++e2) {
            const unsigned gm = rg[i - 1][e2], gc = rg[i][e2], gn = rg[i + 1][e2], vm = rv[i - 1][e2], vc = rv[i][e2], vn = rv[i + 1][e2];
            const float hg0 = wg[0][2 * e2] * bflo(gm) + wg[1][2 * e2] * bflo(gc) + wg[2][2 * e2] * bflo(gn);
            const float hg1 = wg[0][2 * e2 + 1] * bfhi(gm) + wg[1][2 * e2 + 1] * bfhi(gc) + wg[2][2 * e2 + 1] * bfhi(gn);
            const float hv0 = wv[0][2 * e2] * bflo(vm) + wv[1][2 * e2] * bflo(vc) + wv[2][2 * e2] * bflo(vn);
            const float hv1 = wv[0][2 * e2 + 1] * bfhi(vm) + wv[1][2 * e2 + 1] * bfhi(vc) + wv[2][2 * e2 + 1] * bfhi(vn);
            o[2 * e2] = gelu_tanh(hg0) * hv0; o[2 * e2 + 1] = gelu_tanh(hg1) * hv1;
        }
        v4u ov; ov.x = pk2(o[0], o[1]); ov.y = pk2(o[2], o[3]); ov.z = pk2(o[4], o[5]); ov.w = pk2(o[6], o[7]);
        *(v4u*)(act + (size_t)(r0 + i - 1) * DFF) = ov;
    }
}

constexpr int PH_PRE = 0, PH_NORM0 = 1, PH_LAYER0 = 2, NPL = 25, N_PHASES = PH_LAYER0 + DEPTH * NPL;

__global__ void __launch_bounds__(NWAVES * 64, 2) fwd_kernel(Args args) {
    extern __shared__ __attribute__((aligned(16))) unsigned char lds_raw[];
    LAS unsigned char* lds = (LAS unsigned char*)lds_raw;
    volatile LAS unsigned* MISC = (volatile LAS unsigned*)(lds + MISC_OFF);
    const int G = gridDim.x, NGW = G * NWAVES;
    const int lo = args.ph_lo, hi = args.ph_hi;
#define PHASE_IDS int tid = threadIdx.x; asm volatile("" : "+v"(tid)); const int lane = tid & 63, wave = __builtin_amdgcn_readfirstlane(tid >> 6), gw = blockIdx.x * NWAVES + wave; (void)lane; (void)gw;
    if (threadIdx.x < 32) MISC[threadIdx.x] = 0u;
    __syncthreads();
    XcdBarrier bar; bar.bar = (unsigned*)(args.ws + WS_CTL) + CW_BAR; bar.x = 0; bar.st = nullptr;
    if (hi - lo > 1) bar = xcd_barrier_post((unsigned*)(args.ws + WS_CTL) + CW_BAR, MISC + 8);
#define IN(k) (lo <= (k) && (k) < hi)
#define SEAM(k) do { if (IN(k) && IN((k) + 1)) xcd_barrier(bar); } while (0)
    unsigned char* ws = args.ws;

    if (IN(PH_PRE)) { for (int rep = 0; rep < args.rep[4]; ++rep) { PHASE_IDS pre_transposes(args, lds, gw, NGW, wave, lane); __syncthreads(); pre_mod(args, lds, tid, wave, lane); __syncthreads(); } }
    SEAM(PH_PRE);
    if (IN(PH_NORM0)) { PHASE_IDS resnorm_rows<false, true>(args, gw, NGW, lane, args.in[I_XP], args.in[I_XS], nullptr, 0, 0, 0); }
    SEAM(PH_NORM0);

    for (int l = 0; l < DEPTH; ++l) {
        const int pb = PH_LAYER0 + l * NPL;
        const bf16* wl = (const bf16*)(ws + WS_W + (size_t)l * W_LAYER);
        if (IN(pb + 0)) for (int rep = 0; rep < args.rep[0]; ++rep) {
            pg8::Gemm g{(const bf16*)(ws + WS_A), (const bf16*)((const unsigned char*)wl + W_IN_OFF), M, DIN, D}; pg8::StaticOrder S; S.init(M, DIN, G, (int)blockIdx.x);
            pg8::EpiBf16Store E{(bf16*)(ws + WS_BIG), DIN};
            pg8::gemm_phase<pg8::EpiBf16Store, pg8::StaticOrder, true, true>(lds, lds + RING_BYTES, g, S, E);
        }
        SEAM(pb + 0);
        if (IN(pb + 1)) for (int rep = 0; rep < args.rep[1]; ++rep) { PHASE_IDS LAS unsigned char* xt = lds + wave * WAVE_LDS; for (int it = gw; it < NCHUNK * NH * 2; it += NGW) scan_summary_item(args, l, it, lane, xt); }
        SEAM(pb + 1);
        if (IN(pb + 2)) for (int rep = 0; rep < args.rep[2]; ++rep) {
            PHASE_IDS
            LAS unsigned char* xt = lds + wave * WAVE_LDS;
            for (int it = gw; it < NCHUNK * NH + NCHUNK * 4; it += NGW) { if (it < NCHUNK * NH) mixb_item(args, l, it, lane, xt); else mixa_item(args, l, it - NCHUNK * NH, lane); }
        }
        SEAM(pb + 2);
        if (IN(pb + 3)) for (int rep = 0; rep < args.rep[0]; ++rep) {
            pg8::Gemm g{(const bf16*)(ws + WS_A), (const bf16*)((const unsigned char*)wl + W_OUT_OFF), M, D, D}; pg8::StaticOrder S; S.init(M, D, G, (int)blockIdx.x);
            pg8::EpiF32Store E{(float*)(ws + WS_Y), D};
            pg8::gemm_phase<pg8::EpiF32Store, pg8::StaticOrder, true, true>(lds, lds + RING_BYTES, g, S, E);
        }
        SEAM(pb + 3);
        if (IN(pb + 4)) { PHASE_IDS resnorm_rows<true, true>(args, gw, NGW, lane, args.out, args.out + (size_t)M_CTX * D, (const float*)(ws + WS_Y), l, 2, l); }
        SEAM(pb + 4);
        for (int k = 0; k < 9; ++k) {
            if (IN(pb + 5 + 2 * k)) for (int rep = 0; rep < args.rep[0]; ++rep) {
                pg8::Gemm g{(const bf16*)(ws + WS_A) + (size_t)k * 4096 * D, (const bf16*)((const unsigned char*)wl + W_UP_OFF), 4096, NUP, D}; pg8::StaticOrder S; S.init(4096, NUP, G, (int)blockIdx.x);
                pg8::EpiBf16Store E{(bf16*)(ws + WS_HPRE), NUP};
                pg8::gemm_phase<pg8::EpiBf16Store, pg8::StaticOrder, true, true>(lds, lds + RING_BYTES, g, S, E);
            }
            SEAM(pb + 5 + 2 * k);
            if (IN(pb + 6 + 2 * k)) for (int rep = 0; rep < args.rep[3]; ++rep) { PHASE_IDS for (int it = gw; it < 512 * 12; it += NGW) convgate_item(args, l, k, it, lane); }
            SEAM(pb + 6 + 2 * k);
        }
        if (IN(pb + 23)) for (int rep = 0; rep < args.rep[0]; ++rep) {
            pg8::Gemm g{(const bf16*)(ws + WS_BIG), (const bf16*)((const unsigned char*)wl + W_DOWN_OFF), M, D, DFF}; pg8::StaticOrder S; S.init(M, D, G, (int)blockIdx.x);
            pg8::EpiF32Store E{(float*)(ws + WS_Y), D};
            pg8::gemm_phase<pg8::EpiF32Store, pg8::StaticOrder, true, true>(lds, lds + RING_BYTES, g, S, E);
        }
        SEAM(pb + 23);
        if (IN(pb + 24)) {
            PHASE_IDS
            if (l + 1 < DEPTH) resnorm_rows<true, true>(args, gw, NGW, lane, args.out, args.out + (size_t)M_CTX * D, (const float*)(ws + WS_Y), l, 5, l + 1);
            else resnorm_rows<true, false>(args, gw, NGW, lane, args.out, args.out + (size_t)M_CTX * D, (const float*)(ws + WS_Y), l, 5, l);
        }
        if (l + 1 < DEPTH) SEAM(pb + 24);
    }
#undef IN
#undef SEAM
}

extern "C" void kernel_launch(void* const* d_in, const int* in_sizes, int n_in, void* d_out, int out_size, void* d_ws, size_t ws_size, hipStream_t stream) {
    static int grid = 0;
    if (grid == 0) {
        if (n_in != 21 || ws_size < WS_END) { fprintf(stderr, "kernel_launch: expected 21 inputs and >= %zu bytes of workspace; got n_in %d, ws %zu\n", (size_t)WS_END, n_in, ws_size); grid = -1; return; }
        int dev = 0, cus = 0, per_cu = 0;
        if (hipGetDevice(&dev) != hipSuccess || hipDeviceGetAttribute(&cus, hipDeviceAttributeMultiprocessorCount, dev) != hipSuccess) { grid = -1; return; }
        if (hipFuncSetAttribute((const void*)fwd_kernel, hipFuncAttributeMaxDynamicSharedMemorySize, LDS_BYTES) != hipSuccess) { fprintf(stderr, "kernel_launch: hipFuncSetAttribute failed\n"); grid = -1; return; }
        if (hipOccupancyMaxActiveBlocksPerMultiprocessor(&per_cu, (const void*)fwd_kernel, NWAVES * 64, LDS_BYTES) != hipSuccess || per_cu < 1) { fprintf(stderr, "kernel_launch: occupancy query reports %d blocks per CU\n", per_cu); }
        (void)hipGetLastError();
        grid = cus;
    }
    if (grid < 0) return;
    (void)hipMemsetAsync((char*)d_ws + WS_CTL, 0, CTL_ZERO_BYTES, stream);
    Args a{};
    for (int i = 0; i < 21; ++i) a.in[i] = (const float*)d_in[i];
    a.out = (float*)d_out; a.ws = (unsigned char*)d_ws;
    for (int i = 0; i < 6; ++i) a.rep[i] = ((PROBE_DUP >> i) & 1) ? 2 : 1;
#if MK_SINGLE
    a.ph_lo = 0; a.ph_hi = N_PHASES;
    hipLaunchKernelGGL(fwd_kernel, dim3(grid), dim3(NWAVES * 64), LDS_BYTES, stream, a);
#else
    for (int p = 0; p < N_PHASES; ++p) { a.ph_lo = p; a.ph_hi = p + 1; hipLaunchKernelGGL(fwd_kernel, dim3(grid), dim3(NWAVES * 64), LDS_BYTES, stream, a); }
#endif
}
```

```cpp
#include <hip/hip_runtime.h>
#include <cstdio>
#include <cstdint>

#ifndef PROBE_DUP
#define PROBE_DUP 0
#endif
#ifndef MK_SINGLE
#define MK_SINGLE 1
#endif

namespace pg8 {
#define PG8_LAS __attribute__((address_space(3)))
typedef unsigned short bf16_t;
typedef short bf16x8 __attribute__((ext_vector_type(8)));
typedef float f32x4 __attribute__((ext_vector_type(4)));
typedef unsigned u32x4 __attribute__((ext_vector_type(4)));
constexpr int BM = 256, BK = 64, HALF = 128, HTB = HALF * BK * 2, STAGE_BYTES = 8 * HTB, NXCD = 8, WGM = 8;

__host__ __device__ __forceinline__ int lds_byte(int r, int c) { const int st = (r >> 4) * 2 + (c >> 5), rr = r & 15, cc = c & 31, ob = rr * 64 + cc * 2; return st * 1024 + (ob ^ (((ob >> 9) & 1) << 5)); }
__host__ __device__ __forceinline__ void stage_rc(int b, int& R, int& C) { const int st = b / 1024, sb = b % 1024, swz = sb ^ (((sb >> 9) & 1) << 5); R = (st >> 1) * 16 + swz / 64; C = (st & 1) * 32 + (swz % 64) / 2; }
__host__ __device__ __forceinline__ int perm32(int rho) { const int n = rho >> 4, i = rho & 15; return 8 * (i >> 2) + 4 * n + (i & 3); }

struct Unit { int pm, pn; };
struct Gemm { const bf16_t* A; const bf16_t* Bt; int M, N, K; };

struct StaticOrder {
    int nM, nN, nwg, G, c;
    __host__ __device__ void init(int M, int N, int G_, int c_) { nM = M / BM; nN = N / BM; nwg = nM * nN; G = G_; c = c_; }
    __host__ __device__ bool next(int i, Unit& u) const {
        const long L = (long)i * G + c; if (L >= nwg) return false;
        int wgid = (int)L; { const int q = nwg / NXCD, r = nwg % NXCD, xcd = wgid % NXCD, off = wgid / NXCD; wgid = (xcd < r ? xcd * (q + 1) : r * (q + 1) + (xcd - r) * q) + off; }
        const int nig = WGM * nN, gid = wgid / nig, fm = gid * WGM, gsz = (nM - fm) < WGM ? (nM - fm) : WGM;
        u.pm = fm + ((wgid % nig) % gsz); u.pn = (wgid % nig) / gsz; return true;
    }
    __device__ __forceinline__ void a_ready(const Unit&) const {}
    __device__ __forceinline__ void done(const Unit&) const {}
};

__device__ __forceinline__ unsigned cvt_pk_bf16(float lo, float hi) { unsigned r; asm volatile("v_cvt_pk_bf16_f32 %0, %1, %2" : "=v"(r) : "v"(lo), "v"(hi)); return r; }

struct EpiBf16Store {
    static constexpr bool PERM = true, AFTER_DRAIN = false;
    bf16_t* O; int ldc;
    __device__ __forceinline__ void operator()(const f32x4 (&acc)[2][2][4][2], const Unit& u, int wr, int wc, int fr, int fq, PG8_LAS unsigned char*) const {
        const int row0 = u.pm * BM + wr * 64 + fr, col0 = u.pn * BM + wc * 32 + 8 * fq;
#pragma unroll
        for (int ai = 0; ai < 2; ++ai)
#pragma unroll
            for (int m = 0; m < 4; ++m) { bf16_t* rowp = O + (size_t)(row0 + ai * HALF + m * 16) * ldc + col0;
#pragma unroll
                for (int bj = 0; bj < 2; ++bj) { const f32x4 v0 = acc[ai][bj][m][0], v1 = acc[ai][bj][m][1];
                    u32x4 w; w.x = cvt_pk_bf16(v0[0], v0[1]); w.y = cvt_pk_bf16(v0[2], v0[3]); w.z = cvt_pk_bf16(v1[0], v1[1]); w.w = cvt_pk_bf16(v1[2], v1[3]);
                    *(u32x4*)(rowp + bj * HALF) = w; } }
    }
};
struct EpiF32Store {
    static constexpr bool PERM = false, AFTER_DRAIN = false;
    float* C; int ldc;
    __device__ __forceinline__ void operator()(const f32x4 (&acc)[2][2][4][2], const Unit& u, int wr, int wc, int fr, int fq, PG8_LAS unsigned char*) const {
        const int row0 = u.pm * BM + wr * 64 + fr, col0 = u.pn * BM + wc * 32 + 4 * fq;
#pragma unroll
        for (int ai = 0; ai < 2; ++ai)
#pragma unroll
            for (int m = 0; m < 4; ++m) { float* rowp = C + (size_t)(row0 + ai * HALF + m * 16) * ldc + col0;
#pragma unroll
                for (int bj = 0; bj < 2; ++bj)
#pragma unroll
                    for (int n = 0; n < 2; ++n) *(f32x4*)(rowp + bj * HALF + n * 16) = acc[ai][bj][m][n]; }
    }
};


#ifndef EPI_DPP
#define EPI_DPP 0
#endif
__device__ __forceinline__ float rotr1_16(float x, int lane) {
#if EPI_DPP
    return __builtin_bit_cast(float, __builtin_amdgcn_update_dpp(0, __builtin_bit_cast(int, x), 0x121, 0xF, 0xF, false));
#else
    return __shfl(x, (lane & 48) | ((lane + 15) & 15));
#endif
}
__device__ __forceinline__ float rotl1_16(float x, int lane) {
#if EPI_DPP
    return __builtin_bit_cast(float, __builtin_amdgcn_update_dpp(0, __builtin_bit_cast(int, x), 0x12F, 0xF, 0xF, false));
#else
    return __shfl(x, (lane & 48) | ((lane + 1) & 15));
#endif
}
__device__ __forceinline__ float gelu_tanh_f(float x) { const float u = 1.5957691216057308f * (x + 0.044715f * x * x * x); return x * __builtin_amdgcn_rcpf(1.f + __builtin_amdgcn_exp2f(-1.4426950408889634f * u)); }
struct EpiConvGate {
    static constexpr bool PERM = true, AFTER_DRAIN = false;
    bf16_t* act; int ldc; const float* cw; float* edge; int nup, dff;
    __device__ __forceinline__ void operator()(const f32x4 (&acc)[2][2][4][2], const Unit& u, int wr, int wc, int fr, int fq, PG8_LAS unsigned char* xlds) const {
        PG8_LAS float* ex = (PG8_LAS float*)xlds;
        const int lane = fq * 16 + fr, ucol = wc * 32 + 8 * fq;
#pragma unroll
        for (int ai = 0; ai < 2; ++ai)
#pragma unroll
            for (int bj = 0; bj < 2; ++bj)
#pragma unroll
                for (int n = 0; n < 2; ++n) {
                    if (fr == 0)  *(PG8_LAS f32x4*)(ex + (2 * (2 * ai + wr) + 0) * 256 + 128 * bj + ucol + 4 * n) = acc[ai][bj][0][n];
                    if (fr == 15) *(PG8_LAS f32x4*)(ex + (2 * (2 * ai + wr) + 1) * 256 + 128 * bj + ucol + 4 * n) = acc[ai][bj][3][n];
                }
        float* eb = edge + (size_t)u.pm * 4 * nup + u.pn * 256 + ucol;
        if (wr == 0 && fr < 2) {
#pragma unroll
            for (int bj = 0; bj < 2; ++bj)
#pragma unroll
                for (int n = 0; n < 2; ++n) *(f32x4*)(eb + (size_t)fr * nup + 128 * bj + 4 * n) = acc[0][bj][0][n];
        }
        if (wr == 1 && fr >= 14) {
#pragma unroll
            for (int bj = 0; bj < 2; ++bj)
#pragma unroll
                for (int n = 0; n < 2; ++n) *(f32x4*)(eb + (size_t)(fr - 12) * nup + 128 * bj + 4 * n) = acc[1][bj][3][n];
        }
        PG8_LAS float* wb = ex + 8 * 256;
        { const int tid = (wr * 4 + wc) * 64 + lane;
          if (tid < 192) { const int t = tid >> 6, part = tid & 63, gv = part >> 5, c4 = part & 31;
              *(PG8_LAS f32x4*)(wb + (t * 2 + gv) * 128 + 4 * c4) = *(const f32x4*)(cw + (size_t)t * nup + gv * dff + u.pn * 128 + 4 * c4); } }
        asm volatile("s_waitcnt lgkmcnt(0)" ::: "memory"); __builtin_amdgcn_s_barrier(); asm volatile("" ::: "memory");
        const int chn0 = u.pn * 128 + ucol;
        const int row0 = u.pm * BM + wr * 64 + fr;
#pragma unroll
        for (int n = 0; n < 2; ++n) {
#pragma unroll
            for (int ai = 0; ai < 2; ++ai) {
                const int sp = 2 * (2 * ai + wr) - 1, sn = 2 * (2 * ai + wr) + 2;
                float og[4][4];
#pragma unroll
                for (int bj = 0; bj < 2; ++bj) {
                    const f32x4 bprev = (sp >= 0) ? *(const PG8_LAS f32x4*)(ex + sp * 256 + 128 * bj + ucol + 4 * n) : (f32x4){0.f, 0.f, 0.f, 0.f};
                    const f32x4 bnext = (sn <= 7) ? *(const PG8_LAS f32x4*)(ex + sn * 256 + 128 * bj + ucol + 4 * n) : (f32x4){0.f, 0.f, 0.f, 0.f};
                    const f32x4 w0 = *(const PG8_LAS f32x4*)(wb + (0 * 2 + bj) * 128 + ucol + 4 * n), w1 = *(const PG8_LAS f32x4*)(wb + (1 * 2 + bj) * 128 + ucol + 4 * n),
                                w2 = *(const PG8_LAS f32x4*)(wb + (2 * 2 + bj) * 128 + ucol + 4 * n);
#pragma unroll
                    for (int e = 0; e < 4; ++e) {
                        float x[4], rr[4], rl[4];
#pragma unroll
                        for (int m = 0; m < 4; ++m) { x[m] = acc[ai][bj][m][n][e]; rr[m] = rotr1_16(x[m], lane); rl[m] = rotl1_16(x[m], lane); }
#pragma unroll
                        for (int m = 0; m < 4; ++m) {
                            const float pe = (m > 0) ? rr[m > 0 ? m - 1 : 0] : bprev[e];
                            const float ne = (m < 3) ? rl[m < 3 ? m + 1 : 3] : bnext[e];
                            const float prev = (fr > 0) ? rr[m] : pe, next = (fr < 15) ? rl[m] : ne;
                            const float hv = w0[e] * prev + w1[e] * x[m] + w2[e] * next;
                            if (bj == 0) og[m][e] = gelu_tanh_f(hv); else og[m][e] *= hv;
                        }
                    }
                }
#pragma unroll
                for (int m = 0; m < 4; ++m) {
                    typedef unsigned u32x2 __attribute__((ext_vector_type(2)));
                    u32x2 w2; w2.x = cvt_pk_bf16(og[m][0], og[m][1]); w2.y = cvt_pk_bf16(og[m][2], og[m][3]);
                    *(u32x2*)(act + (size_t)(row0 + ai * HALF + m * 16) * ldc + chn0 + 4 * n) = w2;
                }
            }
        }
    }
};

template <class Epi, class Sched, bool ALIGN_EPI = false, bool SP2 = false>
__device__ __forceinline__ void gemm_phase(PG8_LAS unsigned char* lds, PG8_LAS unsigned char* xlds, const Gemm g, const Sched& S, const Epi& E) {
    int tid = threadIdx.x; asm volatile("" : "+v"(tid));
    const int wid = __builtin_amdgcn_readfirstlane(tid >> 6), lane = tid & 63, wr = wid >> 2, wc = wid & 3, fr = lane & 15, fq = lane >> 4;
    const int K = g.K, nt = K / BK;
    unsigned voffA[2], voffB[2];
#pragma unroll
    for (int i = 0; i < 2; ++i) { int R, C; stage_rc(tid * 16 + i * 8192, R, C); const int Rb = Epi::PERM ? ((R & ~31) + perm32(R & 31)) : R;
        voffA[i] = (unsigned)(R * K + C) * 2u; voffB[i] = (unsigned)(Rb * K + C) * 2u; }
    const size_t kstep = (size_t)(BK * 2);
    const size_t hstep = (size_t)HALF * K * 2;
    const size_t tstep = 2 * hstep;
    const unsigned ldsw = (unsigned)wid * 1024u;
    const int aoff = lds_byte(wr * 64 + fr, fq * 8), boff = lds_byte(wc * 32 + fr, fq * 8);
#define PG8_SA(b, h) (((b) * 2 + (h)) * HTB)
#define PG8_SB(b, h) ((4 + (b) * 2 + (h)) * HTB)
#define PG8_STAGE(bufoff, gbase, voff) do { _Pragma("unroll") for (int _i = 0; _i < 2; ++_i) \
        __builtin_amdgcn_global_load_lds((const unsigned*)((const char*)(gbase) + (voff)[_i]), (PG8_LAS unsigned*)(lds + (bufoff) + ldsw + _i * 8192), 16, 0, 0); } while (0)
#define PG8_LDA(dst, b, h) do { _Pragma("unroll") for (int m = 0; m < 4; ++m) _Pragma("unroll") for (int k = 0; k < 2; ++k) dst[m][k] = *(const PG8_LAS bf16x8*)(lds + PG8_SA(b, h) + aoff + m * 2048 + k * 1024); } while (0)
#define PG8_LDB(dst, b, h) do { _Pragma("unroll") for (int n = 0; n < 2; ++n) _Pragma("unroll") for (int k = 0; k < 2; ++k) dst[n][k] = *(const PG8_LAS bf16x8*)(lds + PG8_SB(b, h) + boff + n * 2048 + k * 1024); } while (0)
#define PG8_MMA(ai, bj, At, Bt) do { __builtin_amdgcn_s_setprio(1); _Pragma("unroll") for (int m = 0; m < 4; ++m) _Pragma("unroll") for (int n = 0; n < 2; ++n) _Pragma("unroll") for (int k = 0; k < 2; ++k) \
        acc[ai][bj][m][n] = __builtin_amdgcn_mfma_f32_16x16x32_bf16(Bt[n][k], At[m][k], acc[ai][bj][m][n], 0, 0, 0); __builtin_amdgcn_s_setprio(0); } while (0)
#define PG8_WAIT_V(n) asm volatile("s_waitcnt vmcnt(" #n ")" ::: "memory")
#define PG8_WAIT_L(n) asm volatile("s_waitcnt lgkmcnt(" #n ")" ::: "memory")
#define PG8_BAR __builtin_amdgcn_s_barrier()
#define PG8_SCHED __builtin_amdgcn_sched_barrier(0)
    Unit cur, nxt; int ui = 0;
    if (!S.next(0, cur)) return;
    f32x4 acc[2][2][4][2];
#pragma unroll
    for (int a = 0; a < 2; ++a)
#pragma unroll
        for (int b = 0; b < 2; ++b)
#pragma unroll
            for (int m = 0; m < 4; ++m)
#pragma unroll
                for (int n = 0; n < 2; ++n) acc[a][b][m][n] = (f32x4){0.f, 0.f, 0.f, 0.f};
    bf16x8 At[4][2], B0[2][2], B1[2][2];
    const char* cA = (const char*)g.A + (size_t)cur.pm * tstep; const char* cB = (const char*)g.Bt + (size_t)cur.pn * tstep;
    S.a_ready(cur);
    if constexpr (SP2) {
        PG8_STAGE(PG8_SB(0, 0), cB, voffB); PG8_STAGE(PG8_SB(0, 1), cB + hstep, voffB); PG8_STAGE(PG8_SA(0, 0), cA, voffA); PG8_STAGE(PG8_SA(0, 1), cA + hstep, voffA);
        if (wr == 1) PG8_BAR;
        PG8_WAIT_V(2); PG8_BAR;
        PG8_STAGE(PG8_SB(1, 0), cB + kstep, voffB); PG8_STAGE(PG8_SA(1, 0), cA + kstep, voffA); PG8_STAGE(PG8_SB(1, 1), cB + hstep + kstep, voffB);
        PG8_WAIT_V(6); PG8_BAR;
    } else {
        PG8_STAGE(PG8_SB(0, 0), cB, voffB); PG8_STAGE(PG8_SA(0, 0), cA, voffA); PG8_STAGE(PG8_SB(0, 1), cB + hstep, voffB); PG8_STAGE(PG8_SA(0, 1), cA + hstep, voffA);
        if (wr == 1) PG8_BAR;
        PG8_WAIT_V(4); PG8_BAR;
        PG8_STAGE(PG8_SB(1, 0), cB + kstep, voffB); PG8_STAGE(PG8_SA(1, 0), cA + kstep, voffA); PG8_STAGE(PG8_SB(1, 1), cB + hstep + kstep, voffB);
        PG8_WAIT_V(6); PG8_BAR;
    }
    for (;;) {
        const bool has_next = S.next(ui + 1, nxt);
        const char* nA = has_next ? (const char*)g.A + (size_t)nxt.pm * tstep : cA; const char* nB = has_next ? (const char*)g.Bt + (size_t)nxt.pn * tstep : cB;
        for (int t = 0; t < nt; t += 2) {
            const bool last = (t == nt - 2);
            const char* a1 = cA + (size_t)(t + 1) * kstep;
            const char* a2 = last ? nA : cA + (size_t)(t + 2) * kstep; const char* b2 = last ? nB : cB + (size_t)(t + 2) * kstep;
            const char* a3 = a2 + kstep; const char* b3 = b2 + kstep;
            if (last && has_next) S.a_ready(nxt);
            if constexpr (SP2) {
            PG8_LDB(B0, 0, 0); PG8_LDB(B1, 0, 1); PG8_SCHED; PG8_LDA(At, 0, 0); PG8_STAGE(PG8_SA(1, 1), a1 + hstep, voffA);
            PG8_WAIT_V(8); PG8_WAIT_L(0); PG8_BAR; PG8_MMA(0, 0, At, B0); PG8_MMA(0, 1, At, B1); PG8_BAR; PG8_SCHED;
            PG8_LDA(At, 0, 1); PG8_STAGE(PG8_SB(0, 0), b2, voffB); PG8_STAGE(PG8_SB(0, 1), b2 + hstep, voffB); PG8_STAGE(PG8_SA(0, 0), a2, voffA);
            PG8_WAIT_V(8); PG8_WAIT_L(0); PG8_BAR; PG8_MMA(1, 0, At, B0); PG8_MMA(1, 1, At, B1); PG8_BAR; PG8_SCHED;
            PG8_LDB(B0, 1, 0); PG8_LDB(B1, 1, 1); PG8_SCHED; PG8_LDA(At, 1, 0); PG8_STAGE(PG8_SA(0, 1), a2 + hstep, voffA);
            PG8_WAIT_V(8); PG8_WAIT_L(0); PG8_BAR; PG8_MMA(0, 0, At, B0); PG8_MMA(0, 1, At, B1); PG8_BAR; PG8_SCHED;
            PG8_LDA(At, 1, 1); PG8_STAGE(PG8_SB(1, 0), b3, voffB); PG8_STAGE(PG8_SB(1, 1), b3 + hstep, voffB); PG8_STAGE(PG8_SA(1, 0), a3, voffA);
            PG8_WAIT_V(8); PG8_WAIT_L(0); PG8_BAR; PG8_MMA(1, 0, At, B0); PG8_MMA(1, 1, At, B1); PG8_BAR; PG8_SCHED;
            } else {
            PG8_LDB(B0, 0, 0); PG8_SCHED; PG8_LDA(At, 0, 0); PG8_STAGE(PG8_SA(1, 1), a1 + hstep, voffA);
            PG8_WAIT_L(8); PG8_BAR; PG8_WAIT_L(0); PG8_MMA(0, 0, At, B0); PG8_BAR; PG8_SCHED;
            PG8_LDB(B1, 0, 1); PG8_STAGE(PG8_SB(0, 0), b2, voffB);
            PG8_BAR; PG8_WAIT_L(0); PG8_MMA(0, 1, At, B1); PG8_BAR;
            PG8_LDA(At, 0, 1); PG8_STAGE(PG8_SA(0, 0), a2, voffA);
            PG8_BAR; PG8_WAIT_L(0); PG8_MMA(1, 0, At, B0); PG8_BAR; PG8_SCHED;
            PG8_STAGE(PG8_SB(0, 1), b2 + hstep, voffB);
            PG8_WAIT_V(6); PG8_BAR; PG8_MMA(1, 1, At, B1); PG8_BAR;
            PG8_LDB(B0, 1, 0); PG8_SCHED; PG8_LDA(At, 1, 0); PG8_STAGE(PG8_SA(0, 1), a2 + hstep, voffA);
            PG8_WAIT_L(8); PG8_BAR; PG8_WAIT_L(0); PG8_MMA(0, 0, At, B0); PG8_BAR; PG8_SCHED;
            PG8_LDB(B1, 1, 1); PG8_STAGE(PG8_SB(1, 0), b3, voffB);
            PG8_BAR; PG8_WAIT_L(0); PG8_MMA(0, 1, At, B1); PG8_BAR;
            PG8_LDA(At, 1, 1); PG8_STAGE(PG8_SA(1, 0), a3, voffA);
            PG8_BAR; PG8_WAIT_L(0); PG8_MMA(1, 0, At, B0); PG8_BAR; PG8_SCHED;
            PG8_STAGE(PG8_SB(1, 1), b3 + hstep, voffB);
            PG8_WAIT_V(6); PG8_BAR; PG8_MMA(1, 1, At, B1); PG8_BAR;
            }
        }
        if constexpr (ALIGN_EPI) { if (wr == 0) PG8_BAR; }
        if constexpr (!Epi::AFTER_DRAIN) { E(acc, cur, wr, wc, fr, fq, xlds); S.done(cur); }
        if (!has_next) break;
#pragma unroll
        for (int a = 0; a < 2; ++a)
#pragma unroll
            for (int b = 0; b < 2; ++b)
#pragma unroll
                for (int m = 0; m < 4; ++m)
#pragma unroll
                    for (int n = 0; n < 2; ++n) acc[a][b][m][n] = (f32x4){0.f, 0.f, 0.f, 0.f};
        cur = nxt; cA = nA; cB = nB; ++ui;
        if constexpr (ALIGN_EPI) { if (wr == 1) PG8_BAR; }
    }
    PG8_WAIT_V(0);
    if constexpr (!ALIGN_EPI) { if (wr == 0) PG8_BAR; }
    PG8_BAR;
#undef PG8_SA
#undef PG8_SB
#undef PG8_STAGE
#undef PG8_LDA
#undef PG8_LDB
#undef PG8_MMA
#undef PG8_WAIT_V
#undef PG8_WAIT_L
#undef PG8_BAR
#undef PG8_SCHED
}
}

constexpr int NWAVES = 8;
constexpr int D = 2048, DEPTH = 4;
constexpr int NB_CTX = 16, L_CTX = 256, NB_LAT = 8, L_LAT = 4096;
constexpr int M_CTX = NB_CTX * L_CTX, M_LAT = NB_LAT * L_LAT, M = M_CTX + M_LAT;
constexpr int DCONV = 1024, DRNN = 1024, NH = 16, HD = 64, DIN = 5120, DFF = 6144, NUP = 12288;
constexpr int NVEC = 9;
constexpr int NMODC = 6 * D;
constexpr float EPS = 1e-6f;
constexpr int NCHUNK = M / 64;

constexpr size_t MiB = 1u << 20;
constexpr size_t WS_CTL = 0, CTL_ZERO_BYTES = 64 * 1024;
constexpr size_t WS_MODV = 1 * MiB;
constexpr size_t WS_SUMM = 3 * MiB;
constexpr size_t WS_GATEW = 13 * MiB;
constexpr size_t WS_EDGE = 16 * MiB;
constexpr size_t WS_W = 48 * MiB;
constexpr size_t W_LAYER = 100 * MiB, W_IN_OFF = 0, W_OUT_OFF = 20 * MiB, W_UP_OFF = 28 * MiB, W_DOWN_OFF = 76 * MiB;
constexpr size_t WS_A = 448 * MiB;
constexpr size_t WS_BIG = 592 * MiB;
constexpr size_t WS_Y = 1024 * MiB;
constexpr size_t WS_HPRE = 1312 * MiB;
constexpr size_t WS_END = 1408 * MiB;
constexpr int CW_BAR = 1024;

constexpr int RING_BYTES = 131072;
constexpr int MISC_OFF = 155648;
constexpr int LDS_BYTES = 156160;

#define GAS __attribute__((address_space(1)))
#define LAS __attribute__((address_space(3)))
typedef unsigned short bf16;
typedef unsigned v4u __attribute__((ext_vector_type(4)));
typedef unsigned v2u __attribute__((ext_vector_type(2)));
typedef float f32x4 __attribute__((ext_vector_type(4)));
typedef float f32x2 __attribute__((ext_vector_type(2)));
#define LDS_WAIT() asm volatile("s_waitcnt lgkmcnt(0)" ::: "memory")
__device__ __forceinline__ unsigned f2bf(float f) { unsigned u = __builtin_bit_cast(unsigned, f); return (u + 0x7fffu + ((u >> 16) & 1u)) >> 16; }
__device__ __forceinline__ unsigned pk2(float lo, float hi) { return f2bf(lo) | (f2bf(hi) << 16); }
__device__ __forceinline__ float bf2f(unsigned short b) { return __builtin_bit_cast(float, ((unsigned)b) << 16); }
__device__ __forceinline__ float bflo(unsigned w) { return __builtin_bit_cast(float, w << 16); }
__device__ __forceinline__ float bfhi(unsigned w) { return __builtin_bit_cast(float, w & 0xffff0000u); }
__device__ __forceinline__ float sigmoidf_(float x) { return 1.f / (1.f + __expf(-x)); }
__device__ __forceinline__ float gelu_tanh(float x) { const float u = 1.5957691216057308f * (x + 0.044715f * x * x * x); return x / (1.f + __expf(-u)); }
__device__ __forceinline__ float wave_sum(float v) {
#pragma unroll
    for (int o = 1; o < 64; o <<= 1) v += __shfl_xor(v, o);
    return v;
}

#define XB_TMO      128
#define XB_XCNT(j)  (256  + 64 * (j))
#define XB_XSUB(j)  (1280 + 64 * (j))
#define XB_XGEN(j)  (2304 + 64 * (j))
#define XB_TOP      3328
#define XB_TOPGEN   3392
#define XCD_BAR_WORDS 3456
#define XB_SPIN_CAP (1u << 18)
__device__ __forceinline__ unsigned xb_ld(unsigned* p)              { return __hip_atomic_load(p, __ATOMIC_RELAXED, __HIP_MEMORY_SCOPE_AGENT); }
__device__ __forceinline__ unsigned xb_add(unsigned* p, unsigned v) { return __hip_atomic_fetch_add(p, v, __ATOMIC_RELAXED, __HIP_MEMORY_SCOPE_AGENT); }
__device__ __forceinline__ unsigned xb_xcc_id() { return (unsigned)__builtin_amdgcn_s_getreg((3 << 11) | 20) & 0xFu; }
#define XB_SPIN(cond, bar) do { unsigned _sp = 0; while (cond) { __builtin_amdgcn_s_sleep(1); \
    if ((++_sp & 255u) == 0u) { if (xb_ld(&(bar)[XB_TMO])) break; if (_sp > XB_SPIN_CAP) { atomicAdd(&(bar)[XB_TMO], 1u); break; } } } } while (0)
struct XcdBarrier { unsigned* bar; unsigned x; volatile LAS unsigned* st; };
__device__ __forceinline__ XcdBarrier xcd_barrier_post(unsigned* bar, volatile LAS unsigned* st) {
    XcdBarrier b; b.bar = bar; b.x = xb_xcc_id(); b.st = st;
    if (threadIdx.x == 0) (void)xb_add(&bar[XB_XCNT(b.x)], 1u);
    return b;
}
__device__ __forceinline__ void xcd_barrier_complete(unsigned* bar, unsigned x, unsigned& nloc, unsigned& nx) {
    const unsigned G = gridDim.x * gridDim.y * gridDim.z;
    unsigned sum, cnt, mine, sp = 0u;
    for (;;) {
        sum = 0u; cnt = 0u; mine = 0u;
#pragma unroll
        for (unsigned j = 0; j < 16; ++j) { const unsigned c = xb_ld(&bar[XB_XCNT(j)]); sum += c; cnt += (c > 0u) ? 1u : 0u; mine = (j == x) ? c : mine; }
        if (sum == G) break;
        __builtin_amdgcn_s_sleep(1);
        if ((++sp & 255u) == 0u) { if (xb_ld(&bar[XB_TMO])) break; if (sp > XB_SPIN_CAP) { atomicAdd(&bar[XB_TMO], 1u); break; } }
    }
    nloc = mine > 0u ? mine : 1u; nx = cnt > 0u ? cnt : 1u;
}
__device__ __forceinline__ void xcd_barrier(const XcdBarrier& b) {
    asm volatile("s_waitcnt vmcnt(0)" ::: "memory");
    __syncthreads();
    if (threadIdx.x == 0) {
        unsigned* bar = b.bar; asm volatile("" : "+s"(bar));
        __builtin_amdgcn_s_waitcnt(0);
        unsigned nloc = b.st[0], nx = b.st[1];
        if (nloc == 0u) { xcd_barrier_complete(bar, b.x, nloc, nx); b.st[0] = nloc; b.st[1] = nx; }
        const unsigned old = xb_add(&bar[XB_XSUB(b.x)], 1u);
        const unsigned gen = old / nloc;
        if (old + 1u == (gen + 1u) * nloc) {
            __builtin_amdgcn_fence(__ATOMIC_RELEASE, "agent");
            asm volatile("s_waitcnt vmcnt(0)" ::: "memory");
            const unsigned og = xb_add(&bar[XB_TOP], 1u);
            const unsigned tg = og / nx;
            if (og + 1u == (tg + 1u) * nx) xb_add(&bar[XB_TOPGEN], 1u);
            else XB_SPIN(xb_ld(&bar[XB_TOPGEN]) == tg, bar);
            __builtin_amdgcn_fence(__ATOMIC_ACQUIRE, "agent");
            xb_add(&bar[XB_XGEN(b.x)], 1u);
            asm volatile("s_waitcnt vmcnt(0)" ::: "memory");
        } else {
            XB_SPIN(xb_ld(&bar[XB_XGEN(b.x)]) == gen, bar);
            __builtin_amdgcn_fence(__ATOMIC_ACQUIRE, "agent");
            asm volatile("s_waitcnt vmcnt(0)" ::: "memory");
        }
    }
    __syncthreads();
}

struct Args {
    const float* in[21];
    float* out; unsigned char* ws;
    int ph_lo, ph_hi;
    int rep[6];
};
enum { I_XP = 0, I_XS, I_STATE, I_C, I_CCTX, I_WADA, I_BADA, I_NORMG, I_WIN, I_CONVA, I_RCW, I_RCB, I_RWA, I_RBA, I_RWX, I_RBX, I_RLAM, I_WOUT, I_FUP, I_FCW, I_FDOWN };

__device__ __forceinline__ void transpose_item(const float* W, int K, int N, bf16* WT, int k0, int n0, int dst_row0, LAS float* scr, int lane) {
#pragma unroll 8
    for (int i = 0; i < 32; ++i) { const int kk = 2 * i + (lane >> 5); scr[kk * 33 + (lane & 31)] = W[(size_t)(k0 + kk) * N + n0 + (lane & 31)]; }
    LDS_WAIT(); asm volatile("" ::: "memory");
    const int c = lane & 7;
#pragma unroll
    for (int j = 0; j < 4; ++j) { const int n = (lane >> 3) + 8 * j; const LAS float* s = scr + (8 * c) * 33 + n;
        v4u o; o.x = pk2(s[0 * 33], s[1 * 33]); o.y = pk2(s[2 * 33], s[3 * 33]); o.z = pk2(s[4 * 33], s[5 * 33]); o.w = pk2(s[6 * 33], s[7 * 33]);
        *(GAS v4u*)(WT + (size_t)(dst_row0 + n) * K + k0 + 8 * c) = o; }
    LDS_WAIT(); asm volatile("" ::: "memory");
}
constexpr int TI_IN = (D / 64) * (DIN / 32), TI_OUT = (D / 64) * (D / 32), TI_UP = (D / 64) * (NUP / 32), TI_DOWN = (DFF / 64) * (D / 32);
constexpr int TI_LAYER = TI_IN + TI_OUT + TI_UP + TI_DOWN;

__device__ __forceinline__ void pre_transposes(const Args& a, LAS unsigned char* lds, int gw, int NGW, int wave, int lane) {
    LAS float* scr = (LAS float*)(lds + wave * 16384);
    for (int it = gw; it < DEPTH * 2 * 2 * NH * 2; it += NGW) {
        const int half = it & 1, mat = it >> 1, hd = mat & 15, gate = (mat >> 4) & 1, ld = mat >> 5;
        const float* W = (gate ? a.in[I_RWX] : a.in[I_RWA]) + (size_t)(ld * NH + hd) * 64 * 64;
        transpose_item(W, 64, 64, (bf16*)(a.ws + WS_GATEW) + (size_t)((ld * 2 + gate) * NH + hd) * 64 * 64, 0, 32 * half, 32 * half, scr, lane);
    }
    for (int it = gw; it < DEPTH * TI_LAYER; it += NGW) {
        const int l = it / TI_LAYER; int r = it % TI_LAYER;
        bf16* wl = (bf16*)(a.ws + WS_W + (size_t)l * W_LAYER);
        if (r < TI_IN) { const int nblk = DIN / 32, kb = r / nblk, nb = r % nblk;
            transpose_item(a.in[I_WIN] + (size_t)l * D * DIN, D, DIN, (bf16*)((unsigned char*)wl + W_IN_OFF), 64 * kb, 32 * nb, 32 * nb, scr, lane); continue; }
        r -= TI_IN;
        if (r < TI_OUT) { const int nblk = D / 32, kb = r / nblk, nb = r % nblk;
            transpose_item(a.in[I_WOUT] + (size_t)l * D * D, D, D, (bf16*)((unsigned char*)wl + W_OUT_OFF), 64 * kb, 32 * nb, 32 * nb, scr, lane); continue; }
        r -= TI_OUT;
        if (r < TI_UP) { const int nblk = NUP / 32, kb = r / nblk, nb = r % nblk; const int n0 = 32 * nb;
            const int dst = (n0 < DFF) ? ((n0 >> 7) * 256 + (n0 & 127)) : ((((n0 - DFF) >> 7) * 256) + 128 + ((n0 - DFF) & 127));
            transpose_item(a.in[I_FUP] + (size_t)l * D * NUP, D, NUP, (bf16*)((unsigned char*)wl + W_UP_OFF), 64 * kb, n0, dst, scr, lane); continue; }
        r -= TI_UP;
        { const int nblk = D / 32, kb = r / nblk, nb = r % nblk;
            transpose_item(a.in[I_FDOWN] + (size_t)l * DFF * D, DFF, D, (bf16*)((unsigned char*)wl + W_DOWN_OFF), 64 * kb, 32 * nb, 32 * nb, scr, lane); }
    }
}

__device__ __forceinline__ void pre_mod(const Args& a, LAS unsigned char* lds, int tid, int wave, int lane) {
    LAS float* s = (LAS float*)lds;
    LAS float* red = s + NVEC * D;
    for (int i = tid; i < NVEC * D; i += NWAVES * 64) { const int v = i / D, k = i % D; const float c = (v == 0) ? a.in[I_CCTX][k] : a.in[I_C][(v - 1) * D + k]; s[i] = c / (1.f + __expf(-c)); }
    __syncthreads();
    float* modv = (float*)(a.ws + WS_MODV);
    const int cl = tid & 15, ks = tid >> 4;
    for (int item = blockIdx.x; item < DEPTH * (NMODC / 64); item += gridDim.x) {
        const int l = item / (NMODC / 64), n0 = (item % (NMODC / 64)) * 64;
        float acc[NVEC][4];
#pragma unroll
        for (int v = 0; v < NVEC; ++v) { acc[v][0] = 0.f; acc[v][1] = 0.f; acc[v][2] = 0.f; acc[v][3] = 0.f; }
        const float* wp = a.in[I_WADA] + ((size_t)l * D + ks * 64) * NMODC + n0 + 4 * cl;
        const LAS float* sp = s + ks * 64;
#pragma unroll 8
        for (int kk = 0; kk < 64; ++kk) {
            const f32x4 w = *(const f32x4*)(wp + (size_t)kk * NMODC);
#pragma unroll
            for (int v = 0; v < NVEC; ++v) { const float sv = sp[v * D + kk]; acc[v][0] += sv * w[0]; acc[v][1] += sv * w[1]; acc[v][2] += sv * w[2]; acc[v][3] += sv * w[3]; }
        }
#pragma unroll
        for (int v = 0; v < NVEC; ++v)
#pragma unroll
            for (int e = 0; e < 4; ++e) { float t = acc[v][e]; t += __shfl_xor(t, 16); t += __shfl_xor(t, 32); if (lane < 16) red[(wave * 16 + cl) * 36 + v * 4 + e] = t; }
        __syncthreads();
        for (int o = tid; o < NVEC * 64; o += NWAVES * 64) {
            const int v = o >> 6, col = o & 63;
            float sum = 0.f;
#pragma unroll
            for (int w = 0; w < NWAVES; ++w) sum += red[(w * 16 + (col >> 2)) * 36 + v * 4 + (col & 3)];
            const int n = n0 + col, q = n / D, j = n % D;
            const float val = sum + a.in[I_BADA][l * NMODC + n];
            const float* ng = a.in[I_NORMG] + (size_t)l * 4 * D;
            int slot; float r;
            if (q == 0) { slot = 1; r = val; }
            else if (q == 1) { slot = 0; r = ng[0 * D + j] * (1.f + val); }
            else if (q == 2) { slot = 2; r = val * ng[1 * D + j]; }
            else if (q == 3) { slot = 4; r = val; }
            else if (q == 4) { slot = 3; r = ng[2 * D + j] * (1.f + val); }
            else { slot = 5; r = val * ng[3 * D + j]; }
            modv[((size_t)(l * NVEC + v) * 6 + slot) * D + j] = r;
        }
        __syncthreads();
    }
}

template <bool HAS_RES, bool HAS_U>
__device__ __forceinline__ void resnorm_rows(const Args& a, int gw, int NGW, int lane, const float* xsrc_ctx, const float* xsrc_lat, const float* y, int l_res, int slot_res, int l_u) {
    const float* modv = (const float*)(a.ws + WS_MODV);
    bf16* U = (bf16*)(a.ws + WS_A);
    for (int m = gw; m < M; m += NGW) {
        const int v = (m < M_CTX) ? 0 : 1 + ((m - M_CTX) >> 12);
        const float* xs = (m < M_CTX) ? xsrc_ctx + (size_t)m * D : xsrc_lat + (size_t)(m - M_CTX) * D;
        const GAS f32x4* xr = (const GAS f32x4*)xs + lane;
        f32x4 xv[8];
#pragma unroll
        for (int j = 0; j < 8; ++j) xv[j] = xr[64 * j];
        if (HAS_RES) {
            const GAS f32x4* yr = (const GAS f32x4*)(y + (size_t)m * D) + lane;
            const GAS f32x4* gr = (const GAS f32x4*)(modv + ((size_t)(l_res * NVEC + v) * 6 + slot_res) * D) + lane;
            f32x4 yv[8]; float ss = 0.f;
#pragma unroll
            for (int j = 0; j < 8; ++j) { yv[j] = yr[64 * j]; ss += (yv[j].x * yv[j].x + yv[j].y * yv[j].y) + (yv[j].z * yv[j].z + yv[j].w * yv[j].w); }
            const float rstd = 1.f / sqrtf(wave_sum(ss) * (1.f / D) + EPS);
#pragma unroll
            for (int j = 0; j < 8; ++j) { const f32x4 g = gr[64 * j]; xv[j] = xv[j] + g * yv[j] * rstd; }
        }
        GAS f32x4* xo = (GAS f32x4*)(a.out + (size_t)m * D) + lane;
#pragma unroll
        for (int j = 0; j < 8; ++j) xo[64 * j] = xv[j];
        if (HAS_U) {
            float ss = 0.f;
#pragma unroll
            for (int j = 0; j < 8; ++j) ss += (xv[j].x * xv[j].x + xv[j].y * xv[j].y) + (xv[j].z * xv[j].z + xv[j].w * xv[j].w);
            const float rstd = 1.f / sqrtf(wave_sum(ss) * (1.f / D) + EPS);
            const GAS f32x4* gn = (const GAS f32x4*)(modv + ((size_t)(l_u * NVEC + v) * 6 + (l_u == l_res && HAS_RES ? 3 : 0)) * D) + lane;
            const GAS f32x4* bn = (const GAS f32x4*)(modv + ((size_t)(l_u * NVEC + v) * 6 + (l_u == l_res && HAS_RES ? 4 : 1)) * D) + lane;
            GAS v2u* uo = (GAS v2u*)(U + (size_t)m * D) + lane;
#pragma unroll
            for (int j = 0; j < 8; ++j) { const f32x4 g = gn[64 * j], b = bn[64 * j]; const f32x4 t = xv[j] * rstd * g + b; v2u o; o.x = pk2(t.x, t.y); o.y = pk2(t.z, t.w); uo[64 * j] = o; }
        }
    }
}

struct SeqInfo { int base, L, s0, b, cfirst, clast; bool col, ctx; };
__device__ __forceinline__ SeqInfo seq_info(int c, int layer) {
    SeqInfo q;
    if (c < 64) { q.b = c >> 2; q.s0 = (c & 3) * 64; q.L = L_CTX; q.base = q.b * L_CTX; q.col = false; q.ctx = true; q.cfirst = c & ~3; q.clast = q.cfirst + 3; }
    else { const int cc = c - 64; q.b = cc >> 6; q.s0 = (cc & 63) * 64; q.L = L_LAT; q.base = M_CTX + q.b * L_LAT; q.col = (layer & 1) != 0; q.ctx = false; q.cfirst = 64 + (cc & ~63); q.clast = q.cfirst + 63; }
    return q;
}
__device__ __forceinline__ int tok_of(const SeqInfo& q, int s) { return q.base + (q.col ? (((s & 63) << 6) | (s >> 6)) : s); }

typedef float f32x16 __attribute__((ext_vector_type(16)));
typedef short bf16x8v __attribute__((ext_vector_type(8)));
typedef __bf16 bf16v2 __attribute__((ext_vector_type(2)));
__device__ __forceinline__ unsigned pkbf(float lo, float hi) { const bf16v2 t = __builtin_convertvector((f32x2){lo, hi}, bf16v2); return __builtin_bit_cast(unsigned, t); }
constexpr int XROW = 144;
constexpr int XT_BYTES = 10240;
constexpr int HT_BYTES = 9216;
constexpr int WAVE_LDS = XT_BYTES + HT_BYTES;

__device__ __forceinline__ void stage_tile(const bf16* src, const SeqInfo& q, int pos0, int nrows, LAS unsigned char* xt, int lane) {
    const int sub = lane & 7, rsel = lane >> 3;
#pragma unroll
    for (int r0 = 0; r0 < 72; r0 += 8) {
        const int rr = r0 + rsel, s = pos0 + rr;
        v4u val = (v4u){0u, 0u, 0u, 0u};
        if (rr < nrows && s >= 0 && s < q.L) val = *(const v4u*)(src + (size_t)tok_of(q, s) * DIN + sub * 8);
        if (rr < nrows) *(LAS v4u*)(xt + rr * XROW + sub * 16) = val;
    }
}

template <bool FINAL, int DIR>
__device__ __forceinline__ void scan_dir(const Args& a, int layer, int h, int c, const SeqInfo& q, LAS unsigned char* xt, LAS unsigned char* hft, int lane, float hin0, float hin1) {
    const int ld = layer * 2 + DIR, r = lane & 31, hh = lane >> 5;
    bf16x8v afr[2][4];
#pragma unroll
    for (int ks = 0; ks < 4; ++ks) {
        const int i0 = 16 * ks + 8 * hh;
        const float* cw = a.in[I_RCW] + (size_t)(ld * 4) * DRNN + h * 64 + i0;
        f32x4 w[4][2];
#pragma unroll
        for (int k = 0; k < 4; ++k) { w[k][0] = *(const f32x4*)(cw + k * DRNN); w[k][1] = *(const f32x4*)(cw + k * DRNN + 4); }
        const f32x4 b0 = *(const f32x4*)(a.in[I_RCB] + ld * DRNN + h * 64 + i0), b1 = *(const f32x4*)(a.in[I_RCB] + ld * DRNN + h * 64 + i0 + 4);
#pragma unroll
        for (int tb = 0; tb < 2; ++tb) {
            const int t = tb * 32 + r;
            f32x4 a0 = b0, a1 = b1;
#pragma unroll
            for (int k = 0; k < 4; ++k) {
                const int rr = DIR ? (t + 6 - k) : (t + k);
                const v4u raw = *(const LAS v4u*)(xt + rr * XROW + i0 * 2);
                a0 += w[k][0] * (f32x4){bflo(raw.x), bfhi(raw.x), bflo(raw.y), bfhi(raw.y)};
                a1 += w[k][1] * (f32x4){bflo(raw.z), bfhi(raw.z), bflo(raw.w), bfhi(raw.w)};
            }
            v4u p; p.x = pkbf(a0.x, a0.y); p.y = pkbf(a0.z, a0.w); p.z = pkbf(a1.x, a1.y); p.w = pkbf(a1.z, a1.w);
            afr[tb][ks] = __builtin_bit_cast(bf16x8v, p);
        }
    }
    const bf16* gatew = (const bf16*)(a.ws + WS_GATEW);
    f32x2* summ = (f32x2*)(a.ws + WS_SUMM);
    float* nstate = a.out + (size_t)M * D;
#pragma unroll
    for (int cb = 0; cb < 2; ++cb) {
        const int chh = cb * 32 + r, ch = h * 64 + chh;
        bf16x8v bfr[2][4];
#pragma unroll
        for (int gate = 0; gate < 2; ++gate)
#pragma unroll
            for (int ks = 0; ks < 4; ++ks) bfr[gate][ks] = *(const bf16x8v*)(gatew + ((size_t)((ld * 2 + gate) * NH + h) * 64 + chh) * 64 + 16 * ks + 8 * hh);
        const float ba = a.in[I_RBA][ld * DRNN + ch], bx = a.in[I_RBX][ld * DRNN + ch];
        const float c8l2 = -8.f * 1.4426950408889634f * log1pf(__expf(-a.in[I_RLAM][ld * DRNN + ch]));
        const float cw0 = a.in[I_RCW][(ld * 4 + 0) * DRNN + ch], cw1 = a.in[I_RCW][(ld * 4 + 1) * DRNN + ch], cw2 = a.in[I_RCW][(ld * 4 + 2) * DRNN + ch], cw3 = a.in[I_RCW][(ld * 4 + 3) * DRNN + ch];
        const float cbias = a.in[I_RCB][ld * DRNN + ch];
        float hstate = FINAL ? (cb ? hin1 : hin0) : 0.f, Atot = 1.f;
        const bool first_mine = (hh == DIR);
#pragma unroll
        for (int tbi = 0; tbi < 2; ++tbi) {
            constexpr int dummy = 0; (void)dummy;
            const int tb = DIR ? 1 - tbi : tbi;
            f32x16 accr, acci;
#pragma unroll
            for (int i = 0; i < 16; ++i) { accr[i] = 0.f; acci[i] = 0.f; }
#pragma unroll
            for (int ks = 0; ks < 4; ++ks) {
                accr = __builtin_amdgcn_mfma_f32_32x32x16_bf16(afr[tb][ks], bfr[0][ks], accr, 0, 0, 0);
                acci = __builtin_amdgcn_mfma_f32_32x32x16_bf16(afr[tb][ks], bfr[1][ks], acci, 0, 0, 0);
            }
            float av[16], vv[16];
#pragma unroll
            for (int gq = 0; gq < 4; ++gq) {
                const int t0 = tb * 32 + 8 * gq + 4 * hh;
                const int rbase = DIR ? t0 + 3 : t0;
                float xw[7];
#pragma unroll
                for (int m = 0; m < 7; ++m) xw[m] = bf2f(*(const LAS unsigned short*)(xt + (rbase + m) * XROW + chh * 2));
#pragma unroll
                for (int e = 0; e < 4; ++e) {
                    const int qi = 4 * gq + e;
                    const float xc = DIR ? (cbias + cw0 * xw[e + 3] + cw1 * xw[e + 2] + cw2 * xw[e + 1] + cw3 * xw[e])
                                         : (cbias + cw0 * xw[e] + cw1 * xw[e + 1] + cw2 * xw[e + 2] + cw3 * xw[e + 3]);
                    const float rg = __builtin_amdgcn_rcpf(1.f + __builtin_amdgcn_exp2f(-1.4426950408889634f * (accr[qi] + ba)));
                    const float ig = __builtin_amdgcn_rcpf(1.f + __builtin_amdgcn_exp2f(-1.4426950408889634f * (acci[qi] + bx)));
                    const float aa = __builtin_amdgcn_exp2f(c8l2 * rg);
                    av[qi] = aa; vv[qi] = __builtin_amdgcn_sqrtf(fmaxf(0.f, 1.f - aa * aa)) * ig * xc;
                }
            }
            float Ao[4], Ho[4], pA[4], pH[4];
#pragma unroll
            for (int gq = 0; gq < 4; ++gq) {
                float A_ = 1.f, H_ = 0.f;
#pragma unroll
                for (int ei = 0; ei < 4; ++ei) { const int qi = 4 * gq + (DIR ? 3 - ei : ei); H_ = av[qi] * H_ + vv[qi]; A_ *= av[qi]; }
                Ao[gq] = A_; Ho[gq] = H_; pA[gq] = __shfl_xor(A_, 32); pH[gq] = __shfl_xor(H_, 32);
            }
#pragma unroll
            for (int gqi = 0; gqi < 4; ++gqi) {
                const int gq = DIR ? 3 - gqi : gqi;
                const float pre = first_mine ? hstate : (pA[gq] * hstate + pH[gq]);
                float post;
                if (FINAL) {
                    float hs = pre;
#pragma unroll
                    for (int ei = 0; ei < 4; ++ei) { const int e = DIR ? 3 - ei : ei, qi = 4 * gq + e; hs = av[qi] * hs + vv[qi];
                        LAS unsigned short* hp = (LAS unsigned short*)(hft + (tb * 32 + 8 * gq + 4 * hh + e) * XROW + chh * 2);
                        if (DIR == 0) *hp = (unsigned short)f2bf(hs); else *hp = (unsigned short)f2bf(bf2f(*hp) + hs); }
                    post = hs;
                } else { post = Ao[gq] * pre + Ho[gq]; Atot *= Ao[gq] * pA[gq]; }
                hstate = first_mine ? (pA[gq] * post + pH[gq]) : post;
            }
        }
        if (!FINAL) { if (hh == 0) summ[(size_t)(c * 2 + DIR) * DRNN + ch] = (f32x2){Atot, hstate}; }
        else if (q.ctx && hh == 0 && c == (DIR ? q.cfirst : q.clast)) nstate[((size_t)(q.b * DEPTH + layer) * 2 + DIR) * DRNN + ch] = hstate;
    }
}

__device__ __forceinline__ void scan_summary_item(const Args& a, int layer, int item, int lane, LAS unsigned char* xt) {
    const int d = item & 1, h = (item >> 1) & 15, c = item >> 5;
    const SeqInfo q = seq_info(c, layer);
    stage_tile((const bf16*)(a.ws + WS_BIG) + 3 * DCONV + h * 64, q, q.s0 - 3, 70, xt, lane);
    if (d == 0) scan_dir<false, 0>(a, layer, h, c, q, xt, xt, lane, 0.f, 0.f);
    else scan_dir<false, 1>(a, layer, h, c, q, xt, xt, lane, 0.f, 0.f);
}

__device__ __forceinline__ float carry_in(const Args& a, const SeqInfo& q, int layer, int c, int d, int ch) {
    const f32x2* summ = (const f32x2*)(a.ws + WS_SUMM);
    float hin = q.ctx ? 0.f : a.in[I_STATE][((size_t)(q.b * DEPTH + layer) * 2 + d) * DRNN + ch];
    const int n = d ? (q.clast - c) : (c - q.cfirst);
    for (int i0 = 0; i0 < n; i0 += 8) {
        f32x2 t[8];
#pragma unroll
        for (int k = 0; k < 8; ++k) { const int i = i0 + k; const int cc = d ? (q.clast - i) : (q.cfirst + i); t[k] = (i < n) ? summ[(size_t)(cc * 2 + d) * DRNN + ch] : (f32x2){1.f, 0.f}; }
#pragma unroll
        for (int k = 0; k < 8; ++k) hin = t[k].x * hin + t[k].y;
    }
    return hin;
}

__device__ __forceinline__ void mixb_item(const Args& a, int layer, int item, int lane, LAS unsigned char* xt) {
    const int h = item & 15, c = item >> 4, r = lane & 31, hh = lane >> 5;
    const SeqInfo q = seq_info(c, layer);
    const bf16* proj = (const bf16*)(a.ws + WS_BIG);
    stage_tile(proj + 3 * DCONV + h * 64, q, q.s0 - 3, 70, xt, lane);
    LAS unsigned char* hft = xt + XT_BYTES;
    {
        const float hl = carry_in(a, q, layer, c, 0, h * 64 + lane);
        scan_dir<true, 0>(a, layer, h, c, q, xt, hft, lane, __shfl(hl, r), __shfl(hl, 32 + r));
    }
    {
        const float hl = carry_in(a, q, layer, c, 1, h * 64 + lane);
        scan_dir<true, 1>(a, layer, h, c, q, xt, hft, lane, __shfl(hl, r), __shfl(hl, 32 + r));
    }
    stage_tile(proj + 3 * DCONV + DRNN + h * 64, q, q.s0, 64, xt, lane);
#pragma unroll
    for (int tb = 0; tb < 2; ++tb)
#pragma unroll
        for (int cb = 0; cb < 2; ++cb)
#pragma unroll
            for (int qi = 0; qi < 16; ++qi) {
                const int t = tb * 32 + (qi & 3) + 8 * (qi >> 2) + 4 * hh;
                const int off = t * XROW + (cb * 32 + r) * 2;
                const float g = bf2f(*(const LAS unsigned short*)(xt + off));
                LAS unsigned short* p = (LAS unsigned short*)(hft + off);
                *p = (unsigned short)f2bf(bf2f(*p) * gelu_tanh(g));
            }
    bf16* ymix = (bf16*)(a.ws + WS_A) + DCONV + h * 64;
    const int sub = lane & 7, rsel = lane >> 3;
#pragma unroll
    for (int r0 = 0; r0 < 64; r0 += 8) {
        const int rr = r0 + rsel;
        const v4u val = *(const LAS v4u*)(hft + rr * XROW + sub * 16);
        *(v4u*)(ymix + (size_t)tok_of(q, q.s0 + rr) * D + sub * 8) = val;
    }
}

__device__ __forceinline__ void mixa_item(const Args& a, int layer, int item, int lane) {
    const int g4 = item & 3, c = item >> 2, ch0 = g4 * 256 + lane * 4;
    const SeqInfo q = seq_info(c, layer);
    const bf16* proj = (const bf16*)(a.ws + WS_BIG);
    bf16* ymix = (bf16*)(a.ws + WS_A);
    const f32x4 w0 = *(const f32x4*)(a.in[I_CONVA] + (size_t)(layer * 3 + 0) * DCONV + ch0);
    const f32x4 w1 = *(const f32x4*)(a.in[I_CONVA] + (size_t)(layer * 3 + 1) * DCONV + ch0);
    const f32x4 w2 = *(const f32x4*)(a.in[I_CONVA] + (size_t)(layer * 3 + 2) * DCONV + ch0);
    auto cx_at = [&](int s) -> f32x4 {
        if (s < 0 || s >= q.L) return (f32x4){0.f, 0.f, 0.f, 0.f};
        const bf16* row = proj + (size_t)tok_of(q, s) * DIN + ch0;
        const v2u cg = *(const v2u*)(row + DCONV), xa = *(const v2u*)(row + 2 * DCONV);
        return (f32x4){bflo(cg.x) * bflo(xa.x), bfhi(cg.x) * bfhi(xa.x), bflo(cg.y) * bflo(xa.y), bfhi(cg.y) * bfhi(xa.y)};
    };
    f32x4 cm = cx_at(q.s0 - 1), cc = cx_at(q.s0);
    for (int blk = 0; blk < 8; ++blk) {
        f32x4 cn[8]; v2u bg[8];
#pragma unroll
        for (int e = 0; e < 8; ++e) { const int s = q.s0 + 8 * blk + e; cn[e] = cx_at(s + 1); bg[e] = *(const v2u*)(proj + (size_t)tok_of(q, s) * DIN + ch0); }
#pragma unroll
        for (int e = 0; e < 8; ++e) {
            const int s = q.s0 + 8 * blk + e;
            const f32x4 hv = w0 * cm + w1 * cc + w2 * cn[e];
            const f32x4 bv = (f32x4){bflo(bg[e].x), bfhi(bg[e].x), bflo(bg[e].y), bfhi(bg[e].y)};
            const f32x4 o = bv * hv;
            v2u ov; ov.x = pk2(o.x, o.y); ov.y = pk2(o.z, o.w);
            *(v2u*)(ymix + (size_t)tok_of(q, s) * D + ch0) = ov;
            cm = cc; cc = cn[e];
        }
    }
}

__device__ __forceinline__ void convgate_item(const Args& a, int layer, int chunk, int item, int lane) {
    const int cgp = item % 12, rb = item / 12, r0 = rb * 8, ch0 = cgp * 512 + lane * 8;
    const int seqlen = (chunk == 0) ? L_CTX : L_LAT;
    const bf16* hp = (const bf16*)(a.ws + WS_HPRE) + (size_t)((ch0 >> 7) * 256 + (ch0 & 127));
    bf16* act = (bf16*)(a.ws + WS_BIG) + (size_t)(chunk * 4096) * DFF + ch0;
    const float* cw = a.in[I_FCW] + (size_t)layer * 3 * NUP;
    float wg[3][8], wv[3][8];
#pragma unroll
    for (int t = 0; t < 3; ++t)
#pragma unroll
        for (int e = 0; e < 8; ++e) { wg[t][e] = cw[t * NUP + ch0 + e]; wv[t][e] = cw[t * NUP + DFF + ch0 + e]; }
    v4u rg[10], rv[10];
#pragma unroll
    for (int i = 0; i < 10; ++i) {
        const int r = r0 - 1 + i;
        const bool ok = (i == 0) ? ((r0 % seqlen) != 0) : (i == 9) ? (((r0 + 8) % seqlen) != 0) : true;
        if (ok) { rg[i] = *(const v4u*)(hp + (size_t)r * NUP); rv[i] = *(const v4u*)(hp + (size_t)r * NUP + 128); }
        else { rg[i] = (v4u){0u, 0u, 0u, 0u}; rv[i] = (v4u){0u, 0u, 0u, 0u}; }
    }
#pragma unroll
    for (int i = 1; i <= 8; ++i) {
        float o[8];
#pragma unroll
        for (int e2 = 0; e2 < 4; ++e2) {
            const unsigned gm = rg[i - 1][e2], gc = rg[i][e2], gn = rg[i + 1][e2], vm = rv[i - 1][e2], vc = rv[i][e2], vn = rv[i + 1][e2];
            const float hg0 = wg[0][2 * e2] * bflo(gm) + wg[1][2 * e2] * bflo(gc) + wg[2][2 * e2] * bflo(gn);
            const float hg1 = wg[0][2 * e2 + 1] * bfhi(gm) + wg[1][2 * e2 + 1] * bfhi(gc) + wg[2][2 * e2 + 1] * bfhi(gn);
            const float hv0 = wv[0][2 * e2] * bflo(vm) + wv[1][2 * e2] * bflo(vc) + wv[2][2 * e2] * bflo(vn);
            const float hv1 = wv[0][2 * e2 + 1] * bfhi(vm) + wv[1][2 * e2 + 1] * bfhi(vc) + wv[2][2 * e2 + 1] * bfhi(vn);
            o[2 * e2] = gelu_tanh(hg0) * hv0; o[2 * e2 + 1] = gelu_tanh(hg1) * hv1;
        }
        v4u ov; ov.x = pk2(o[0], o[1]); ov.y = pk2(o[2], o[3]); ov.z = pk2(o[4], o[5]); ov.w = pk2(o[6], o[7]);
        *(v4u*)(act + (size_t)(r0 + i - 1) * DFF) = ov;
    }
}

__device__ __forceinline__ void ffn_fixup(const Args& a, int layer, int gtid, int nthreads) {
    const float* edge = (const float*)(a.ws + WS_EDGE);
    const float* cw = a.in[I_FCW] + (size_t)layer * 3 * NUP;
    bf16* act = (bf16*)(a.ws + WS_BIG);
    for (int it = gtid; it < NB_LAT * 15 * (DFF / 4) * 2; it += nthreads) {
        const int which = it & 1, cq = (it >> 1) % (DFF / 4), bi = (it >> 1) / (DFF / 4);
        const int pm = 16 + (bi / 15) * 16 + (bi % 15), chn = 4 * cq, ug = (chn >> 7) * 256 + (chn & 127);
        const float* e0 = edge + (size_t)pm * 4 * NUP, * e1 = edge + (size_t)(pm + 1) * 4 * NUP;
        const float* pp = which ? e0 + 3 * (size_t)NUP : e0 + 2 * (size_t)NUP;
        const float* pc = which ? e1 : e0 + 3 * (size_t)NUP;
        const float* pn = which ? e1 + NUP : e1;
        f32x4 hg = *(const f32x4*)(cw + chn) * *(const f32x4*)(pp + ug) + *(const f32x4*)(cw + NUP + chn) * *(const f32x4*)(pc + ug) + *(const f32x4*)(cw + 2 * (size_t)NUP + chn) * *(const f32x4*)(pn + ug);
        f32x4 hv = *(const f32x4*)(cw + DFF + chn) * *(const f32x4*)(pp + ug + 128) + *(const f32x4*)(cw + NUP + DFF + chn) * *(const f32x4*)(pc + ug + 128) + *(const f32x4*)(cw + 2 * (size_t)NUP + DFF + chn) * *(const f32x4*)(pn + ug + 128);
        const size_t R = (size_t)pm * 256 + 255 + which;
        v2u o; o.x = pk2(gelu_tanh(hg.x) * hv.x, gelu_tanh(hg.y) * hv.y); o.y = pk2(gelu_tanh(hg.z) * hv.z, gelu_tanh(hg.w) * hv.w);
        *(v2u*)(act + R * DFF + chn) = o;
    }
}

constexpr int PH_PRE = 0, PH_NORM0 = 1, PH_LAYER0 = 2, NPL = 9, N_PHASES = PH_LAYER0 + DEPTH * NPL;

__global__ void __launch_bounds__(NWAVES * 64, 2) fwd_kernel(Args args) {
    extern __shared__ __attribute__((aligned(16))) unsigned char lds_raw[];
    LAS unsigned char* lds = (LAS unsigned char*)lds_raw;
    volatile LAS unsigned* MISC = (volatile LAS unsigned*)(lds + MISC_OFF);
    const int G = gridDim.x, NGW = G * NWAVES;
    const int lo = args.ph_lo, hi = args.ph_hi;
#define PHASE_IDS int tid = threadIdx.x; asm volatile("" : "+v"(tid)); const int lane = tid & 63, wave = __builtin_amdgcn_readfirstlane(tid >> 6), gw = blockIdx.x * NWAVES + wave; (void)lane; (void)gw;
    if (threadIdx.x < 32) MISC[threadIdx.x] = 0u;
    __syncthreads();
    XcdBarrier bar; bar.bar = (unsigned*)(args.ws + WS_CTL) + CW_BAR; bar.x = 0; bar.st = nullptr;
    if (hi - lo > 1) bar = xcd_barrier_post((unsigned*)(args.ws + WS_CTL) + CW_BAR, MISC + 8);
#define IN(k) (lo <= (k) && (k) < hi)
#define SEAM(k) do { if (IN(k) && IN((k) + 1)) xcd_barrier(bar); } while (0)
    unsigned char* ws = args.ws;

    if (IN(PH_PRE)) { for (int rep = 0; rep < args.rep[4]; ++rep) { PHASE_IDS pre_transposes(args, lds, gw, NGW, wave, lane); __syncthreads(); pre_mod(args, lds, tid, wave, lane); __syncthreads(); } }
    SEAM(PH_PRE);
    if (IN(PH_NORM0)) { PHASE_IDS resnorm_rows<false, true>(args, gw, NGW, lane, args.in[I_XP], args.in[I_XS], nullptr, 0, 0, 0); }
    SEAM(PH_NORM0);

    for (int l = 0; l < DEPTH; ++l) {
        const int pb = PH_LAYER0 + l * NPL;
        const bf16* wl = (const bf16*)(ws + WS_W + (size_t)l * W_LAYER);
        if (IN(pb + 0)) for (int rep = 0; rep < args.rep[0]; ++rep) {
            pg8::Gemm g{(const bf16*)(ws + WS_A), (const bf16*)((const unsigned char*)wl + W_IN_OFF), M, DIN, D}; pg8::StaticOrder S; S.init(M, DIN, G, (int)blockIdx.x);
            pg8::EpiBf16Store E{(bf16*)(ws + WS_BIG), DIN};
            pg8::gemm_phase<pg8::EpiBf16Store, pg8::StaticOrder, true, true>(lds, lds + RING_BYTES, g, S, E);
        }
        SEAM(pb + 0);
        if (IN(pb + 1)) for (int rep = 0; rep < args.rep[1]; ++rep) { PHASE_IDS LAS unsigned char* xt = lds + wave * WAVE_LDS; for (int it = gw; it < NCHUNK * NH * 2; it += NGW) scan_summary_item(args, l, it, lane, xt); }
        SEAM(pb + 1);
        if (IN(pb + 2)) for (int rep = 0; rep < args.rep[2]; ++rep) {
            PHASE_IDS
            LAS unsigned char* xt = lds + wave * WAVE_LDS;
            for (int it = gw; it < NCHUNK * NH + NCHUNK * 4; it += NGW) { if (it < NCHUNK * NH) mixb_item(args, l, it, lane, xt); else mixa_item(args, l, it - NCHUNK * NH, lane); }
        }
        SEAM(pb + 2);
        if (IN(pb + 3)) for (int rep = 0; rep < args.rep[0]; ++rep) {
            pg8::Gemm g{(const bf16*)(ws + WS_A), (const bf16*)((const unsigned char*)wl + W_OUT_OFF), M, D, D}; pg8::StaticOrder S; S.init(M, D, G, (int)blockIdx.x);
            pg8::EpiF32Store E{(float*)(ws + WS_Y), D};
            pg8::gemm_phase<pg8::EpiF32Store, pg8::StaticOrder, true, true>(lds, lds + RING_BYTES, g, S, E);
        }
        SEAM(pb + 3);
        if (IN(pb + 4)) { PHASE_IDS resnorm_rows<true, true>(args, gw, NGW, lane, args.out, args.out + (size_t)M_CTX * D, (const float*)(ws + WS_Y), l, 2, l); }
        SEAM(pb + 4);
        if (IN(pb + 5)) for (int rep = 0; rep < args.rep[0]; ++rep) {
            pg8::Gemm g{(const bf16*)(ws + WS_A), (const bf16*)((const unsigned char*)wl + W_UP_OFF), M, NUP, D}; pg8::StaticOrder S; S.init(M, NUP, G, (int)blockIdx.x);
            pg8::EpiConvGate E{(bf16*)(ws + WS_BIG), DFF, args.in[I_FCW] + (size_t)l * 3 * NUP, (float*)(ws + WS_EDGE), NUP, DFF};
            pg8::gemm_phase<pg8::EpiConvGate, pg8::StaticOrder, true, true>(lds, lds + RING_BYTES, g, S, E);
        }
        SEAM(pb + 5);
        if (IN(pb + 6)) { PHASE_IDS ffn_fixup(args, l, blockIdx.x * (NWAVES * 64) + tid, G * NWAVES * 64); }
        SEAM(pb + 6);
        if (IN(pb + 7)) for (int rep = 0; rep < args.rep[0]; ++rep) {
            pg8::Gemm g{(const bf16*)(ws + WS_BIG), (const bf16*)((const unsigned char*)wl + W_DOWN_OFF), M, D, DFF}; pg8::StaticOrder S; S.init(M, D, G, (int)blockIdx.x);
            pg8::EpiF32Store E{(float*)(ws + WS_Y), D};
            pg8::gemm_phase<pg8::EpiF32Store, pg8::StaticOrder, true, true>(lds, lds + RING_BYTES, g, S, E);
        }
        SEAM(pb + 7);
        if (IN(pb + 8)) {
            PHASE_IDS
            if (l + 1 < DEPTH) resnorm_rows<true, true>(args, gw, NGW, lane, args.out, args.out + (size_t)M_CTX * D, (const float*)(ws + WS_Y), l, 5, l + 1);
            else resnorm_rows<true, false>(args, gw, NGW, lane, args.out, args.out + (size_t)M_CTX * D, (const float*)(ws + WS_Y), l, 5, l);
        }
        if (l + 1 < DEPTH) SEAM(pb + 8);
    }
#undef IN
#undef SEAM
}

extern "C" void kernel_launch(void* const* d_in, const int* in_sizes, int n_in, void* d_out, int out_size, void* d_ws, size_t ws_size, hipStream_t stream) {
    static int grid = 0;
    if (grid == 0) {
        if (n_in != 21 || ws_size < WS_END) { fprintf(stderr, "kernel_launch: expected 21 inputs and >= %zu bytes of workspace; got n_in %d, ws %zu\n", (size_t)WS_END, n_in, ws_size); grid = -1; return; }
        int dev = 0, cus = 0, per_cu = 0;
        if (hipGetDevice(&dev) != hipSuccess || hipDeviceGetAttribute(&cus, hipDeviceAttributeMultiprocessorCount, dev) != hipSuccess) { grid = -1; return; }
        if (hipFuncSetAttribute((const void*)fwd_kernel, hipFuncAttributeMaxDynamicSharedMemorySize, LDS_BYTES) != hipSuccess) { fprintf(stderr, "kernel_launch: hipFuncSetAttribute failed\n"); grid = -1; return; }
        if (hipOccupancyMaxActiveBlocksPerMultiprocessor(&per_cu, (const void*)fwd_kernel, NWAVES * 64, LDS_BYTES) != hipSuccess || per_cu < 1) { fprintf(stderr, "kernel_launch: occupancy query reports %d blocks per CU\n", per_cu); }
        (void)hipGetLastError();
        grid = cus;
    }
    if (grid < 0) return;
    (void)hipMemsetAsync((char*)d_ws + WS_CTL, 0, CTL_ZERO_BYTES, stream);
    Args a{};
    for (int i = 0; i < 21; ++i) a.in[i] = (const float*)d_in[i];
    a.out = (float*)d_out; a.ws = (unsigned char*)d_ws;
    for (int i = 0; i < 6; ++i) a.rep[i] = ((PROBE_DUP >> i) & 1) ? 2 : 1;
#if MK_SINGLE
    a.ph_lo = 0; a.ph_hi = N_PHASES;
    hipLaunchKernelGGL(fwd_kernel, dim3(grid), dim3(NWAVES * 64), LDS_BYTES, stream, a);
#else
    for (int p = 0; p < N_PHASES; ++p) { a.ph_lo = p; a.ph_hi = p + 1; hipLaunchKernelGGL(fwd_kernel, dim3(grid), dim3(NWAVES * 64), LDS_BYTES, stream, a); }
#endif
}
```

```cpp
#include <hip/hip_runtime.h>
#include <cstdio>
#include <cstdint>

#ifndef PROBE_DUP
#define PROBE_DUP 0
#endif
#ifndef MK_SINGLE
#define MK_SINGLE 1
#endif

namespace pg8 {
#define PG8_LAS __attribute__((address_space(3)))
typedef unsigned short bf16_t;
typedef short bf16x8 __attribute__((ext_vector_type(8)));
typedef float f32x4 __attribute__((ext_vector_type(4)));
typedef unsigned u32x4 __attribute__((ext_vector_type(4)));
constexpr int BM = 256, BK = 64, HALF = 128, HTB = HALF * BK * 2, STAGE_BYTES = 8 * HTB, NXCD = 8, WGM = 8;

__host__ __device__ __forceinline__ int lds_byte(int r, int c) { const int st = (r >> 4) * 2 + (c >> 5), rr = r & 15, cc = c & 31, ob = rr * 64 + cc * 2; return st * 1024 + (ob ^ (((ob >> 9) & 1) << 5)); }
__host__ __device__ __forceinline__ void stage_rc(int b, int& R, int& C) { const int st = b / 1024, sb = b % 1024, swz = sb ^ (((sb >> 9) & 1) << 5); R = (st >> 1) * 16 + swz / 64; C = (st & 1) * 32 + (swz % 64) / 2; }
__host__ __device__ __forceinline__ int perm32(int rho) { const int n = rho >> 4, i = rho & 15; return 8 * (i >> 2) + 4 * n + (i & 3); }

struct Unit { int pm, pn; };
struct Gemm { const bf16_t* A; const bf16_t* Bt; int M, N, K; };

struct StaticOrder {
    int nM, nN, nwg, G, c;
    __host__ __device__ void init(int M, int N, int G_, int c_) { nM = M / BM; nN = N / BM; nwg = nM * nN; G = G_; c = c_; }
    __host__ __device__ bool next(int i, Unit& u) const {
        const long L = (long)i * G + c; if (L >= nwg) return false;
        int wgid = (int)L; { const int q = nwg / NXCD, r = nwg % NXCD, xcd = wgid % NXCD, off = wgid / NXCD; wgid = (xcd < r ? xcd * (q + 1) : r * (q + 1) + (xcd - r) * q) + off; }
        const int nig = WGM * nN, gid = wgid / nig, fm = gid * WGM, gsz = (nM - fm) < WGM ? (nM - fm) : WGM;
        u.pm = fm + ((wgid % nig) % gsz); u.pn = (wgid % nig) / gsz; return true;
    }
    __device__ __forceinline__ void a_ready(const Unit&) const {}
    __device__ __forceinline__ void done(const Unit&) const {}
};

__device__ __forceinline__ unsigned cvt_pk_bf16(float lo, float hi) { unsigned r; asm volatile("v_cvt_pk_bf16_f32 %0, %1, %2" : "=v"(r) : "v"(lo), "v"(hi)); return r; }

struct EpiBf16Store {
    static constexpr bool PERM = true, AFTER_DRAIN = false;
    bf16_t* O; int ldc;
    __device__ __forceinline__ void operator()(const f32x4 (&acc)[2][2][4][2], const Unit& u, int wr, int wc, int fr, int fq, PG8_LAS unsigned char*) const {
        const int row0 = u.pm * BM + wr * 64 + fr, col0 = u.pn * BM + wc * 32 + 8 * fq;
#pragma unroll
        for (int ai = 0; ai < 2; ++ai)
#pragma unroll
            for (int m = 0; m < 4; ++m) { bf16_t* rowp = O + (size_t)(row0 + ai * HALF + m * 16) * ldc + col0;
#pragma unroll
                for (int bj = 0; bj < 2; ++bj) { const f32x4 v0 = acc[ai][bj][m][0], v1 = acc[ai][bj][m][1];
                    u32x4 w; w.x = cvt_pk_bf16(v0[0], v0[1]); w.y = cvt_pk_bf16(v0[2], v0[3]); w.z = cvt_pk_bf16(v1[0], v1[1]); w.w = cvt_pk_bf16(v1[2], v1[3]);
                    *(u32x4*)(rowp + bj * HALF) = w; } }
    }
};
struct EpiF32Store {
    static constexpr bool PERM = false, AFTER_DRAIN = false;
    float* C; int ldc;
    __device__ __forceinline__ void operator()(const f32x4 (&acc)[2][2][4][2], const Unit& u, int wr, int wc, int fr, int fq, PG8_LAS unsigned char*) const {
        const int row0 = u.pm * BM + wr * 64 + fr, col0 = u.pn * BM + wc * 32 + 4 * fq;
#pragma unroll
        for (int ai = 0; ai < 2; ++ai)
#pragma unroll
            for (int m = 0; m < 4; ++m) { float* rowp = C + (size_t)(row0 + ai * HALF + m * 16) * ldc + col0;
#pragma unroll
                for (int bj = 0; bj < 2; ++bj)
#pragma unroll
                    for (int n = 0; n < 2; ++n) *(f32x4*)(rowp + bj * HALF + n * 16) = acc[ai][bj][m][n]; }
    }
};


#ifndef EPI_DPP
#define EPI_DPP 1
#endif
__device__ __forceinline__ float rotr1_16(float x, int lane) {
#if EPI_DPP
    return __builtin_bit_cast(float, __builtin_amdgcn_update_dpp(0, __builtin_bit_cast(int, x), 0x121, 0xF, 0xF, false));
#else
    return __shfl(x, (lane & 48) | ((lane + 15) & 15));
#endif
}
__device__ __forceinline__ float rotl1_16(float x, int lane) {
#if EPI_DPP
    return __builtin_bit_cast(float, __builtin_amdgcn_update_dpp(0, __builtin_bit_cast(int, x), 0x12F, 0xF, 0xF, false));
#else
    return __shfl(x, (lane & 48) | ((lane + 1) & 15));
#endif
}
__device__ __forceinline__ float gelu_tanh_f(float x) { const float u = 1.5957691216057308f * (x + 0.044715f * x * x * x); return x * __builtin_amdgcn_rcpf(1.f + __builtin_amdgcn_exp2f(-1.4426950408889634f * u)); }
struct EpiConvGate {
    static constexpr bool PERM = true, AFTER_DRAIN = false;
    bf16_t* act; int ldc; const float* cw; float* edge; int nup, dff;
    __device__ __forceinline__ void operator()(const f32x4 (&acc)[2][2][4][2], const Unit& u, int wr, int wc, int fr, int fq, PG8_LAS unsigned char* xlds) const {
        PG8_LAS float* ex = (PG8_LAS float*)xlds;
        const int lane = fq * 16 + fr, ucol = wc * 32 + 8 * fq;
#pragma unroll
        for (int ai = 0; ai < 2; ++ai)
#pragma unroll
            for (int bj = 0; bj < 2; ++bj)
#pragma unroll
                for (int n = 0; n < 2; ++n) {
                    if (fr == 0)  *(PG8_LAS f32x4*)(ex + (2 * (2 * ai + wr) + 0) * 256 + 128 * bj + ucol + 4 * n) = acc[ai][bj][0][n];
                    if (fr == 15) *(PG8_LAS f32x4*)(ex + (2 * (2 * ai + wr) + 1) * 256 + 128 * bj + ucol + 4 * n) = acc[ai][bj][3][n];
                }
        float* eb = edge + (size_t)u.pm * 4 * nup + u.pn * 256 + ucol;
        if (wr == 0 && fr < 2) {
#pragma unroll
            for (int bj = 0; bj < 2; ++bj)
#pragma unroll
                for (int n = 0; n < 2; ++n) *(f32x4*)(eb + (size_t)fr * nup + 128 * bj + 4 * n) = acc[0][bj][0][n];
        }
        if (wr == 1 && fr >= 14) {
#pragma unroll
            for (int bj = 0; bj < 2; ++bj)
#pragma unroll
                for (int n = 0; n < 2; ++n) *(f32x4*)(eb + (size_t)(fr - 12) * nup + 128 * bj + 4 * n) = acc[1][bj][3][n];
        }
        PG8_LAS float* wb = ex + 8 * 256;
        { const int tid = (wr * 4 + wc) * 64 + lane;
          if (tid < 192) { const int t = tid >> 6, part = tid & 63, gv = part >> 5, c4 = part & 31;
              *(PG8_LAS f32x4*)(wb + (t * 2 + gv) * 128 + 4 * c4) = *(const f32x4*)(cw + (size_t)t * nup + gv * dff + u.pn * 128 + 4 * c4); } }
        asm volatile("s_waitcnt lgkmcnt(0)" ::: "memory"); __builtin_amdgcn_s_barrier(); asm volatile("" ::: "memory");
        const int chn0 = u.pn * 128 + ucol;
        const int row0 = u.pm * BM + wr * 64 + fr;
#pragma unroll
        for (int n = 0; n < 2; ++n) {
#pragma unroll
            for (int ai = 0; ai < 2; ++ai) {
                const int sp = 2 * (2 * ai + wr) - 1, sn = 2 * (2 * ai + wr) + 2;
                float og[4][4];
#pragma unroll
                for (int bj = 0; bj < 2; ++bj) {
                    const f32x4 bprev = (sp >= 0) ? *(const PG8_LAS f32x4*)(ex + sp * 256 + 128 * bj + ucol + 4 * n) : (f32x4){0.f, 0.f, 0.f, 0.f};
                    const f32x4 bnext = (sn <= 7) ? *(const PG8_LAS f32x4*)(ex + sn * 256 + 128 * bj + ucol + 4 * n) : (f32x4){0.f, 0.f, 0.f, 0.f};
                    const f32x4 w0 = *(const PG8_LAS f32x4*)(wb + (0 * 2 + bj) * 128 + ucol + 4 * n), w1 = *(const PG8_LAS f32x4*)(wb + (1 * 2 + bj) * 128 + ucol + 4 * n),
                                w2 = *(const PG8_LAS f32x4*)(wb + (2 * 2 + bj) * 128 + ucol + 4 * n);
#pragma unroll
                    for (int e = 0; e < 4; ++e) {
                        float x[4], rr[4], rl[4];
#pragma unroll
                        for (int m = 0; m < 4; ++m) { x[m] = acc[ai][bj][m][n][e]; rr[m] = rotr1_16(x[m], lane); rl[m] = rotl1_16(x[m], lane); }
#pragma unroll
                        for (int m = 0; m < 4; ++m) {
                            const float pe = (m > 0) ? rr[m > 0 ? m - 1 : 0] : bprev[e];
                            const float ne = (m < 3) ? rl[m < 3 ? m + 1 : 3] : bnext[e];
                            const float prev = (fr > 0) ? rr[m] : pe, next = (fr < 15) ? rl[m] : ne;
                            const float hv = w0[e] * prev + w1[e] * x[m] + w2[e] * next;
                            if (bj == 0) og[m][e] = gelu_tanh_f(hv); else og[m][e] *= hv;
                        }
                    }
                }
#pragma unroll
                for (int m = 0; m < 4; ++m) {
                    typedef unsigned u32x2 __attribute__((ext_vector_type(2)));
                    u32x2 w2; w2.x = cvt_pk_bf16(og[m][0], og[m][1]); w2.y = cvt_pk_bf16(og[m][2], og[m][3]);
                    *(u32x2*)(act + (size_t)(row0 + ai * HALF + m * 16) * ldc + chn0 + 4 * n) = w2;
                }
            }
        }
    }
};

template <class Epi, class Sched, bool ALIGN_EPI = false, bool SP2 = false>
__device__ __forceinline__ void gemm_phase(PG8_LAS unsigned char* lds, PG8_LAS unsigned char* xlds, const Gemm g, const Sched& S, const Epi& E) {
    int tid = threadIdx.x; asm volatile("" : "+v"(tid));
    const int wid = __builtin_amdgcn_readfirstlane(tid >> 6), lane = tid & 63, wr = wid >> 2, wc = wid & 3, fr = lane & 15, fq = lane >> 4;
    const int K = g.K, nt = K / BK;
    unsigned voffA[2], voffB[2];
#pragma unroll
    for (int i = 0; i < 2; ++i) { int R, C; stage_rc(tid * 16 + i * 8192, R, C); const int Rb = Epi::PERM ? ((R & ~31) + perm32(R & 31)) : R;
        voffA[i] = (unsigned)(R * K + C) * 2u; voffB[i] = (unsigned)(Rb * K + C) * 2u; }
    const size_t kstep = (size_t)(BK * 2);
    const size_t hstep = (size_t)HALF * K * 2;
    const size_t tstep = 2 * hstep;
    const unsigned ldsw = (unsigned)wid * 1024u;
    const int aoff = lds_byte(wr * 64 + fr, fq * 8), boff = lds_byte(wc * 32 + fr, fq * 8);
#define PG8_SA(b, h) (((b) * 2 + (h)) * HTB)
#define PG8_SB(b, h) ((4 + (b) * 2 + (h)) * HTB)
#define PG8_STAGE(bufoff, gbase, voff) do { _Pragma("unroll") for (int _i = 0; _i < 2; ++_i) \
        __builtin_amdgcn_global_load_lds((const unsigned*)((const char*)(gbase) + (voff)[_i]), (PG8_LAS unsigned*)(lds + (bufoff) + ldsw + _i * 8192), 16, 0, 0); } while (0)
#define PG8_LDA(dst, b, h) do { _Pragma("unroll") for (int m = 0; m < 4; ++m) _Pragma("unroll") for (int k = 0; k < 2; ++k) dst[m][k] = *(const PG8_LAS bf16x8*)(lds + PG8_SA(b, h) + aoff + m * 2048 + k * 1024); } while (0)
#define PG8_LDB(dst, b, h) do { _Pragma("unroll") for (int n = 0; n < 2; ++n) _Pragma("unroll") for (int k = 0; k < 2; ++k) dst[n][k] = *(const PG8_LAS bf16x8*)(lds + PG8_SB(b, h) + boff + n * 2048 + k * 1024); } while (0)
#define PG8_MMA(ai, bj, At, Bt) do { __builtin_amdgcn_s_setprio(1); _Pragma("unroll") for (int m = 0; m < 4; ++m) _Pragma("unroll") for (int n = 0; n < 2; ++n) _Pragma("unroll") for (int k = 0; k < 2; ++k) \
        acc[ai][bj][m][n] = __builtin_amdgcn_mfma_f32_16x16x32_bf16(Bt[n][k], At[m][k], acc[ai][bj][m][n], 0, 0, 0); __builtin_amdgcn_s_setprio(0); } while (0)
#define PG8_WAIT_V(n) asm volatile("s_waitcnt vmcnt(" #n ")" ::: "memory")
#define PG8_WAIT_L(n) asm volatile("s_waitcnt lgkmcnt(" #n ")" ::: "memory")
#define PG8_BAR __builtin_amdgcn_s_barrier()
#define PG8_SCHED __builtin_amdgcn_sched_barrier(0)
    Unit cur, nxt; int ui = 0;
    if (!S.next(0, cur)) return;
    f32x4 acc[2][2][4][2];
#pragma unroll
    for (int a = 0; a < 2; ++a)
#pragma unroll
        for (int b = 0; b < 2; ++b)
#pragma unroll
            for (int m = 0; m < 4; ++m)
#pragma unroll
                for (int n = 0; n < 2; ++n) acc[a][b][m][n] = (f32x4){0.f, 0.f, 0.f, 0.f};
    bf16x8 At[4][2], B0[2][2], B1[2][2];
    const char* cA = (const char*)g.A + (size_t)cur.pm * tstep; const char* cB = (const char*)g.Bt + (size_t)cur.pn * tstep;
    S.a_ready(cur);
    if constexpr (SP2) {
        PG8_STAGE(PG8_SB(0, 0), cB, voffB); PG8_STAGE(PG8_SB(0, 1), cB + hstep, voffB); PG8_STAGE(PG8_SA(0, 0), cA, voffA); PG8_STAGE(PG8_SA(0, 1), cA + hstep, voffA);
        if (wr == 1) PG8_BAR;
        PG8_WAIT_V(2); PG8_BAR;
        PG8_STAGE(PG8_SB(1, 0), cB + kstep, voffB); PG8_STAGE(PG8_SA(1, 0), cA + kstep, voffA); PG8_STAGE(PG8_SB(1, 1), cB + hstep + kstep, voffB);
        PG8_WAIT_V(6); PG8_BAR;
    } else {
        PG8_STAGE(PG8_SB(0, 0), cB, voffB); PG8_STAGE(PG8_SA(0, 0), cA, voffA); PG8_STAGE(PG8_SB(0, 1), cB + hstep, voffB); PG8_STAGE(PG8_SA(0, 1), cA + hstep, voffA);
        if (wr == 1) PG8_BAR;
        PG8_WAIT_V(4); PG8_BAR;
        PG8_STAGE(PG8_SB(1, 0), cB + kstep, voffB); PG8_STAGE(PG8_SA(1, 0), cA + kstep, voffA); PG8_STAGE(PG8_SB(1, 1), cB + hstep + kstep, voffB);
        PG8_WAIT_V(6); PG8_BAR;
    }
    for (;;) {
        const bool has_next = S.next(ui + 1, nxt);
        const char* nA = has_next ? (const char*)g.A + (size_t)nxt.pm * tstep : cA; const char* nB = has_next ? (const char*)g.Bt + (size_t)nxt.pn * tstep : cB;
        for (int t = 0; t < nt; t += 2) {
            const bool last = (t == nt - 2);
            const char* a1 = cA + (size_t)(t + 1) * kstep;
            const char* a2 = last ? nA : cA + (size_t)(t + 2) * kstep; const char* b2 = last ? nB : cB + (size_t)(t + 2) * kstep;
            const char* a3 = a2 + kstep; const char* b3 = b2 + kstep;
            if (last && has_next) S.a_ready(nxt);
            if constexpr (SP2) {
            PG8_LDB(B0, 0, 0); PG8_LDB(B1, 0, 1); PG8_SCHED; PG8_LDA(At, 0, 0); PG8_STAGE(PG8_SA(1, 1), a1 + hstep, voffA);
            PG8_WAIT_V(8); PG8_WAIT_L(0); PG8_BAR; PG8_MMA(0, 0, At, B0); PG8_MMA(0, 1, At, B1); PG8_BAR; PG8_SCHED;
            PG8_LDA(At, 0, 1); PG8_STAGE(PG8_SB(0, 0), b2, voffB); PG8_STAGE(PG8_SB(0, 1), b2 + hstep, voffB); PG8_STAGE(PG8_SA(0, 0), a2, voffA);
            PG8_WAIT_V(8); PG8_WAIT_L(0); PG8_BAR; PG8_MMA(1, 0, At, B0); PG8_MMA(1, 1, At, B1); PG8_BAR; PG8_SCHED;
            PG8_LDB(B0, 1, 0); PG8_LDB(B1, 1, 1); PG8_SCHED; PG8_LDA(At, 1, 0); PG8_STAGE(PG8_SA(0, 1), a2 + hstep, voffA);
            PG8_WAIT_V(8); PG8_WAIT_L(0); PG8_BAR; PG8_MMA(0, 0, At, B0); PG8_MMA(0, 1, At, B1); PG8_BAR; PG8_SCHED;
            PG8_LDA(At, 1, 1); PG8_STAGE(PG8_SB(1, 0), b3, voffB); PG8_STAGE(PG8_SB(1, 1), b3 + hstep, voffB); PG8_STAGE(PG8_SA(1, 0), a3, voffA);
            PG8_WAIT_V(8); PG8_WAIT_L(0); PG8_BAR; PG8_MMA(1, 0, At, B0); PG8_MMA(1, 1, At, B1); PG8_BAR; PG8_SCHED;
            } else {
            PG8_LDB(B0, 0, 0); PG8_SCHED; PG8_LDA(At, 0, 0); PG8_STAGE(PG8_SA(1, 1), a1 + hstep, voffA);
            PG8_WAIT_L(8); PG8_BAR; PG8_WAIT_L(0); PG8_MMA(0, 0, At, B0); PG8_BAR; PG8_SCHED;
            PG8_LDB(B1, 0, 1); PG8_STAGE(PG8_SB(0, 0), b2, voffB);
            PG8_BAR; PG8_WAIT_L(0); PG8_MMA(0, 1, At, B1); PG8_BAR;
            PG8_LDA(At, 0, 1); PG8_STAGE(PG8_SA(0, 0), a2, voffA);
            PG8_BAR; PG8_WAIT_L(0); PG8_MMA(1, 0, At, B0); PG8_BAR; PG8_SCHED;
            PG8_STAGE(PG8_SB(0, 1), b2 + hstep, voffB);
            PG8_WAIT_V(6); PG8_BAR; PG8_MMA(1, 1, At, B1); PG8_BAR;
            PG8_LDB(B0, 1, 0); PG8_SCHED; PG8_LDA(At, 1, 0); PG8_STAGE(PG8_SA(0, 1), a2 + hstep, voffA);
            PG8_WAIT_L(8); PG8_BAR; PG8_WAIT_L(0); PG8_MMA(0, 0, At, B0); PG8_BAR; PG8_SCHED;
            PG8_LDB(B1, 1, 1); PG8_STAGE(PG8_SB(1, 0), b3, voffB);
            PG8_BAR; PG8_WAIT_L(0); PG8_MMA(0, 1, At, B1); PG8_BAR;
            PG8_LDA(At, 1, 1); PG8_STAGE(PG8_SA(1, 0), a3, voffA);
            PG8_BAR; PG8_WAIT_L(0); PG8_MMA(1, 0, At, B0); PG8_BAR; PG8_SCHED;
            PG8_STAGE(PG8_SB(1, 1), b3 + hstep, voffB);
            PG8_WAIT_V(6); PG8_BAR; PG8_MMA(1, 1, At, B1); PG8_BAR;
            }
        }
        if constexpr (ALIGN_EPI) { if (wr == 0) PG8_BAR; }
        if constexpr (!Epi::AFTER_DRAIN) { E(acc, cur, wr, wc, fr, fq, xlds); S.done(cur); }
        if (!has_next) break;
#pragma unroll
        for (int a = 0; a < 2; ++a)
#pragma unroll
            for (int b = 0; b < 2; ++b)
#pragma unroll
                for (int m = 0; m < 4; ++m)
#pragma unroll
                    for (int n = 0; n < 2; ++n) acc[a][b][m][n] = (f32x4){0.f, 0.f, 0.f, 0.f};
        cur = nxt; cA = nA; cB = nB; ++ui;
        if constexpr (ALIGN_EPI) { if (wr == 1) PG8_BAR; }
    }
    PG8_WAIT_V(0);
    if constexpr (!ALIGN_EPI) { if (wr == 0) PG8_BAR; }
    PG8_BAR;
#undef PG8_SA
#undef PG8_SB
#undef PG8_STAGE
#undef PG8_LDA
#undef PG8_LDB
#undef PG8_MMA
#undef PG8_WAIT_V
#undef PG8_WAIT_L
#undef PG8_BAR
#undef PG8_SCHED
}
}

constexpr int NWAVES = 8;
constexpr int D = 2048, DEPTH = 4;
constexpr int NB_CTX = 16, L_CTX = 256, NB_LAT = 8, L_LAT = 4096;
constexpr int M_CTX = NB_CTX * L_CTX, M_LAT = NB_LAT * L_LAT, M = M_CTX + M_LAT;
constexpr int DCONV = 1024, DRNN = 1024, NH = 16, HD = 64, DIN = 5120, DFF = 6144, NUP = 12288;
constexpr int NVEC = 9;
constexpr int NMODC = 6 * D;
constexpr float EPS = 1e-6f;
constexpr int NCHUNK = M / 64;

constexpr size_t MiB = 1u << 20;
constexpr size_t WS_CTL = 0, CTL_ZERO_BYTES = 64 * 1024;
constexpr size_t WS_MODV = 1 * MiB;
constexpr size_t WS_SUMM = 3 * MiB;
constexpr size_t WS_GATEW = 13 * MiB;
constexpr size_t WS_EDGE = 16 * MiB;
constexpr size_t WS_W = 48 * MiB;
constexpr size_t W_LAYER = 100 * MiB, W_IN_OFF = 0, W_OUT_OFF = 20 * MiB, W_UP_OFF = 28 * MiB, W_DOWN_OFF = 76 * MiB;
constexpr size_t WS_A = 448 * MiB;
constexpr size_t WS_BIG = 592 * MiB;
constexpr size_t WS_Y = 1024 * MiB;
constexpr size_t WS_HPRE = 1312 * MiB;
constexpr size_t WS_END = 1408 * MiB;
constexpr int CW_BAR = 1024;

constexpr int RING_BYTES = 131072;
constexpr int MISC_OFF = 155648;
constexpr int LDS_BYTES = 156160;

#define GAS __attribute__((address_space(1)))
#define LAS __attribute__((address_space(3)))
typedef unsigned short bf16;
typedef unsigned v4u __attribute__((ext_vector_type(4)));
typedef unsigned v2u __attribute__((ext_vector_type(2)));
typedef float f32x4 __attribute__((ext_vector_type(4)));
typedef float f32x2 __attribute__((ext_vector_type(2)));
#define LDS_WAIT() asm volatile("s_waitcnt lgkmcnt(0)" ::: "memory")
__device__ __forceinline__ unsigned f2bf(float f) { unsigned u = __builtin_bit_cast(unsigned, f); return (u + 0x7fffu + ((u >> 16) & 1u)) >> 16; }
__device__ __forceinline__ unsigned pk2(float lo, float hi) { return f2bf(lo) | (f2bf(hi) << 16); }
__device__ __forceinline__ float bf2f(unsigned short b) { return __builtin_bit_cast(float, ((unsigned)b) << 16); }
__device__ __forceinline__ float bflo(unsigned w) { return __builtin_bit_cast(float, w << 16); }
__device__ __forceinline__ float bfhi(unsigned w) { return __builtin_bit_cast(float, w & 0xffff0000u); }
__device__ __forceinline__ float sigmoidf_(float x) { return 1.f / (1.f + __expf(-x)); }
__device__ __forceinline__ float gelu_tanh(float x) { const float u = 1.5957691216057308f * (x + 0.044715f * x * x * x); return x / (1.f + __expf(-u)); }
__device__ __forceinline__ float wave_sum(float v) {
#pragma unroll
    for (int o = 1; o < 64; o <<= 1) v += __shfl_xor(v, o);
    return v;
}

#define XB_TMO      128
#define XB_XCNT(j)  (256  + 64 * (j))
#define XB_XSUB(j)  (1280 + 64 * (j))
#define XB_XGEN(j)  (2304 + 64 * (j))
#define XB_TOP      3328
#define XB_TOPGEN   3392
#define XCD_BAR_WORDS 3456
#define XB_SPIN_CAP (1u << 18)
__device__ __forceinline__ unsigned xb_ld(unsigned* p)              { return __hip_atomic_load(p, __ATOMIC_RELAXED, __HIP_MEMORY_SCOPE_AGENT); }
__device__ __forceinline__ unsigned xb_add(unsigned* p, unsigned v) { return __hip_atomic_fetch_add(p, v, __ATOMIC_RELAXED, __HIP_MEMORY_SCOPE_AGENT); }
__device__ __forceinline__ unsigned xb_xcc_id() { return (unsigned)__builtin_amdgcn_s_getreg((3 << 11) | 20) & 0xFu; }
#define XB_SPIN(cond, bar) do { unsigned _sp = 0; while (cond) { __builtin_amdgcn_s_sleep(1); \
    if ((++_sp & 255u) == 0u) { if (xb_ld(&(bar)[XB_TMO])) break; if (_sp > XB_SPIN_CAP) { atomicAdd(&(bar)[XB_TMO], 1u); break; } } } } while (0)
struct XcdBarrier { unsigned* bar; unsigned x; volatile LAS unsigned* st; };
__device__ __forceinline__ XcdBarrier xcd_barrier_post(unsigned* bar, volatile LAS unsigned* st) {
    XcdBarrier b; b.bar = bar; b.x = xb_xcc_id(); b.st = st;
    if (threadIdx.x == 0) (void)xb_add(&bar[XB_XCNT(b.x)], 1u);
    return b;
}
__device__ __forceinline__ void xcd_barrier_complete(unsigned* bar, unsigned x, unsigned& nloc, unsigned& nx) {
    const unsigned G = gridDim.x * gridDim.y * gridDim.z;
    unsigned sum, cnt, mine, sp = 0u;
    for (;;) {
        sum = 0u; cnt = 0u; mine = 0u;
#pragma unroll
        for (unsigned j = 0; j < 16; ++j) { const unsigned c = xb_ld(&bar[XB_XCNT(j)]); sum += c; cnt += (c > 0u) ? 1u : 0u; mine = (j == x) ? c : mine; }
        if (sum == G) break;
        __builtin_amdgcn_s_sleep(1);
        if ((++sp & 255u) == 0u) { if (xb_ld(&bar[XB_TMO])) break; if (sp > XB_SPIN_CAP) { atomicAdd(&bar[XB_TMO], 1u); break; } }
    }
    nloc = mine > 0u ? mine : 1u; nx = cnt > 0u ? cnt : 1u;
}
__device__ __forceinline__ void xcd_barrier(const XcdBarrier& b) {
    asm volatile("s_waitcnt vmcnt(0)" ::: "memory");
    __syncthreads();
    if (threadIdx.x == 0) {
        unsigned* bar = b.bar; asm volatile("" : "+s"(bar));
        __builtin_amdgcn_s_waitcnt(0);
        unsigned nloc = b.st[0], nx = b.st[1];
        if (nloc == 0u) { xcd_barrier_complete(bar, b.x, nloc, nx); b.st[0] = nloc; b.st[1] = nx; }
        const unsigned old = xb_add(&bar[XB_XSUB(b.x)], 1u);
        const unsigned gen = old / nloc;
        if (old + 1u == (gen + 1u) * nloc) {
            __builtin_amdgcn_fence(__ATOMIC_RELEASE, "agent");
            asm volatile("s_waitcnt vmcnt(0)" ::: "memory");
            const unsigned og = xb_add(&bar[XB_TOP], 1u);
            const unsigned tg = og / nx;
            if (og + 1u == (tg + 1u) * nx) xb_add(&bar[XB_TOPGEN], 1u);
            else XB_SPIN(xb_ld(&bar[XB_TOPGEN]) == tg, bar);
            __builtin_amdgcn_fence(__ATOMIC_ACQUIRE, "agent");
            xb_add(&bar[XB_XGEN(b.x)], 1u);
            asm volatile("s_waitcnt vmcnt(0)" ::: "memory");
        } else {
            XB_SPIN(xb_ld(&bar[XB_XGEN(b.x)]) == gen, bar);
            __builtin_amdgcn_fence(__ATOMIC_ACQUIRE, "agent");
            asm volatile("s_waitcnt vmcnt(0)" ::: "memory");
        }
    }
    __syncthreads();
}

struct Args {
    const float* in[21];
    float* out; unsigned char* ws;
    int ph_lo, ph_hi;
    int rep[6];
};
enum { I_XP = 0, I_XS, I_STATE, I_C, I_CCTX, I_WADA, I_BADA, I_NORMG, I_WIN, I_CONVA, I_RCW, I_RCB, I_RWA, I_RBA, I_RWX, I_RBX, I_RLAM, I_WOUT, I_FUP, I_FCW, I_FDOWN };

__device__ __forceinline__ void transpose_item(const float* W, int K, int N, bf16* WT, int k0, int n0, int dst_row0, LAS float* scr, int lane) {
#pragma unroll 8
    for (int i = 0; i < 32; ++i) { const int kk = 2 * i + (lane >> 5); scr[kk * 33 + (lane & 31)] = W[(size_t)(k0 + kk) * N + n0 + (lane & 31)]; }
    LDS_WAIT(); asm volatile("" ::: "memory");
    const int c = lane & 7;
#pragma unroll
    for (int j = 0; j < 4; ++j) { const int n = (lane >> 3) + 8 * j; const LAS float* s = scr + (8 * c) * 33 + n;
        v4u o; o.x = pk2(s[0 * 33], s[1 * 33]); o.y = pk2(s[2 * 33], s[3 * 33]); o.z = pk2(s[4 * 33], s[5 * 33]); o.w = pk2(s[6 * 33], s[7 * 33]);
        *(GAS v4u*)(WT + (size_t)(dst_row0 + n) * K + k0 + 8 * c) = o; }
    LDS_WAIT(); asm volatile("" ::: "memory");
}
constexpr int TI_IN = (D / 64) * (DIN / 32), TI_OUT = (D / 64) * (D / 32), TI_UP = (D / 64) * (NUP / 32), TI_DOWN = (DFF / 64) * (D / 32);
constexpr int TI_LAYER = TI_IN + TI_OUT + TI_UP + TI_DOWN;

__device__ __forceinline__ void pre_transposes(const Args& a, LAS unsigned char* lds, int gw, int NGW, int wave, int lane) {
    LAS float* scr = (LAS float*)(lds + wave * 16384);
    for (int it = gw; it < DEPTH * 2 * 2 * NH * 2; it += NGW) {
        const int half = it & 1, mat = it >> 1, hd = mat & 15, gate = (mat >> 4) & 1, ld = mat >> 5;
        const float* W = (gate ? a.in[I_RWX] : a.in[I_RWA]) + (size_t)(ld * NH + hd) * 64 * 64;
        transpose_item(W, 64, 64, (bf16*)(a.ws + WS_GATEW) + (size_t)((ld * 2 + gate) * NH + hd) * 64 * 64, 0, 32 * half, 32 * half, scr, lane);
    }
    for (int it = gw; it < DEPTH * TI_LAYER; it += NGW) {
        const int l = it / TI_LAYER; int r = it % TI_LAYER;
        bf16* wl = (bf16*)(a.ws + WS_W + (size_t)l * W_LAYER);
        if (r < TI_IN) { const int nblk = DIN / 32, kb = r / nblk, nb = r % nblk;
            transpose_item(a.in[I_WIN] + (size_t)l * D * DIN, D, DIN, (bf16*)((unsigned char*)wl + W_IN_OFF), 64 * kb, 32 * nb, 32 * nb, scr, lane); continue; }
        r -= TI_IN;
        if (r < TI_OUT) { const int nblk = D / 32, kb = r / nblk, nb = r % nblk;
            transpose_item(a.in[I_WOUT] + (size_t)l * D * D, D, D, (bf16*)((unsigned char*)wl + W_OUT_OFF), 64 * kb, 32 * nb, 32 * nb, scr, lane); continue; }
        r -= TI_OUT;
        if (r < TI_UP) { const int nblk = NUP / 32, kb = r / nblk, nb = r % nblk; const int n0 = 32 * nb;
            const int dst = (n0 < DFF) ? ((n0 >> 7) * 256 + (n0 & 127)) : ((((n0 - DFF) >> 7) * 256) + 128 + ((n0 - DFF) & 127));
            transpose_item(a.in[I_FUP] + (size_t)l * D * NUP, D, NUP, (bf16*)((unsigned char*)wl + W_UP_OFF), 64 * kb, n0, dst, scr, lane); continue; }
        r -= TI_UP;
        { const int nblk = D / 32, kb = r / nblk, nb = r % nblk;
            transpose_item(a.in[I_FDOWN] + (size_t)l * DFF * D, DFF, D, (bf16*)((unsigned char*)wl + W_DOWN_OFF), 64 * kb, 32 * nb, 32 * nb, scr, lane); }
    }
}

__device__ __forceinline__ void pre_mod(const Args& a, LAS unsigned char* lds, int tid, int wave, int lane) {
    LAS float* s = (LAS float*)lds;
    LAS float* red = s + NVEC * D;
    for (int i = tid; i < NVEC * D; i += NWAVES * 64) { const int v = i / D, k = i % D; const float c = (v == 0) ? a.in[I_CCTX][k] : a.in[I_C][(v - 1) * D + k]; s[i] = c / (1.f + __expf(-c)); }
    __syncthreads();
    float* modv = (float*)(a.ws + WS_MODV);
    const int cl = tid & 15, ks = tid >> 4;
    for (int item = blockIdx.x; item < DEPTH * (NMODC / 64); item += gridDim.x) {
        const int l = item / (NMODC / 64), n0 = (item % (NMODC / 64)) * 64;
        float acc[NVEC][4];
#pragma unroll
        for (int v = 0; v < NVEC; ++v) { acc[v][0] = 0.f; acc[v][1] = 0.f; acc[v][2] = 0.f; acc[v][3] = 0.f; }
        const float* wp = a.in[I_WADA] + ((size_t)l * D + ks * 64) * NMODC + n0 + 4 * cl;
        const LAS float* sp = s + ks * 64;
#pragma unroll 8
        for (int kk = 0; kk < 64; ++kk) {
            const f32x4 w = *(const f32x4*)(wp + (size_t)kk * NMODC);
#pragma unroll
            for (int v = 0; v < NVEC; ++v) { const float sv = sp[v * D + kk]; acc[v][0] += sv * w[0]; acc[v][1] += sv * w[1]; acc[v][2] += sv * w[2]; acc[v][3] += sv * w[3]; }
        }
#pragma unroll
        for (int v = 0; v < NVEC; ++v)
#pragma unroll
            for (int e = 0; e < 4; ++e) { float t = acc[v][e]; t += __shfl_xor(t, 16); t += __shfl_xor(t, 32); if (lane < 16) red[(wave * 16 + cl) * 36 + v * 4 + e] = t; }
        __syncthreads();
        for (int o = tid; o < NVEC * 64; o += NWAVES * 64) {
            const int v = o >> 6, col = o & 63;
            float sum = 0.f;
#pragma unroll
            for (int w = 0; w < NWAVES; ++w) sum += red[(w * 16 + (col >> 2)) * 36 + v * 4 + (col & 3)];
            const int n = n0 + col, q = n / D, j = n % D;
            const float val = sum + a.in[I_BADA][l * NMODC + n];
            const float* ng = a.in[I_NORMG] + (size_t)l * 4 * D;
            int slot; float r;
            if (q == 0) { slot = 1; r = val; }
            else if (q == 1) { slot = 0; r = ng[0 * D + j] * (1.f + val); }
            else if (q == 2) { slot = 2; r = val * ng[1 * D + j]; }
            else if (q == 3) { slot = 4; r = val; }
            else if (q == 4) { slot = 3; r = ng[2 * D + j] * (1.f + val); }
            else { slot = 5; r = val * ng[3 * D + j]; }
            modv[((size_t)(l * NVEC + v) * 6 + slot) * D + j] = r;
        }
        __syncthreads();
    }
}

template <bool HAS_RES, bool HAS_U>
__device__ __forceinline__ void resnorm_rows(const Args& a, int gw, int NGW, int lane, const float* xsrc_ctx, const float* xsrc_lat, const float* y, int l_res, int slot_res, int l_u) {
    const float* modv = (const float*)(a.ws + WS_MODV);
    bf16* U = (bf16*)(a.ws + WS_A);
    for (int m = gw; m < M; m += NGW) {
        const int v = (m < M_CTX) ? 0 : 1 + ((m - M_CTX) >> 12);
        const float* xs = (m < M_CTX) ? xsrc_ctx + (size_t)m * D : xsrc_lat + (size_t)(m - M_CTX) * D;
        const GAS f32x4* xr = (const GAS f32x4*)xs + lane;
        f32x4 xv[8];
#pragma unroll
        for (int j = 0; j < 8; ++j) xv[j] = xr[64 * j];
        if (HAS_RES) {
            const GAS f32x4* yr = (const GAS f32x4*)(y + (size_t)m * D) + lane;
            const GAS f32x4* gr = (const GAS f32x4*)(modv + ((size_t)(l_res * NVEC + v) * 6 + slot_res) * D) + lane;
            f32x4 yv[8]; float ss = 0.f;
#pragma unroll
            for (int j = 0; j < 8; ++j) { yv[j] = yr[64 * j]; ss += (yv[j].x * yv[j].x + yv[j].y * yv[j].y) + (yv[j].z * yv[j].z + yv[j].w * yv[j].w); }
            const float rstd = 1.f / sqrtf(wave_sum(ss) * (1.f / D) + EPS);
#pragma unroll
            for (int j = 0; j < 8; ++j) { const f32x4 g = gr[64 * j]; xv[j] = xv[j] + g * yv[j] * rstd; }
        }
        GAS f32x4* xo = (GAS f32x4*)(a.out + (size_t)m * D) + lane;
#pragma unroll
        for (int j = 0; j < 8; ++j) xo[64 * j] = xv[j];
        if (HAS_U) {
            float ss = 0.f;
#pragma unroll
            for (int j = 0; j < 8; ++j) ss += (xv[j].x * xv[j].x + xv[j].y * xv[j].y) + (xv[j].z * xv[j].z + xv[j].w * xv[j].w);
            const float rstd = 1.f / sqrtf(wave_sum(ss) * (1.f / D) + EPS);
            const GAS f32x4* gn = (const GAS f32x4*)(modv + ((size_t)(l_u * NVEC + v) * 6 + (l_u == l_res && HAS_RES ? 3 : 0)) * D) + lane;
            const GAS f32x4* bn = (const GAS f32x4*)(modv + ((size_t)(l_u * NVEC + v) * 6 + (l_u == l_res && HAS_RES ? 4 : 1)) * D) + lane;
            GAS v2u* uo = (GAS v2u*)(U + (size_t)m * D) + lane;
#pragma unroll
            for (int j = 0; j < 8; ++j) { const f32x4 g = gn[64 * j], b = bn[64 * j]; const f32x4 t = xv[j] * rstd * g + b; v2u o; o.x = pk2(t.x, t.y); o.y = pk2(t.z, t.w); uo[64 * j] = o; }
        }
    }
}

struct SeqInfo { int base, L, s0, b, cfirst, clast; bool col, ctx; };
__device__ __forceinline__ SeqInfo seq_info(int c, int layer) {
    SeqInfo q;
    if (c < 64) { q.b = c >> 2; q.s0 = (c & 3) * 64; q.L = L_CTX; q.base = q.b * L_CTX; q.col = false; q.ctx = true; q.cfirst = c & ~3; q.clast = q.cfirst + 3; }
    else { const int cc = c - 64; q.b = cc >> 6; q.s0 = (cc & 63) * 64; q.L = L_LAT; q.base = M_CTX + q.b * L_LAT; q.col = (layer & 1) != 0; q.ctx = false; q.cfirst = 64 + (cc & ~63); q.clast = q.cfirst + 63; }
    return q;
}
__device__ __forceinline__ int tok_of(const SeqInfo& q, int s) { return q.base + (q.col ? (((s & 63) << 6) | (s >> 6)) : s); }

typedef float f32x16 __attribute__((ext_vector_type(16)));
typedef short bf16x8v __attribute__((ext_vector_type(8)));
typedef __bf16 bf16v2 __attribute__((ext_vector_type(2)));
__device__ __forceinline__ unsigned pkbf(float lo, float hi) { const bf16v2 t = __builtin_convertvector((f32x2){lo, hi}, bf16v2); return __builtin_bit_cast(unsigned, t); }
constexpr int XROW = 144;
constexpr int XT_BYTES = 10240;
constexpr int HT_BYTES = 9216;
constexpr int WAVE_LDS = XT_BYTES + HT_BYTES;

__device__ __forceinline__ void stage_tile(const bf16* src, const SeqInfo& q, int pos0, int nrows, LAS unsigned char* xt, int lane) {
    const int sub = lane & 7, rsel = lane >> 3;
#pragma unroll
    for (int r0 = 0; r0 < 72; r0 += 8) {
        const int rr = r0 + rsel, s = pos0 + rr;
        v4u val = (v4u){0u, 0u, 0u, 0u};
        if (rr < nrows && s >= 0 && s < q.L) val = *(const v4u*)(src + (size_t)tok_of(q, s) * DIN + sub * 8);
        if (rr < nrows) *(LAS v4u*)(xt + rr * XROW + sub * 16) = val;
    }
}

template <bool FINAL, int DIR>
__device__ __forceinline__ void scan_dir(const Args& a, int layer, int h, int c, const SeqInfo& q, LAS unsigned char* xt, LAS unsigned char* hft, int lane, float hin0, float hin1) {
    const int ld = layer * 2 + DIR, r = lane & 31, hh = lane >> 5;
    bf16x8v afr[2][4];
#pragma unroll
    for (int ks = 0; ks < 4; ++ks) {
        const int i0 = 16 * ks + 8 * hh;
        const float* cw = a.in[I_RCW] + (size_t)(ld * 4) * DRNN + h * 64 + i0;
        f32x4 w[4][2];
#pragma unroll
        for (int k = 0; k < 4; ++k) { w[k][0] = *(const f32x4*)(cw + k * DRNN); w[k][1] = *(const f32x4*)(cw + k * DRNN + 4); }
        const f32x4 b0 = *(const f32x4*)(a.in[I_RCB] + ld * DRNN + h * 64 + i0), b1 = *(const f32x4*)(a.in[I_RCB] + ld * DRNN + h * 64 + i0 + 4);
#pragma unroll
        for (int tb = 0; tb < 2; ++tb) {
            const int t = tb * 32 + r;
            f32x4 a0 = b0, a1 = b1;
#pragma unroll
            for (int k = 0; k < 4; ++k) {
                const int rr = DIR ? (t + 6 - k) : (t + k);
                const v4u raw = *(const LAS v4u*)(xt + rr * XROW + i0 * 2);
                a0 += w[k][0] * (f32x4){bflo(raw.x), bfhi(raw.x), bflo(raw.y), bfhi(raw.y)};
                a1 += w[k][1] * (f32x4){bflo(raw.z), bfhi(raw.z), bflo(raw.w), bfhi(raw.w)};
            }
            v4u p; p.x = pkbf(a0.x, a0.y); p.y = pkbf(a0.z, a0.w); p.z = pkbf(a1.x, a1.y); p.w = pkbf(a1.z, a1.w);
            afr[tb][ks] = __builtin_bit_cast(bf16x8v, p);
        }
    }
    const bf16* gatew = (const bf16*)(a.ws + WS_GATEW);
    f32x2* summ = (f32x2*)(a.ws + WS_SUMM);
    float* nstate = a.out + (size_t)M * D;
#pragma unroll
    for (int cb = 0; cb < 2; ++cb) {
        const int chh = cb * 32 + r, ch = h * 64 + chh;
        bf16x8v bfr[2][4];
#pragma unroll
        for (int gate = 0; gate < 2; ++gate)
#pragma unroll
            for (int ks = 0; ks < 4; ++ks) bfr[gate][ks] = *(const bf16x8v*)(gatew + ((size_t)((ld * 2 + gate) * NH + h) * 64 + chh) * 64 + 16 * ks + 8 * hh);
        const float ba = a.in[I_RBA][ld * DRNN + ch], bx = a.in[I_RBX][ld * DRNN + ch];
        const float c8l2 = -8.f * 1.4426950408889634f * log1pf(__expf(-a.in[I_RLAM][ld * DRNN + ch]));
        const float cw0 = a.in[I_RCW][(ld * 4 + 0) * DRNN + ch], cw1 = a.in[I_RCW][(ld * 4 + 1) * DRNN + ch], cw2 = a.in[I_RCW][(ld * 4 + 2) * DRNN + ch], cw3 = a.in[I_RCW][(ld * 4 + 3) * DRNN + ch];
        const float cbias = a.in[I_RCB][ld * DRNN + ch];
        float hstate = FINAL ? (cb ? hin1 : hin0) : 0.f, Atot = 1.f;
        const bool first_mine = (hh == DIR);
#pragma unroll
        for (int tbi = 0; tbi < 2; ++tbi) {
            constexpr int dummy = 0; (void)dummy;
            const int tb = DIR ? 1 - tbi : tbi;
            f32x16 accr, acci;
#pragma unroll
            for (int i = 0; i < 16; ++i) { accr[i] = 0.f; acci[i] = 0.f; }
#pragma unroll
            for (int ks = 0; ks < 4; ++ks) {
                accr = __builtin_amdgcn_mfma_f32_32x32x16_bf16(afr[tb][ks], bfr[0][ks], accr, 0, 0, 0);
                acci = __builtin_amdgcn_mfma_f32_32x32x16_bf16(afr[tb][ks], bfr[1][ks], acci, 0, 0, 0);
            }
            float av[16], vv[16];
#pragma unroll
            for (int gq = 0; gq < 4; ++gq) {
                const int t0 = tb * 32 + 8 * gq + 4 * hh;
                const int rbase = DIR ? t0 + 3 : t0;
                float xw[7];
#pragma unroll
                for (int m = 0; m < 7; ++m) xw[m] = bf2f(*(const LAS unsigned short*)(xt + (rbase + m) * XROW + chh * 2));
#pragma unroll
                for (int e = 0; e < 4; ++e) {
                    const int qi = 4 * gq + e;
                    const float xc = DIR ? (cbias + cw0 * xw[e + 3] + cw1 * xw[e + 2] + cw2 * xw[e + 1] + cw3 * xw[e])
                                         : (cbias + cw0 * xw[e] + cw1 * xw[e + 1] + cw2 * xw[e + 2] + cw3 * xw[e + 3]);
                    const float rg = __builtin_amdgcn_rcpf(1.f + __builtin_amdgcn_exp2f(-1.4426950408889634f * (accr[qi] + ba)));
                    const float ig = __builtin_amdgcn_rcpf(1.f + __builtin_amdgcn_exp2f(-1.4426950408889634f * (acci[qi] + bx)));
                    const float aa = __builtin_amdgcn_exp2f(c8l2 * rg);
                    av[qi] = aa; vv[qi] = __builtin_amdgcn_sqrtf(fmaxf(0.f, 1.f - aa * aa)) * ig * xc;
                }
            }
            float Ao[4], Ho[4], pA[4], pH[4];
#pragma unroll
            for (int gq = 0; gq < 4; ++gq) {
                float A_ = 1.f, H_ = 0.f;
#pragma unroll
                for (int ei = 0; ei < 4; ++ei) { const int qi = 4 * gq + (DIR ? 3 - ei : ei); H_ = av[qi] * H_ + vv[qi]; A_ *= av[qi]; }
                Ao[gq] = A_; Ho[gq] = H_; pA[gq] = __shfl_xor(A_, 32); pH[gq] = __shfl_xor(H_, 32);
            }
#pragma unroll
            for (int gqi = 0; gqi < 4; ++gqi) {
                const int gq = DIR ? 3 - gqi : gqi;
                const float pre = first_mine ? hstate : (pA[gq] * hstate + pH[gq]);
                float post;
                if (FINAL) {
                    float hs = pre;
#pragma unroll
                    for (int ei = 0; ei < 4; ++ei) { const int e = DIR ? 3 - ei : ei, qi = 4 * gq + e; hs = av[qi] * hs + vv[qi];
                        LAS unsigned short* hp = (LAS unsigned short*)(hft + (tb * 32 + 8 * gq + 4 * hh + e) * XROW + chh * 2);
                        if (DIR == 0) *hp = (unsigned short)f2bf(hs); else *hp = (unsigned short)f2bf(bf2f(*hp) + hs); }
                    post = hs;
                } else { post = Ao[gq] * pre + Ho[gq]; Atot *= Ao[gq] * pA[gq]; }
                hstate = first_mine ? (pA[gq] * post + pH[gq]) : post;
            }
        }
        if (!FINAL) { if (hh == 0) summ[(size_t)(c * 2 + DIR) * DRNN + ch] = (f32x2){Atot, hstate}; }
        else if (q.ctx && hh == 0 && c == (DIR ? q.cfirst : q.clast)) nstate[((size_t)(q.b * DEPTH + layer) * 2 + DIR) * DRNN + ch] = hstate;
    }
}

__device__ __forceinline__ void scan_summary_item(const Args& a, int layer, int item, int lane, LAS unsigned char* xt) {
    const int d = item & 1, h = (item >> 1) & 15, c = item >> 5;
    const SeqInfo q = seq_info(c, layer);
    stage_tile((const bf16*)(a.ws + WS_BIG) + 3 * DCONV + h * 64, q, q.s0 - 3, 70, xt, lane);
    if (d == 0) scan_dir<false, 0>(a, layer, h, c, q, xt, xt, lane, 0.f, 0.f);
    else scan_dir<false, 1>(a, layer, h, c, q, xt, xt, lane, 0.f, 0.f);
}

__device__ __forceinline__ float carry_in(const Args& a, const SeqInfo& q, int layer, int c, int d, int ch) {
    const f32x2* summ = (const f32x2*)(a.ws + WS_SUMM);
    float hin = q.ctx ? 0.f : a.in[I_STATE][((size_t)(q.b * DEPTH + layer) * 2 + d) * DRNN + ch];
    const int n = d ? (q.clast - c) : (c - q.cfirst);
    for (int i0 = 0; i0 < n; i0 += 8) {
        f32x2 t[8];
#pragma unroll
        for (int k = 0; k < 8; ++k) { const int i = i0 + k; const int cc = d ? (q.clast - i) : (q.cfirst + i); t[k] = (i < n) ? summ[(size_t)(cc * 2 + d) * DRNN + ch] : (f32x2){1.f, 0.f}; }
#pragma unroll
        for (int k = 0; k < 8; ++k) hin = t[k].x * hin + t[k].y;
    }
    return hin;
}

__device__ __forceinline__ void mixb_item(const Args& a, int layer, int item, int lane, LAS unsigned char* xt) {
    const int h = item & 15, c = item >> 4, r = lane & 31, hh = lane >> 5;
    const SeqInfo q = seq_info(c, layer);
    const bf16* proj = (const bf16*)(a.ws + WS_BIG);
    stage_tile(proj + 3 * DCONV + h * 64, q, q.s0 - 3, 70, xt, lane);
    LAS unsigned char* hft = xt + XT_BYTES;
    {
        const float hl = carry_in(a, q, layer, c, 0, h * 64 + lane);
        scan_dir<true, 0>(a, layer, h, c, q, xt, hft, lane, __shfl(hl, r), __shfl(hl, 32 + r));
    }
    {
        const float hl = carry_in(a, q, layer, c, 1, h * 64 + lane);
        scan_dir<true, 1>(a, layer, h, c, q, xt, hft, lane, __shfl(hl, r), __shfl(hl, 32 + r));
    }
    stage_tile(proj + 3 * DCONV + DRNN + h * 64, q, q.s0, 64, xt, lane);
#pragma unroll
    for (int tb = 0; tb < 2; ++tb)
#pragma unroll
        for (int cb = 0; cb < 2; ++cb)
#pragma unroll
            for (int qi = 0; qi < 16; ++qi) {
                const int t = tb * 32 + (qi & 3) + 8 * (qi >> 2) + 4 * hh;
                const int off = t * XROW + (cb * 32 + r) * 2;
                const float g = bf2f(*(const LAS unsigned short*)(xt + off));
                LAS unsigned short* p = (LAS unsigned short*)(hft + off);
                *p = (unsigned short)f2bf(bf2f(*p) * gelu_tanh(g));
            }
    bf16* ymix = (bf16*)(a.ws + WS_A) + DCONV + h * 64;
    const int sub = lane & 7, rsel = lane >> 3;
#pragma unroll
    for (int r0 = 0; r0 < 64; r0 += 8) {
        const int rr = r0 + rsel;
        const v4u val = *(const LAS v4u*)(hft + rr * XROW + sub * 16);
        *(v4u*)(ymix + (size_t)tok_of(q, q.s0 + rr) * D + sub * 8) = val;
    }
}

__device__ __forceinline__ void mixa_item(const Args& a, int layer, int item, int lane) {
    const int g4 = item & 3, c = item >> 2, ch0 = g4 * 256 + lane * 4;
    const SeqInfo q = seq_info(c, layer);
    const bf16* proj = (const bf16*)(a.ws + WS_BIG);
    bf16* ymix = (bf16*)(a.ws + WS_A);
    const f32x4 w0 = *(const f32x4*)(a.in[I_CONVA] + (size_t)(layer * 3 + 0) * DCONV + ch0);
    const f32x4 w1 = *(const f32x4*)(a.in[I_CONVA] + (size_t)(layer * 3 + 1) * DCONV + ch0);
    const f32x4 w2 = *(const f32x4*)(a.in[I_CONVA] + (size_t)(layer * 3 + 2) * DCONV + ch0);
    auto cx_at = [&](int s) -> f32x4 {
        if (s < 0 || s >= q.L) return (f32x4){0.f, 0.f, 0.f, 0.f};
        const bf16* row = proj + (size_t)tok_of(q, s) * DIN + ch0;
        const v2u cg = *(const v2u*)(row + DCONV), xa = *(const v2u*)(row + 2 * DCONV);
        return (f32x4){bflo(cg.x) * bflo(xa.x), bfhi(cg.x) * bfhi(xa.x), bflo(cg.y) * bflo(xa.y), bfhi(cg.y) * bfhi(xa.y)};
    };
    f32x4 cm = cx_at(q.s0 - 1), cc = cx_at(q.s0);
    for (int blk = 0; blk < 8; ++blk) {
        f32x4 cn[8]; v2u bg[8];
#pragma unroll
        for (int e = 0; e < 8; ++e) { const int s = q.s0 + 8 * blk + e; cn[e] = cx_at(s + 1); bg[e] = *(const v2u*)(proj + (size_t)tok_of(q, s) * DIN + ch0); }
#pragma unroll
        for (int e = 0; e < 8; ++e) {
            const int s = q.s0 + 8 * blk + e;
            const f32x4 hv = w0 * cm + w1 * cc + w2 * cn[e];
            const f32x4 bv = (f32x4){bflo(bg[e].x), bfhi(bg[e].x), bflo(bg[e].y), bfhi(bg[e].y)};
            const f32x4 o = bv * hv;
            v2u ov; ov.x = pk2(o.x, o.y); ov.y = pk2(o.z, o.w);
            *(v2u*)(ymix + (size_t)tok_of(q, s) * D + ch0) = ov;
            cm = cc; cc = cn[e];
        }
    }
}

__device__ __forceinline__ void convgate_item(const Args& a, int layer, int chunk, int item, int lane) {
    const int cgp = item % 12, rb = item / 12, r0 = rb * 8, ch0 = cgp * 512 + lane * 8;
    const int seqlen = (chunk == 0) ? L_CTX : L_LAT;
    const bf16* hp = (const bf16*)(a.ws + WS_HPRE) + (size_t)((ch0 >> 7) * 256 + (ch0 & 127));
    bf16* act = (bf16*)(a.ws + WS_BIG) + (size_t)(chunk * 4096) * DFF + ch0;
    const float* cw = a.in[I_FCW] + (size_t)layer * 3 * NUP;
    float wg[3][8], wv[3][8];
#pragma unroll
    for (int t = 0; t < 3; ++t)
#pragma unroll
        for (int e = 0; e < 8; ++e) { wg[t][e] = cw[t * NUP + ch0 + e]; wv[t][e] = cw[t * NUP + DFF + ch0 + e]; }
    v4u rg[10], rv[10];
#pragma unroll
    for (int i = 0; i < 10; ++i) {
        const int r = r0 - 1 + i;
        const bool ok = (i == 0) ? ((r0 % seqlen) != 0) : (i == 9) ? (((r0 + 8) % seqlen) != 0) : true;
        if (ok) { rg[i] = *(const v4u*)(hp + (size_t)r * NUP); rv[i] = *(const v4u*)(hp + (size_t)r * NUP + 128); }
        else { rg[i] = (v4u){0u, 0u, 0u, 0u}; rv[i] = (v4u){0u, 0u, 0u, 0u}; }
    }
#pragma unroll
    for (int i = 1; i <= 8; ++i) {
        float o[8];
#pragma unroll
        for (int e2 = 0; e2 < 4; ++e2) {
            const unsigned gm = rg[i - 1][e2], gc = rg[i][e2], gn = rg[i + 1][e2], vm = rv[i - 1][e2], vc = rv[i][e2], vn = rv[i + 1][e2];
            const float hg0 = wg[0][2 * e2] * bflo(gm) + wg[1][2 * e2] * bflo(gc) + wg[2][2 * e2] * bflo(gn);
            const float hg1 = wg[0][2 * e2 + 1] * bfhi(gm) + wg[1][2 * e2 + 1] * bfhi(gc) + wg[2][2 * e2 + 1] * bfhi(gn);
            const float hv0 = wv[0][2 * e2] * bflo(vm) + wv[1][2 * e2] * bflo(vc) + wv[2][2 * e2] * bflo(vn);
            const float hv1 = wv[0][2 * e2 + 1] * bfhi(vm) + wv[1][2 * e2 + 1] * bfhi(vc) + wv[2][2 * e2 + 1] * bfhi(vn);
            o[2 * e2] = gelu_tanh(hg0) * hv0; o[2 * e2 + 1] = gelu_tanh(hg1) * hv1;
        }
        v4u ov; ov.x = pk2(o[0], o[1]); ov.y = pk2(o[2], o[3]); ov.z = pk2(o[4], o[5]); ov.w = pk2(o[6], o[7]);
        *(v4u*)(act + (size_t)(r0 + i - 1) * DFF) = ov;
    }
}

__device__ __forceinline__ void ffn_fixup(const Args& a, int layer, int gtid, int nthreads) {
    const float* edge = (const float*)(a.ws + WS_EDGE);
    const float* cw = a.in[I_FCW] + (size_t)layer * 3 * NUP;
    bf16* act = (bf16*)(a.ws + WS_BIG);
    for (int it = gtid; it < NB_LAT * 15 * (DFF / 4) * 2; it += nthreads) {
        const int which = it & 1, cq = (it >> 1) % (DFF / 4), bi = (it >> 1) / (DFF / 4);
        const int pm = 16 + (bi / 15) * 16 + (bi % 15), chn = 4 * cq, ug = (chn >> 7) * 256 + (chn & 127);
        const float* e0 = edge + (size_t)pm * 4 * NUP, * e1 = edge + (size_t)(pm + 1) * 4 * NUP;
        const float* pp = which ? e0 + 3 * (size_t)NUP : e0 + 2 * (size_t)NUP;
        const float* pc = which ? e1 : e0 + 3 * (size_t)NUP;
        const float* pn = which ? e1 + NUP : e1;
        f32x4 hg = *(const f32x4*)(cw + chn) * *(const f32x4*)(pp + ug) + *(const f32x4*)(cw + NUP + chn) * *(const f32x4*)(pc + ug) + *(const f32x4*)(cw + 2 * (size_t)NUP + chn) * *(const f32x4*)(pn + ug);
        f32x4 hv = *(const f32x4*)(cw + DFF + chn) * *(const f32x4*)(pp + ug + 128) + *(const f32x4*)(cw + NUP + DFF + chn) * *(const f32x4*)(pc + ug + 128) + *(const f32x4*)(cw + 2 * (size_t)NUP + DFF + chn) * *(const f32x4*)(pn + ug + 128);
        const size_t R = (size_t)pm * 256 + 255 + which;
        v2u o; o.x = pk2(gelu_tanh(hg.x) * hv.x, gelu_tanh(hg.y) * hv.y); o.y = pk2(gelu_tanh(hg.z) * hv.z, gelu_tanh(hg.w) * hv.w);
        *(v2u*)(act + R * DFF + chn) = o;
    }
}

constexpr int PH_PRE = 0, PH_NORM0 = 1, PH_LAYER0 = 2, NPL = 9, N_PHASES = PH_LAYER0 + DEPTH * NPL;

__global__ void __launch_bounds__(NWAVES * 64, 2) fwd_kernel(Args args) {
    extern __shared__ __attribute__((aligned(16))) unsigned char lds_raw[];
    LAS unsigned char* lds = (LAS unsigned char*)lds_raw;
    volatile LAS unsigned* MISC = (volatile LAS unsigned*)(lds + MISC_OFF);
    const int G = gridDim.x, NGW = G * NWAVES;
    const int lo = args.ph_lo, hi = args.ph_hi;
#define PHASE_IDS int tid = threadIdx.x; asm volatile("" : "+v"(tid)); const int lane = tid & 63, wave = __builtin_amdgcn_readfirstlane(tid >> 6), gw = blockIdx.x * NWAVES + wave; (void)lane; (void)gw;
    if (threadIdx.x < 32) MISC[threadIdx.x] = 0u;
    __syncthreads();
    XcdBarrier bar; bar.bar = (unsigned*)(args.ws + WS_CTL) + CW_BAR; bar.x = 0; bar.st = nullptr;
    if (hi - lo > 1) bar = xcd_barrier_post((unsigned*)(args.ws + WS_CTL) + CW_BAR, MISC + 8);
#define IN(k) (lo <= (k) && (k) < hi)
#define SEAM(k) do { if (IN(k) && IN((k) + 1)) xcd_barrier(bar); } while (0)
    unsigned char* ws = args.ws;

    if (IN(PH_PRE)) { for (int rep = 0; rep < args.rep[4]; ++rep) { PHASE_IDS pre_transposes(args, lds, gw, NGW, wave, lane); __syncthreads(); pre_mod(args, lds, tid, wave, lane); __syncthreads(); } }
    SEAM(PH_PRE);
    if (IN(PH_NORM0)) { PHASE_IDS resnorm_rows<false, true>(args, gw, NGW, lane, args.in[I_XP], args.in[I_XS], nullptr, 0, 0, 0); }
    SEAM(PH_NORM0);

    for (int l = 0; l < DEPTH; ++l) {
        const int pb = PH_LAYER0 + l * NPL;
        const bf16* wl = (const bf16*)(ws + WS_W + (size_t)l * W_LAYER);
        if (IN(pb + 0)) for (int rep = 0; rep < args.rep[0]; ++rep) {
            pg8::Gemm g{(const bf16*)(ws + WS_A), (const bf16*)((const unsigned char*)wl + W_IN_OFF), M, DIN, D}; pg8::StaticOrder S; S.init(M, DIN, G, (int)blockIdx.x);
            pg8::EpiBf16Store E{(bf16*)(ws + WS_BIG), DIN};
            pg8::gemm_phase<pg8::EpiBf16Store, pg8::StaticOrder, true, true>(lds, lds + RING_BYTES, g, S, E);
        }
        SEAM(pb + 0);
        if (IN(pb + 1)) for (int rep = 0; rep < args.rep[1]; ++rep) { PHASE_IDS LAS unsigned char* xt = lds + wave * WAVE_LDS; for (int it = gw; it < NCHUNK * NH * 2; it += NGW) scan_summary_item(args, l, it, lane, xt); }
        SEAM(pb + 1);
        if (IN(pb + 2)) for (int rep = 0; rep < args.rep[2]; ++rep) {
            PHASE_IDS
            LAS unsigned char* xt = lds + wave * WAVE_LDS;
            for (int it = gw; it < NCHUNK * NH + NCHUNK * 4; it += NGW) { if (it < NCHUNK * NH) mixb_item(args, l, it, lane, xt); else mixa_item(args, l, it - NCHUNK * NH, lane); }
        }
        SEAM(pb + 2);
        if (IN(pb + 3)) for (int rep = 0; rep < args.rep[0]; ++rep) {
            pg8::Gemm g{(const bf16*)(ws + WS_A), (const bf16*)((const unsigned char*)wl + W_OUT_OFF), M, D, D}; pg8::StaticOrder S; S.init(M, D, G, (int)blockIdx.x);
            pg8::EpiF32Store E{(float*)(ws + WS_Y), D};
            pg8::gemm_phase<pg8::EpiF32Store, pg8::StaticOrder, true, true>(lds, lds + RING_BYTES, g, S, E);
        }
        SEAM(pb + 3);
        if (IN(pb + 4)) { PHASE_IDS resnorm_rows<true, true>(args, gw, NGW, lane, args.out, args.out + (size_t)M_CTX * D, (const float*)(ws + WS_Y), l, 2, l); }
        SEAM(pb + 4);
        if (IN(pb + 5)) for (int rep = 0; rep < args.rep[0]; ++rep) {
            pg8::Gemm g{(const bf16*)(ws + WS_A), (const bf16*)((const unsigned char*)wl + W_UP_OFF), M, NUP, D}; pg8::StaticOrder S; S.init(M, NUP, G, (int)blockIdx.x);
            pg8::EpiConvGate E{(bf16*)(ws + WS_BIG), DFF, args.in[I_FCW] + (size_t)l * 3 * NUP, (float*)(ws + WS_EDGE), NUP, DFF};
            pg8::gemm_phase<pg8::EpiConvGate, pg8::StaticOrder, true, true>(lds, lds + RING_BYTES, g, S, E);
        }
        SEAM(pb + 5);
        if (IN(pb + 6)) { PHASE_IDS ffn_fixup(args, l, blockIdx.x * (NWAVES * 64) + tid, G * NWAVES * 64); }
        SEAM(pb + 6);
        if (IN(pb + 7)) for (int rep = 0; rep < args.rep[0]; ++rep) {
            pg8::Gemm g{(const bf16*)(ws + WS_BIG), (const bf16*)((const unsigned char*)wl + W_DOWN_OFF), M, D, DFF}; pg8::StaticOrder S; S.init(M, D, G, (int)blockIdx.x);
            pg8::EpiF32Store E{(float*)(ws + WS_Y), D};
            pg8::gemm_phase<pg8::EpiF32Store, pg8::StaticOrder, true, true>(lds, lds + RING_BYTES, g, S, E);
        }
        SEAM(pb + 7);
        if (IN(pb + 8)) {
            PHASE_IDS
            if (l + 1 < DEPTH) resnorm_rows<true, true>(args, gw, NGW, lane, args.out, args.out + (size_t)M_CTX * D, (const float*)(ws + WS_Y), l, 5, l + 1);
            else resnorm_rows<true, false>(args, gw, NGW, lane, args.out, args.out + (size_t)M_CTX * D, (const float*)(ws + WS_Y), l, 5, l);
        }
        if (l + 1 < DEPTH) SEAM(pb + 8);
    }
#undef IN
#undef SEAM
}

extern "C" void kernel_launch(void* const* d_in, const int* in_sizes, int n_in, void* d_out, int out_size, void* d_ws, size_t ws_size, hipStream_t stream) {
    static int grid = 0;
    if (grid == 0) {
        if (n_in != 21 || ws_size < WS_END) { fprintf(stderr, "kernel_launch: expected 21 inputs and >= %zu bytes of workspace; got n_in %d, ws %zu\n", (size_t)WS_END, n_in, ws_size); grid = -1; return; }
        int dev = 0, cus = 0, per_cu = 0;
        if (hipGetDevice(&dev) != hipSuccess || hipDeviceGetAttribute(&cus, hipDeviceAttributeMultiprocessorCount, dev) != hipSuccess) { grid = -1; return; }
        if (hipFuncSetAttribute((const void*)fwd_kernel, hipFuncAttributeMaxDynamicSharedMemorySize, LDS_BYTES) != hipSuccess) { fprintf(stderr, "kernel_launch: hipFuncSetAttribute failed\n"); grid = -1; return; }
        if (hipOccupancyMaxActiveBlocksPerMultiprocessor(&per_cu, (const void*)fwd_kernel, NWAVES * 64, LDS_BYTES) != hipSuccess || per_cu < 1) { fprintf(stderr, "kernel_launch: occupancy query reports %d blocks per CU\n", per_cu); }
        (void)hipGetLastError();
        grid = cus;
    }
    if (grid < 0) return;
    (void)hipMemsetAsync((char*)d_ws + WS_CTL, 0, CTL_ZERO_BYTES, stream);
    Args a{};
    for (int i = 0; i < 21; ++i) a.in[i] = (const float*)d_in[i];
    a.out = (float*)d_out; a.ws = (unsigned char*)d_ws;
    for (int i = 0; i < 6; ++i) a.rep[i] = ((PROBE_DUP >> i) & 1) ? 2 : 1;
#if MK_SINGLE
    a.ph_lo = 0; a.ph_hi = N_PHASES;
    hipLaunchKernelGGL(fwd_kernel, dim3(grid), dim3(NWAVES * 64), LDS_BYTES, stream, a);
#else
    for (int p = 0; p < N_PHASES; ++p) { a.ph_lo = p; a.ph_hi = p + 1; hipLaunchKernelGGL(fwd_kernel, dim3(grid), dim3(NWAVES * 64), LDS_BYTES, stream, a); }
#endif
}
```

```cpp
#include <hip/hip_runtime.h>
#include <cstdio>
#include <cstdint>

#ifndef PROBE_DUP
#define PROBE_DUP 0
#endif
#ifndef STAGE_ASM
#define STAGE_ASM 1
#endif
#ifndef GEMM_STAGGER
#define GEMM_STAGGER 0
#endif
#ifndef PROBE_NORM
#define PROBE_NORM 0
#endif
#ifndef PROBE_GEMM
#define PROBE_GEMM 0
#endif
#ifndef MK_SINGLE
#define MK_SINGLE 1
#endif

__host__ __device__ __forceinline__ size_t blk_off(int m, int k, int K) { return ((size_t)((m >> 8) * (K >> 6) + (k >> 6)) * 256 + (m & 255)) * 64 + (k & 63); }
namespace pg8 {
#define PG8_LAS __attribute__((address_space(3)))
typedef unsigned short bf16_t;
typedef short bf16x8 __attribute__((ext_vector_type(8)));
typedef float f32x4 __attribute__((ext_vector_type(4)));
typedef unsigned u32x4 __attribute__((ext_vector_type(4)));
typedef float f32x2 __attribute__((ext_vector_type(2)));
constexpr int BM = 256, BK = 64, HALF = 128, HTB = HALF * BK * 2, STAGE_BYTES = 8 * HTB, NXCD = 8, WGM = 4;

__host__ __device__ __forceinline__ int lds_byte(int r, int c) { const int st = (r >> 4) * 2 + (c >> 5), rr = r & 15, cc = c & 31, ob = rr * 64 + cc * 2; return st * 1024 + (ob ^ (((ob >> 9) & 1) << 5)); }
__host__ __device__ __forceinline__ void stage_rc(int b, int& R, int& C) { const int st = b / 1024, sb = b % 1024, swz = sb ^ (((sb >> 9) & 1) << 5); R = (st >> 1) * 16 + swz / 64; C = (st & 1) * 32 + (swz % 64) / 2; }
__host__ __device__ __forceinline__ int perm32(int rho) { const int n = rho >> 4, i = rho & 15; return 8 * (i >> 2) + 4 * n + (i & 3); }

struct Unit { int pm, pn, kt0, nt, slice; };
struct Gemm { const bf16_t* A; const bf16_t* Bt; int M, N, K, KL; };

struct StaticOrder {
    int nM, nN, nwg, G, c;
    __host__ __device__ void init(int M, int N, int G_, int c_) { nM = M / BM; nN = N / BM; nwg = nM * nN; G = G_; c = c_; }
    __host__ __device__ bool next(int i, Unit& u) const {
        const long L = (long)i * G + c; if (L >= nwg) return false;
        int wgid = (int)L; { const int q = nwg / NXCD, r = nwg % NXCD, xcd = wgid % NXCD, off = wgid / NXCD; wgid = (xcd < r ? xcd * (q + 1) : r * (q + 1) + (xcd - r) * q) + off; }
        const int nig = WGM * nN, gid = wgid / nig, fm = gid * WGM, gsz = (nM - fm) < WGM ? (nM - fm) : WGM;
        u.pm = fm + ((wgid % nig) % gsz); u.pn = (wgid % nig) / gsz; return true;
    }
    __device__ __forceinline__ void a_ready(const Unit&) const {}
    __device__ __forceinline__ void done(const Unit&) const {}
};

struct TwoRectOrder {
    StaticOrder a, b; int r1, pm2;
    __host__ __device__ bool next(int i, Unit& u) const { if (i < r1) return a.next(i, u); if (!b.next(i - r1, u)) return false; u.pm += pm2; return true; }
    __device__ __forceinline__ void a_ready(const Unit&) const {}
    __device__ __forceinline__ void done(const Unit&) const {}
};
template <class Main> struct WithTail {
    Main m; int r_main; Unit tail;
    __host__ __device__ bool next(int i, Unit& u) const { if (i < r_main) { if (!m.next(i, u)) return false; u.kt0 = 0; u.nt = 0; u.slice = 0; return true; } if (i > r_main) return false; u = tail; return true; }
    __device__ __forceinline__ void a_ready(const Unit&) const {}
    __device__ __forceinline__ void done(const Unit&) const {}
};
struct ConstOrder {
    int n;
    __host__ __device__ bool next(int i, Unit& u) const { if (i >= n) return false; u.pm = 0; u.pn = 0; return true; }
    __device__ __forceinline__ void a_ready(const Unit&) const {}
    __device__ __forceinline__ void done(const Unit&) const {}
};
struct OneUnit {
    int pm, pn;
    __host__ __device__ bool next(int i, Unit& u) const { if (i != 0) return false; u.pm = pm; u.pn = pn; return true; }
    __device__ __forceinline__ void a_ready(const Unit&) const {}
    __device__ __forceinline__ void done(const Unit&) const {}
};
__device__ __forceinline__ unsigned cvt_pk_bf16(float lo, float hi) { unsigned r; asm volatile("v_cvt_pk_bf16_f32 %0, %1, %2" : "=v"(r) : "v"(lo), "v"(hi)); return r; }

struct EpiBf16Store {
    static constexpr bool PERM = true, AFTER_DRAIN = false, PREFETCH = false, ROWPERM = false;
    bf16_t* O; int ldc; bf16_t* O2; int ldc2; size_t sstride;
    __device__ __forceinline__ void operator()(const f32x4 (&acc)[2][2][4][2], const Unit& u, int wr, int wc, int fr, int fq, PG8_LAS unsigned char*) const {
        const int row0 = u.pm * BM + wr * 64 + fr, col0 = u.pn * BM + wc * 32 + 8 * fq;
        bf16_t* const Ob = u.slice ? O2 + (size_t)(u.slice - 1) * sstride : O; const int ld = u.slice ? ldc2 : ldc;
#pragma unroll
        for (int ai = 0; ai < 2; ++ai)
#pragma unroll
            for (int m = 0; m < 4; ++m) { bf16_t* rowp = Ob + (size_t)(row0 + ai * HALF + m * 16) * ld + col0;
#pragma unroll
                for (int bj = 0; bj < 2; ++bj) { const f32x4 v0 = acc[ai][bj][m][0], v1 = acc[ai][bj][m][1];
                    u32x4 w; w.x = cvt_pk_bf16(v0[0], v0[1]); w.y = cvt_pk_bf16(v0[2], v0[3]); w.z = cvt_pk_bf16(v1[0], v1[1]); w.w = cvt_pk_bf16(v1[2], v1[3]);
                    *(u32x4*)(rowp + bj * HALF) = w; } }
    }
};
struct EpiBf16Scratch {
    static constexpr bool PERM = true, AFTER_DRAIN = false, PREFETCH = false, ROWPERM = false;
    EpiBf16Store e;
    __device__ __forceinline__ void operator()(const f32x4 (&acc)[2][2][4][2], const Unit&, int wr, int wc, int fr, int fq, PG8_LAS unsigned char* x) const { const Unit z{0, 0, 0, 0, 0}; e(acc, z, wr, wc, fr, fq, x); }
};
struct EpiF32Store {
    static constexpr bool PERM = false, AFTER_DRAIN = false, PREFETCH = false, ROWPERM = false;
    float* C; int ldc;
    __device__ __forceinline__ void operator()(const f32x4 (&acc)[2][2][4][2], const Unit& u, int wr, int wc, int fr, int fq, PG8_LAS unsigned char*) const {
        const int row0 = u.pm * BM + wr * 64 + fr, col0 = u.pn * BM + wc * 32 + 4 * fq;
#pragma unroll
        for (int ai = 0; ai < 2; ++ai)
#pragma unroll
            for (int m = 0; m < 4; ++m) { float* rowp = C + (size_t)(row0 + ai * HALF + m * 16) * ldc + col0;
#pragma unroll
                for (int bj = 0; bj < 2; ++bj)
#pragma unroll
                    for (int n = 0; n < 2; ++n) *(f32x4*)(rowp + bj * HALF + n * 16) = acc[ai][bj][m][n]; }
    }
};


#ifndef EPI_DPP
#define EPI_DPP 1
#endif
__device__ __forceinline__ float rotr1_16(float x, int lane) {
#if EPI_DPP
    return __builtin_bit_cast(float, __builtin_amdgcn_update_dpp(0, __builtin_bit_cast(int, x), 0x121, 0xF, 0xF, false));
#else
    return __shfl(x, (lane & 48) | ((lane + 15) & 15));
#endif
}
__device__ __forceinline__ float rotl1_16(float x, int lane) {
#if EPI_DPP
    return __builtin_bit_cast(float, __builtin_amdgcn_update_dpp(0, __builtin_bit_cast(int, x), 0x12F, 0xF, 0xF, false));
#else
    return __shfl(x, (lane & 48) | ((lane + 1) & 15));
#endif
}
__device__ __forceinline__ float gelu_tanh_f(float x) { const float u = 1.5957691216057308f * (x + 0.044715f * x * x * x); return x * __builtin_amdgcn_rcpf(1.f + __builtin_amdgcn_exp2f(-1.4426950408889634f * u)); }
struct EpiConvGate {
    static constexpr bool PERM = true, AFTER_DRAIN = false, PREFETCH = true, ROWPERM = true;
    static constexpr int XBLK = 3072 + 8192;
    bf16_t* act; int ldc; const float* cw; float* edge; int nup, dff;
    static constexpr int ZOFF = 2 * XBLK;
    __device__ __forceinline__ void prefetch(const Unit& u, PG8_LAS unsigned char* xb, int wid, int lane, bool first) const {
        if (wid < 3) { const int gv = lane >> 5, c4 = lane & 31;
            __builtin_amdgcn_global_load_lds((const unsigned*)(cw + (size_t)wid * nup + gv * dff + u.pn * 128 + 4 * c4), (PG8_LAS unsigned*)(xb + wid * 1024), 16, 0, 0); }
        if (first && wid == 3) { float z = 0.f; asm volatile("" : "+v"(z)); *(PG8_LAS f32x4*)(xb + ZOFF + lane * 16) = (f32x4){z, z, z, z}; }
    }
    __device__ __forceinline__ void operator()(const f32x4 (&acc)[2][2][4][2], const Unit& u, int wr, int wc, int fr, int fq, PG8_LAS unsigned char* xlds, PG8_LAS unsigned char* zlds) const {
        PG8_LAS float* ex = (PG8_LAS float*)(xlds + 3072);
        const int ucol = wc * 32 + 8 * fq;
#pragma unroll
        for (int ai = 0; ai < 2; ++ai)
#pragma unroll
            for (int bj = 0; bj < 2; ++bj)
#pragma unroll
                for (int n = 0; n < 2; ++n) {
                    if (fr == 0)  *(PG8_LAS f32x4*)(ex + (2 * (2 * ai + wr) + 0) * 256 + 128 * bj + ucol + 4 * n) = acc[ai][bj][0][n];
                    if (fr == 15) *(PG8_LAS f32x4*)(ex + (2 * (2 * ai + wr) + 1) * 256 + 128 * bj + ucol + 4 * n) = acc[ai][bj][3][n];
                }
        float* eb = edge + (size_t)u.pm * 4 * nup + u.pn * 256 + ucol;
        if (wr == 0 && fr == 0) {
#pragma unroll
            for (int bj = 0; bj < 2; ++bj)
#pragma unroll
                for (int n = 0; n < 2; ++n) { *(f32x4*)(eb + 128 * bj + 4 * n) = acc[0][bj][0][n]; *(f32x4*)(eb + (size_t)nup + 128 * bj + 4 * n) = acc[0][bj][1][n]; }
        }
        if (wr == 1 && fr == 15) {
#pragma unroll
            for (int bj = 0; bj < 2; ++bj)
#pragma unroll
                for (int n = 0; n < 2; ++n) { *(f32x4*)(eb + (size_t)2 * nup + 128 * bj + 4 * n) = acc[1][bj][2][n]; *(f32x4*)(eb + (size_t)3 * nup + 128 * bj + 4 * n) = acc[1][bj][3][n]; }
        }
        const PG8_LAS float* wb = (const PG8_LAS float*)xlds;
        asm volatile("s_waitcnt lgkmcnt(0)" ::: "memory"); __builtin_amdgcn_s_barrier(); asm volatile("" ::: "memory");
        const int chn0 = u.pn * 128 + ucol;
        const int row0 = u.pm * BM + wr * 64 + 4 * fr;
#define EPI_FMAC(te, x, w, CTRL) asm("v_fmac_f32_dpp %0, %1, %2 " CTRL " row_mask:0xf bank_mask:0xf" : "+v"(te) : "v"(x), "v"(w))
        const PG8_LAS float* pprev[2]; const PG8_LAS float* pnext[2];
#pragma unroll
        for (int ai = 0; ai < 2; ++ai) {
            const int sp = 2 * (2 * ai + wr) - 1, sn = 2 * (2 * ai + wr) + 2;
            pprev[ai] = (fr == 0 && sp >= 0) ? ex + sp * 256 + ucol : (const PG8_LAS float*)zlds;
            pnext[ai] = (fr == 15 && sn <= 7) ? ex + sn * 256 + ucol : (const PG8_LAS float*)zlds;
        }
        f32x4 nw0, nw1, nw2, nbp, nbn;
#define EPI_LOADOPS(g_) do { const int ai_ = (g_) >> 2, n_ = ((g_) >> 1) & 1, bj_ = (g_) & 1; \
            nw0 = *(const PG8_LAS f32x4*)(wb + (0 * 2 + bj_) * 128 + ucol + 4 * n_); nw1 = *(const PG8_LAS f32x4*)(wb + (1 * 2 + bj_) * 128 + ucol + 4 * n_); nw2 = *(const PG8_LAS f32x4*)(wb + (2 * 2 + bj_) * 128 + ucol + 4 * n_); \
            nbp = *(const PG8_LAS f32x4*)(pprev[ai_] + 128 * bj_ + 4 * n_); nbn = *(const PG8_LAS f32x4*)(pnext[ai_] + 128 * bj_ + 4 * n_); } while (0)
        EPI_LOADOPS(0);
        unsigned o0[4][2];
        f32x4 hg[4];
#pragma unroll
        for (int g = 0; g < 8; ++g) {
            const int ai = g >> 2, n = (g >> 1) & 1, bj = g & 1;
            const f32x4 w0 = nw0, w1 = nw1, w2 = nw2, bprev = nbp, bnext = nbn;
            const f32x4 X0 = acc[ai][bj][0][n], X1 = acc[ai][bj][1][n], X2 = acc[ai][bj][2][n], X3 = acc[ai][bj][3][n];
            f32x4 t[4];
            t[0] = w1 * X0 + w2 * X1 + w0 * bprev;
            t[1] = w1 * X1 + w0 * X0 + w2 * X2;
            t[2] = w1 * X2 + w0 * X1 + w2 * X3;
            t[3] = w1 * X3 + w0 * X2 + w2 * bnext;
#pragma unroll
            for (int e = 0; e < 4; ++e) {
                float ta = t[0][e], tb = t[3][e]; const float x3 = X3[e], x0 = X0[e], w0e = w0[e], w2e = w2[e];
                EPI_FMAC(ta, x3, w0e, "row_shr:1");
                EPI_FMAC(tb, x0, w2e, "row_shl:1");
                t[0][e] = ta; t[3][e] = tb;
            }
            __builtin_amdgcn_sched_barrier(0);
            if (g < 7) EPI_LOADOPS(g + 1);
            __builtin_amdgcn_sched_barrier(0);
#pragma unroll
            for (int m = 0; m < 4; ++m) {
                const f32x4 tm = t[m];
                if (bj == 0) {
                    const f32x4 z = tm * ((tm * tm) * (-0.10294324f) + (-2.30220820f));
                    f32x4 d; d.x = __builtin_amdgcn_exp2f(z.x); d.y = __builtin_amdgcn_exp2f(z.y); d.z = __builtin_amdgcn_exp2f(z.z); d.w = __builtin_amdgcn_exp2f(z.w);
                    d = d + 1.f;
                    f32x4 r; r.x = __builtin_amdgcn_rcpf(d.x); r.y = __builtin_amdgcn_rcpf(d.y); r.z = __builtin_amdgcn_rcpf(d.z); r.w = __builtin_amdgcn_rcpf(d.w);
                    hg[m] = tm * r;
                } else {
                    const f32x4 pv = hg[m] * tm;
                    const unsigned p0 = cvt_pk_bf16(pv.x, pv.y), p1 = cvt_pk_bf16(pv.z, pv.w);
                    if (n == 0) { o0[m][0] = p0; o0[m][1] = p1; }
                    else { u32x4 w4; w4.x = o0[m][0]; w4.y = o0[m][1]; w4.z = p0; w4.w = p1; *(u32x4*)(act + blk_off(row0 + ai * HALF + m, chn0, ldc)) = w4; }
                }
            }
            __builtin_amdgcn_sched_barrier(0);
        }
#undef EPI_LOADOPS
#undef EPI_FMAC
    }
};

template <class Epi, class Sched, bool ALIGN_EPI = false, bool SP2 = false, int VARIANT = 0>
__device__ __forceinline__ void gemm_phase(PG8_LAS unsigned char* lds, PG8_LAS unsigned char* xlds, const Gemm g, const Sched& S, const Epi& E, const int wave_id) {
    int zz_ = 0; asm volatile("" : "+s"(zz_));
    const int lane = (int)__builtin_amdgcn_mbcnt_hi(~0u, __builtin_amdgcn_mbcnt_lo(~0u, (unsigned)zz_));
    int wid = wave_id; asm volatile("" : "+s"(wid));
    const int tid = wid * 64 + lane, wr = wid >> 2, wc = wid & 3, fr = lane & 15, fq = lane >> 4;
    const int K = g.K, nt_def = g.KL / BK;
    unsigned voffA[2], voffB[2];
#pragma unroll
    for (int i = 0; i < 2; ++i) { int R, C; stage_rc(tid * 16 + i * 8192, R, C); const int Rb = Epi::PERM ? ((R & ~31) + perm32(R & 31)) : R;
        const int Ra = Epi::ROWPERM ? ((R & ~63) + 4 * (R & 15) + ((R >> 4) & 3)) : R;
        voffA[i] = (unsigned)(Ra * BK + C) * 2u; voffB[i] = (unsigned)(Rb * BK + C) * 2u; }
    const size_t kstep = (size_t)BM * BK * 2;
    const size_t hstep = (size_t)HALF * BK * 2;
    const size_t tstep = (size_t)(K / BK) * kstep;
    const unsigned ldsw = (unsigned)wid * 1024u;
    const unsigned ldsb = (unsigned)(size_t)lds + ldsw; (void)ldsb;
    const int aoff = lds_byte(wr * 64 + fr, fq * 8), boff = lds_byte(wc * 32 + fr, fq * 8);
#define PG8_SA(b, h) (((b) * 2 + (h)) * HTB)
#define PG8_SB(b, h) ((4 + (b) * 2 + (h)) * HTB)
#if STAGE_ASM
#define PG8_STAGE(bufoff, gbase, voff) do { if (VARIANT != 2) _Pragma("unroll") for (int _i = 0; _i < 2; ++_i) \
        asm volatile("s_mov_b32 m0, %2\n\ts_nop 4\n\tglobal_load_lds_dwordx4 %0, %1" :: "v"((voff)[_i]), "s"((const char*)(gbase)), "s"(ldsb + (unsigned)((bufoff) + _i * 8192)) : "memory", "m0"); } while (0)
#else
#define PG8_STAGE(bufoff, gbase, voff) do { if (VARIANT != 2) _Pragma("unroll") for (int _i = 0; _i < 2; ++_i) \
        __builtin_amdgcn_global_load_lds((const unsigned*)((const char*)(gbase) + (voff)[_i]), (PG8_LAS unsigned*)(lds + (bufoff) + ldsw + _i * 8192), 16, 0, 0); } while (0)
#endif
#define PG8_LDA(dst, b, h) do { if (VARIANT != 3) _Pragma("unroll") for (int m = 0; m < 4; ++m) _Pragma("unroll") for (int k = 0; k < 2; ++k) dst[m][k] = *(const PG8_LAS bf16x8*)(lds + PG8_SA(b, h) + aoff + m * 2048 + k * 1024); } while (0)
#define PG8_LDB(dst, b, h) do { if (VARIANT != 3) _Pragma("unroll") for (int n = 0; n < 2; ++n) _Pragma("unroll") for (int k = 0; k < 2; ++k) dst[n][k] = *(const PG8_LAS bf16x8*)(lds + PG8_SB(b, h) + boff + n * 2048 + k * 1024); } while (0)
#define PG8_MMA(ai, bj, At, Bt) do { __builtin_amdgcn_s_setprio(1); if (VARIANT != 1) _Pragma("unroll") for (int m = 0; m < 4; ++m) _Pragma("unroll") for (int n = 0; n < 2; ++n) _Pragma("unroll") for (int k = 0; k < 2; ++k) \
        acc[ai][bj][m][n] = __builtin_amdgcn_mfma_f32_16x16x32_bf16(Bt[n][k], At[m][k], acc[ai][bj][m][n], 0, 0, 0); __builtin_amdgcn_s_setprio(0); } while (0)
#define PG8_MMA0(ai, bj, At, Bt) do { __builtin_amdgcn_s_setprio(1); if (VARIANT != 1) { _Pragma("unroll") for (int m = 0; m < 4; ++m) _Pragma("unroll") for (int n = 0; n < 2; ++n) \
        acc[ai][bj][m][n] = __builtin_amdgcn_mfma_f32_16x16x32_bf16(Bt[n][0], At[m][0], (f32x4){0.f, 0.f, 0.f, 0.f}, 0, 0, 0); \
        _Pragma("unroll") for (int m = 0; m < 4; ++m) _Pragma("unroll") for (int n = 0; n < 2; ++n) \
        acc[ai][bj][m][n] = __builtin_amdgcn_mfma_f32_16x16x32_bf16(Bt[n][1], At[m][1], acc[ai][bj][m][n], 0, 0, 0); } __builtin_amdgcn_s_setprio(0); } while (0)
#define PG8_WAIT_V(n) asm volatile("s_waitcnt vmcnt(" #n ")" ::: "memory")
#define PG8_WAIT_L(n) asm volatile("s_waitcnt lgkmcnt(" #n ")" ::: "memory")
#define PG8_BAR __builtin_amdgcn_s_barrier()
#define PG8_SCHED __builtin_amdgcn_sched_barrier(0)
    Unit cur{}, nxt{}; int ui = 0;
    if (!S.next(0, cur)) return;
    int nt = cur.nt ? cur.nt : nt_def;
#if GEMM_STAGGER
    {
        const unsigned long long t0 = __builtin_amdgcn_s_memrealtime(); const unsigned long long d = (unsigned long long)(((blockIdx.x >> 6) & 3) * GEMM_STAGGER);
        while (__builtin_amdgcn_s_memrealtime() - t0 < d) __builtin_amdgcn_s_sleep(8);
    }
#endif
    f32x4 acc[2][2][4][2];
    if constexpr (!SP2) {
#pragma unroll
    for (int a = 0; a < 2; ++a)
#pragma unroll
        for (int b = 0; b < 2; ++b)
#pragma unroll
            for (int m = 0; m < 4; ++m)
#pragma unroll
                for (int n = 0; n < 2; ++n) acc[a][b][m][n] = (f32x4){0.f, 0.f, 0.f, 0.f};
    }
    bf16x8 At[4][2], B0[2][2], B1[2][2];
    if (VARIANT == 3) { _Pragma("unroll") for (int m = 0; m < 4; ++m) _Pragma("unroll") for (int k = 0; k < 2; ++k) { At[m][k] = (bf16x8){(short)0x3c00, 1, 2, 3, 4, 5, 6, (short)(tid & 255)}; } _Pragma("unroll") for (int n = 0; n < 2; ++n) _Pragma("unroll") for (int k = 0; k < 2; ++k) { B0[n][k] = At[n][k]; B1[n][k] = At[n + 2][k]; } }
    const char* cA = (const char*)g.A + (size_t)cur.pm * tstep + (size_t)cur.kt0 * kstep; const char* cB = (const char*)g.Bt + (size_t)cur.pn * tstep + (size_t)cur.kt0 * kstep;
    S.a_ready(cur);
    if constexpr (Epi::PREFETCH) E.prefetch(cur, xlds, wid, lane, true);
    if constexpr (SP2) {
        PG8_STAGE(PG8_SB(0, 0), cB, voffB); PG8_STAGE(PG8_SB(0, 1), cB + hstep, voffB); PG8_STAGE(PG8_SA(0, 0), cA, voffA); PG8_STAGE(PG8_SA(0, 1), cA + hstep, voffA);
        if (wr == 1) PG8_BAR;
        PG8_WAIT_V(2); PG8_BAR;
        PG8_STAGE(PG8_SB(1, 0), cB + kstep, voffB); PG8_STAGE(PG8_SA(1, 0), cA + kstep, voffA); PG8_STAGE(PG8_SB(1, 1), cB + hstep + kstep, voffB);
        PG8_WAIT_V(6); PG8_BAR;
    } else {
        PG8_STAGE(PG8_SB(0, 0), cB, voffB); PG8_STAGE(PG8_SA(0, 0), cA, voffA); PG8_STAGE(PG8_SB(0, 1), cB + hstep, voffB); PG8_STAGE(PG8_SA(0, 1), cA + hstep, voffA);
        if (wr == 1) PG8_BAR;
        PG8_WAIT_V(4); PG8_BAR;
        PG8_STAGE(PG8_SB(1, 0), cB + kstep, voffB); PG8_STAGE(PG8_SA(1, 0), cA + kstep, voffA); PG8_STAGE(PG8_SB(1, 1), cB + hstep + kstep, voffB);
        PG8_WAIT_V(6); PG8_BAR;
    }
    for (;;) {
        const bool has_next = S.next(ui + 1, nxt);
        const char* nA = has_next ? (const char*)g.A + (size_t)nxt.pm * tstep + (size_t)nxt.kt0 * kstep : cA; const char* nB = has_next ? (const char*)g.Bt + (size_t)nxt.pn * tstep + (size_t)nxt.kt0 * kstep : cB;
        {
            constexpr int t = 0;
            const bool last = (t == nt - 2);
            const char* a1 = cA + (size_t)(t + 1) * kstep;
            const char* a2 = last ? nA : cA + (size_t)(t + 2) * kstep; const char* b2 = last ? nB : cB + (size_t)(t + 2) * kstep;
            const char* a3 = a2 + kstep; const char* b3 = b2 + kstep;
            if (last && has_next) S.a_ready(nxt);
            if constexpr (SP2) {
            PG8_LDB(B0, 0, 0); PG8_LDB(B1, 0, 1); PG8_SCHED; PG8_LDA(At, 0, 0); PG8_STAGE(PG8_SA(1, 1), a1 + hstep, voffA);
            PG8_WAIT_V(8); PG8_WAIT_L(0); PG8_BAR; PG8_MMA0(0, 0, At, B0); PG8_MMA0(0, 1, At, B1); PG8_BAR; PG8_SCHED;
            PG8_LDA(At, 0, 1); PG8_STAGE(PG8_SB(0, 0), b2, voffB); PG8_STAGE(PG8_SB(0, 1), b2 + hstep, voffB); PG8_STAGE(PG8_SA(0, 0), a2, voffA);
            PG8_WAIT_V(8); PG8_WAIT_L(0); PG8_BAR; PG8_MMA0(1, 0, At, B0); PG8_MMA0(1, 1, At, B1); PG8_BAR; PG8_SCHED;
            PG8_LDB(B0, 1, 0); PG8_LDB(B1, 1, 1); PG8_SCHED; PG8_LDA(At, 1, 0); PG8_STAGE(PG8_SA(0, 1), a2 + hstep, voffA);
            PG8_WAIT_V(8); PG8_WAIT_L(0); PG8_BAR; PG8_MMA(0, 0, At, B0); PG8_MMA(0, 1, At, B1); PG8_BAR; PG8_SCHED;
            PG8_LDA(At, 1, 1); PG8_STAGE(PG8_SB(1, 0), b3, voffB); PG8_STAGE(PG8_SB(1, 1), b3 + hstep, voffB); PG8_STAGE(PG8_SA(1, 0), a3, voffA);
            PG8_WAIT_V(8); PG8_WAIT_L(0); PG8_BAR; PG8_MMA(1, 0, At, B0); PG8_MMA(1, 1, At, B1); PG8_BAR; PG8_SCHED;
            } else {
            PG8_LDB(B0, 0, 0); PG8_SCHED; PG8_LDA(At, 0, 0); PG8_STAGE(PG8_SA(1, 1), a1 + hstep, voffA);
            PG8_WAIT_L(8); PG8_BAR; PG8_WAIT_L(0); PG8_MMA(0, 0, At, B0); PG8_BAR; PG8_SCHED;
            PG8_LDB(B1, 0, 1); PG8_STAGE(PG8_SB(0, 0), b2, voffB);
            PG8_BAR; PG8_WAIT_L(0); PG8_MMA(0, 1, At, B1); PG8_BAR;
            PG8_LDA(At, 0, 1); PG8_STAGE(PG8_SA(0, 0), a2, voffA);
            PG8_BAR; PG8_WAIT_L(0); PG8_MMA(1, 0, At, B0); PG8_BAR; PG8_SCHED;
            PG8_STAGE(PG8_SB(0, 1), b2 + hstep, voffB);
            PG8_WAIT_V(6); PG8_BAR; PG8_MMA(1, 1, At, B1); PG8_BAR;
            PG8_LDB(B0, 1, 0); PG8_SCHED; PG8_LDA(At, 1, 0); PG8_STAGE(PG8_SA(0, 1), a2 + hstep, voffA);
            PG8_WAIT_L(8); PG8_BAR; PG8_WAIT_L(0); PG8_MMA(0, 0, At, B0); PG8_BAR; PG8_SCHED;
            PG8_LDB(B1, 1, 1); PG8_STAGE(PG8_SB(1, 0), b3, voffB);
            PG8_BAR; PG8_WAIT_L(0); PG8_MMA(0, 1, At, B1); PG8_BAR;
            PG8_LDA(At, 1, 1); PG8_STAGE(PG8_SA(1, 0), a3, voffA);
            PG8_BAR; PG8_WAIT_L(0); PG8_MMA(1, 0, At, B0); PG8_BAR; PG8_SCHED;
            PG8_STAGE(PG8_SB(1, 1), b3 + hstep, voffB);
            PG8_WAIT_V(6); PG8_BAR; PG8_MMA(1, 1, At, B1); PG8_BAR;
            }
                }
        for (int t = 2; t < nt; t += 2) {
            const bool last = (t == nt - 2);
            const char* a1 = cA + (size_t)(t + 1) * kstep;
            const char* a2 = last ? nA : cA + (size_t)(t + 2) * kstep; const char* b2 = last ? nB : cB + (size_t)(t + 2) * kstep;
            const char* a3 = a2 + kstep; const char* b3 = b2 + kstep;
            if (last && has_next) S.a_ready(nxt);
            if constexpr (SP2) {
            PG8_LDB(B0, 0, 0); PG8_LDB(B1, 0, 1); PG8_SCHED; PG8_LDA(At, 0, 0); PG8_STAGE(PG8_SA(1, 1), a1 + hstep, voffA);
            PG8_WAIT_V(8); PG8_WAIT_L(0); PG8_BAR; PG8_MMA(0, 0, At, B0); PG8_MMA(0, 1, At, B1); PG8_BAR; PG8_SCHED;
            PG8_LDA(At, 0, 1); PG8_STAGE(PG8_SB(0, 0), b2, voffB); PG8_STAGE(PG8_SB(0, 1), b2 + hstep, voffB); PG8_STAGE(PG8_SA(0, 0), a2, voffA);
            PG8_WAIT_V(8); PG8_WAIT_L(0); PG8_BAR; PG8_MMA(1, 0, At, B0); PG8_MMA(1, 1, At, B1); PG8_BAR; PG8_SCHED;
            PG8_LDB(B0, 1, 0); PG8_LDB(B1, 1, 1); PG8_SCHED; PG8_LDA(At, 1, 0); PG8_STAGE(PG8_SA(0, 1), a2 + hstep, voffA);
            PG8_WAIT_V(8); PG8_WAIT_L(0); PG8_BAR; PG8_MMA(0, 0, At, B0); PG8_MMA(0, 1, At, B1); PG8_BAR; PG8_SCHED;
            PG8_LDA(At, 1, 1); PG8_STAGE(PG8_SB(1, 0), b3, voffB); PG8_STAGE(PG8_SB(1, 1), b3 + hstep, voffB); PG8_STAGE(PG8_SA(1, 0), a3, voffA);
            PG8_WAIT_V(8); PG8_WAIT_L(0); PG8_BAR; PG8_MMA(1, 0, At, B0); PG8_MMA(1, 1, At, B1); PG8_BAR; PG8_SCHED;
            } else {
            PG8_LDB(B0, 0, 0); PG8_SCHED; PG8_LDA(At, 0, 0); PG8_STAGE(PG8_SA(1, 1), a1 + hstep, voffA);
            PG8_WAIT_L(8); PG8_BAR; PG8_WAIT_L(0); PG8_MMA(0, 0, At, B0); PG8_BAR; PG8_SCHED;
            PG8_LDB(B1, 0, 1); PG8_STAGE(PG8_SB(0, 0), b2, voffB);
            PG8_BAR; PG8_WAIT_L(0); PG8_MMA(0, 1, At, B1); PG8_BAR;
            PG8_LDA(At, 0, 1); PG8_STAGE(PG8_SA(0, 0), a2, voffA);
            PG8_BAR; PG8_WAIT_L(0); PG8_MMA(1, 0, At, B0); PG8_BAR; PG8_SCHED;
            PG8_STAGE(PG8_SB(0, 1), b2 + hstep, voffB);
            PG8_WAIT_V(6); PG8_BAR; PG8_MMA(1, 1, At, B1); PG8_BAR;
            PG8_LDB(B0, 1, 0); PG8_SCHED; PG8_LDA(At, 1, 0); PG8_STAGE(PG8_SA(0, 1), a2 + hstep, voffA);
            PG8_WAIT_L(8); PG8_BAR; PG8_WAIT_L(0); PG8_MMA(0, 0, At, B0); PG8_BAR; PG8_SCHED;
            PG8_LDB(B1, 1, 1); PG8_STAGE(PG8_SB(1, 0), b3, voffB);
            PG8_BAR; PG8_WAIT_L(0); PG8_MMA(0, 1, At, B1); PG8_BAR;
            PG8_LDA(At, 1, 1); PG8_STAGE(PG8_SA(1, 0), a3, voffA);
            PG8_BAR; PG8_WAIT_L(0); PG8_MMA(1, 0, At, B0); PG8_BAR; PG8_SCHED;
            PG8_STAGE(PG8_SB(1, 1), b3 + hstep, voffB);
            PG8_WAIT_V(6); PG8_BAR; PG8_MMA(1, 1, At, B1); PG8_BAR;
            }
                }
        if constexpr (ALIGN_EPI) { if (wr == 0) PG8_BAR; }
        if constexpr (Epi::PREFETCH) { E(acc, cur, wr, wc, fr, fq, xlds + (ui & 1) * Epi::XBLK, xlds + Epi::ZOFF); if (has_next) E.prefetch(nxt, xlds + ((ui + 1) & 1) * Epi::XBLK, wid, lane, false); }
        else E(acc, cur, wr, wc, fr, fq, xlds);
        S.done(cur);
        if (!has_next) break;
        if constexpr (!SP2) {
#pragma unroll
        for (int a = 0; a < 2; ++a)
#pragma unroll
            for (int b = 0; b < 2; ++b)
#pragma unroll
                for (int m = 0; m < 4; ++m)
#pragma unroll
                    for (int n = 0; n < 2; ++n) acc[a][b][m][n] = (f32x4){0.f, 0.f, 0.f, 0.f};
        }
        cur = nxt; cA = nA; cB = nB; ++ui; nt = cur.nt ? cur.nt : nt_def;
        if constexpr (ALIGN_EPI) { if (wr == 1) PG8_BAR; }
    }
    PG8_WAIT_V(0);
    if constexpr (!ALIGN_EPI) { if (wr == 0) PG8_BAR; }
    PG8_BAR;
#undef PG8_SA
#undef PG8_SB
#undef PG8_STAGE
#undef PG8_LDA
#undef PG8_LDB
#undef PG8_MMA
#undef PG8_WAIT_V
#undef PG8_MMA0
#undef PG8_WAIT_L
#undef PG8_BAR
#undef PG8_SCHED
}
}

constexpr int NWAVES = 8;
constexpr int D = 2048, DEPTH = 4;
constexpr int NB_CTX = 16, L_CTX = 256, NB_LAT = 8, L_LAT = 4096;
constexpr int M_CTX = NB_CTX * L_CTX, M_LAT = NB_LAT * L_LAT, M = M_CTX + M_LAT;
constexpr int DCONV = 1024, DRNN = 1024, NH = 16, HD = 64, DIN = 5120, DFF = 6144, NUP = 12288;
constexpr int NVEC = 9;
constexpr int NMODC = 6 * D;
constexpr float EPS = 1e-6f;
constexpr int P2_NMAIN = 4096;
constexpr int M_MAIN = 32768;
constexpr int NCHUNK = M / 64;

constexpr size_t MiB = 1u << 20;
constexpr size_t WS_CTL = 0, CTL_ZERO_BYTES = 64 * 1024;
constexpr size_t WS_MODV = 1 * MiB;
constexpr size_t WS_SUMM = 3 * MiB;
constexpr size_t WS_HIN = 43 * MiB;
constexpr size_t WS_GATEW = 13 * MiB;
constexpr size_t WS_EDGE = 16 * MiB;
constexpr size_t WS_W = 48 * MiB;
constexpr size_t W_LAYER = 100 * MiB, W_IN_OFF = 0, W_OUT_OFF = 20 * MiB, W_UP_OFF = 28 * MiB, W_DOWN_OFF = 76 * MiB;
constexpr size_t WS_A = 448 * MiB;
constexpr size_t WS_BIG = 592 * MiB;
constexpr size_t WS_Y = 1024 * MiB;
constexpr size_t WS_Y2 = 1312 * MiB;
constexpr size_t WS_X = 1168 * MiB;
constexpr size_t WS_HPRE = 1312 * MiB;
constexpr size_t WS_END = 1408 * MiB;
constexpr int CW_BAR = 1024;

constexpr int RING_BYTES = 131072;
constexpr int MISC_OFF = 155648;
constexpr int LDS_BYTES = 156160;

#define GAS __attribute__((address_space(1)))
#define LAS __attribute__((address_space(3)))
typedef unsigned short bf16;
typedef unsigned v4u __attribute__((ext_vector_type(4)));
typedef unsigned v2u __attribute__((ext_vector_type(2)));
typedef float f32x4 __attribute__((ext_vector_type(4)));
typedef float f32x2 __attribute__((ext_vector_type(2)));
#define LDS_WAIT() asm volatile("s_waitcnt lgkmcnt(0)" ::: "memory")
__device__ __forceinline__ unsigned f2bf(float f) { unsigned u = __builtin_bit_cast(unsigned, f); return (u + 0x7fffu + ((u >> 16) & 1u)) >> 16; }
__device__ __forceinline__ unsigned pk2(float lo, float hi) { return f2bf(lo) | (f2bf(hi) << 16); }
typedef __bf16 bf16v2 __attribute__((ext_vector_type(2)));
__device__ __forceinline__ unsigned pkbf(float lo, float hi) { const bf16v2 t = __builtin_convertvector((f32x2){lo, hi}, bf16v2); return __builtin_bit_cast(unsigned, t); }
__device__ __forceinline__ float bf2f(unsigned short b) { return __builtin_bit_cast(float, ((unsigned)b) << 16); }
__device__ __forceinline__ float bflo(unsigned w) { return __builtin_bit_cast(float, w << 16); }
__device__ __forceinline__ float bfhi(unsigned w) { return __builtin_bit_cast(float, w & 0xffff0000u); }
__device__ __forceinline__ float sigmoidf_(float x) { return 1.f / (1.f + __expf(-x)); }
__device__ __forceinline__ float gelu_tanh(float x) { const float u = 1.5957691216057308f * (x + 0.044715f * x * x * x); return x / (1.f + __expf(-u)); }
__device__ __forceinline__ float wave_sum(float v) {
#pragma unroll
    for (int o = 1; o < 64; o <<= 1) v += __shfl_xor(v, o);
    return v;
}

#define XB_TMO      128
#define XB_XCNT(j)  (256  + 64 * (j))
#define XB_XSUB(j)  (1280 + 64 * (j))
#define XB_XGEN(j)  (2304 + 64 * (j))
#define XB_TOP      3328
#define XB_TOPGEN   3392
#define XCD_BAR_WORDS 3456
#define XB_SPIN_CAP (1u << 18)
__device__ __forceinline__ unsigned xb_ld(unsigned* p)              { return __hip_atomic_load(p, __ATOMIC_RELAXED, __HIP_MEMORY_SCOPE_AGENT); }
__device__ __forceinline__ unsigned xb_add(unsigned* p, unsigned v) { return __hip_atomic_fetch_add(p, v, __ATOMIC_RELAXED, __HIP_MEMORY_SCOPE_AGENT); }
__device__ __forceinline__ unsigned xb_xcc_id() { return (unsigned)__builtin_amdgcn_s_getreg((3 << 11) | 20) & 0xFu; }
#define XB_SPIN(cond, bar) do { unsigned _sp = 0; while (cond) { __builtin_amdgcn_s_sleep(1); \
    if ((++_sp & 255u) == 0u) { if (xb_ld(&(bar)[XB_TMO])) break; if (_sp > XB_SPIN_CAP) { atomicAdd(&(bar)[XB_TMO], 1u); break; } } } } while (0)
struct XcdBarrier { unsigned* bar; unsigned x; volatile LAS unsigned* st; int wave; };
__device__ __forceinline__ bool xb_thread0(int wave) { int z = 0; asm volatile("" : "+s"(z)); return wave == 0 && __builtin_amdgcn_mbcnt_hi(~0u, __builtin_amdgcn_mbcnt_lo(~0u, (unsigned)z)) == 0u; }
__device__ __forceinline__ XcdBarrier xcd_barrier_post(unsigned* bar, volatile LAS unsigned* st, int wave) {
    XcdBarrier b; b.bar = bar; b.x = xb_xcc_id(); b.st = st; b.wave = wave;
    if (xb_thread0(wave)) (void)xb_add(&bar[XB_XCNT(b.x)], 1u);
    return b;
}
__device__ __forceinline__ void xcd_barrier_complete(unsigned* bar, unsigned x, unsigned& nloc, unsigned& nx) {
    const unsigned G = gridDim.x * gridDim.y * gridDim.z;
    unsigned sum, cnt, mine, sp = 0u;
    for (;;) {
        sum = 0u; cnt = 0u; mine = 0u;
#pragma unroll
        for (unsigned j = 0; j < 16; ++j) { const unsigned c = xb_ld(&bar[XB_XCNT(j)]); sum += c; cnt += (c > 0u) ? 1u : 0u; mine = (j == x) ? c : mine; }
        if (sum == G) break;
        __builtin_amdgcn_s_sleep(1);
        if ((++sp & 255u) == 0u) { if (xb_ld(&bar[XB_TMO])) break; if (sp > XB_SPIN_CAP) { atomicAdd(&bar[XB_TMO], 1u); break; } }
    }
    nloc = mine > 0u ? mine : 1u; nx = cnt > 0u ? cnt : 1u;
}
__device__ __forceinline__ void xcd_barrier(const XcdBarrier& b) {
    asm volatile("s_waitcnt vmcnt(0)" ::: "memory");
    __syncthreads();
    if (xb_thread0(b.wave)) {
        unsigned* bar = b.bar; asm volatile("" : "+s"(bar));
        __builtin_amdgcn_s_waitcnt(0);
        unsigned nloc = b.st[0], nx = b.st[1];
        if (nloc == 0u) { xcd_barrier_complete(bar, b.x, nloc, nx); b.st[0] = nloc; b.st[1] = nx; }
        const unsigned old = xb_add(&bar[XB_XSUB(b.x)], 1u);
        const unsigned gen = old / nloc;
        if (old + 1u == (gen + 1u) * nloc) {
            __builtin_amdgcn_fence(__ATOMIC_RELEASE, "agent");
            asm volatile("s_waitcnt vmcnt(0)" ::: "memory");
            const unsigned og = xb_add(&bar[XB_TOP], 1u);
            const unsigned tg = og / nx;
            if (og + 1u == (tg + 1u) * nx) xb_add(&bar[XB_TOPGEN], 1u);
            else XB_SPIN(xb_ld(&bar[XB_TOPGEN]) == tg, bar);
            __builtin_amdgcn_fence(__ATOMIC_ACQUIRE, "agent");
            xb_add(&bar[XB_XGEN(b.x)], 1u);
            asm volatile("s_waitcnt vmcnt(0)" ::: "memory");
        } else {
            XB_SPIN(xb_ld(&bar[XB_XGEN(b.x)]) == gen, bar);
            __builtin_amdgcn_fence(__ATOMIC_ACQUIRE, "agent");
            asm volatile("s_waitcnt vmcnt(0)" ::: "memory");
        }
    }
    __syncthreads();
}

struct Args {
    const float* in[21];
    float* out; unsigned char* ws;
    int ph_lo, ph_hi;
    int rep[8];
};
enum { I_XP = 0, I_XS, I_STATE, I_C, I_CCTX, I_WADA, I_BADA, I_NORMG, I_WIN, I_CONVA, I_RCW, I_RCB, I_RWA, I_RBA, I_RWX, I_RBX, I_RLAM, I_WOUT, I_FUP, I_FCW, I_FDOWN };

__device__ __forceinline__ void transpose_item(const float* W, int K, int N, bf16* WT, int k0, int n0, int dst_row0, LAS float* scr, int lane) {
#pragma unroll 8
    for (int i = 0; i < 32; ++i) { const int kk = 2 * i + (lane >> 5); scr[kk * 33 + (lane & 31)] = W[(size_t)(k0 + kk) * N + n0 + (lane & 31)]; }
    LDS_WAIT(); asm volatile("" ::: "memory");
    const int c = lane & 7;
#pragma unroll
    for (int j = 0; j < 4; ++j) { const int n = (lane >> 3) + 8 * j; const LAS float* s = scr + (8 * c) * 33 + n;
        v4u o; o.x = pk2(s[0 * 33], s[1 * 33]); o.y = pk2(s[2 * 33], s[3 * 33]); o.z = pk2(s[4 * 33], s[5 * 33]); o.w = pk2(s[6 * 33], s[7 * 33]);
        *(GAS v4u*)(WT + blk_off(dst_row0 + n, k0 + 8 * c, K)) = o; }
    LDS_WAIT(); asm volatile("" ::: "memory");
}
constexpr int TI_IN = (D / 64) * (DIN / 32), TI_OUT = (D / 64) * (D / 32), TI_UP = (D / 64) * (NUP / 32), TI_DOWN = (DFF / 64) * (D / 32);
constexpr int TI_LAYER = TI_IN + TI_OUT + TI_UP + TI_DOWN;

__device__ __forceinline__ void pre_transposes(const Args& a, LAS unsigned char* lds, int gw, int NGW, int wave, int lane) {
    LAS float* scr = (LAS float*)(lds + wave * 16384);
    for (int it = gw; it < DEPTH * 2 * 2 * NH * 2; it += NGW) {
        const int half = it & 1, mat = it >> 1, hd = mat & 15, gate = (mat >> 4) & 1, ld = mat >> 5;
        const float* W = (gate ? a.in[I_RWX] : a.in[I_RWA]) + (size_t)(ld * NH + hd) * 64 * 64;
        transpose_item(W, 64, 64, (bf16*)(a.ws + WS_GATEW) + (size_t)((ld * 2 + gate) * NH + hd) * 64 * 64, 0, 32 * half, 32 * half, scr, lane);
    }
    for (int it = gw; it < DEPTH * TI_LAYER; it += NGW) {
        const int l = it / TI_LAYER; int r = it % TI_LAYER;
        bf16* wl = (bf16*)(a.ws + WS_W + (size_t)l * W_LAYER);
        if (r < TI_IN) { const int nblk = DIN / 32, kb = r / nblk, nb = r % nblk;
            transpose_item(a.in[I_WIN] + (size_t)l * D * DIN, D, DIN, (bf16*)((unsigned char*)wl + W_IN_OFF), 64 * kb, 32 * nb, 32 * nb, scr, lane); continue; }
        r -= TI_IN;
        if (r < TI_OUT) { const int nblk = D / 32, kb = r / nblk, nb = r % nblk;
            transpose_item(a.in[I_WOUT] + (size_t)l * D * D, D, D, (bf16*)((unsigned char*)wl + W_OUT_OFF), 64 * kb, 32 * nb, 32 * nb, scr, lane); continue; }
        r -= TI_OUT;
        if (r < TI_UP) { const int nblk = NUP / 32, kb = r / nblk, nb = r % nblk; const int n0 = 32 * nb;
            const int dst = (n0 < DFF) ? ((n0 >> 7) * 256 + (n0 & 127)) : ((((n0 - DFF) >> 7) * 256) + 128 + ((n0 - DFF) & 127));
            transpose_item(a.in[I_FUP] + (size_t)l * D * NUP, D, NUP, (bf16*)((unsigned char*)wl + W_UP_OFF), 64 * kb, n0, dst, scr, lane); continue; }
        r -= TI_UP;
        { const int nblk = D / 32, kb = r / nblk, nb = r % nblk;
            transpose_item(a.in[I_FDOWN] + (size_t)l * DFF * D, DFF, D, (bf16*)((unsigned char*)wl + W_DOWN_OFF), 64 * kb, 32 * nb, 32 * nb, scr, lane); }
    }
}

__device__ __forceinline__ void pre_mod(const Args& a, LAS unsigned char* lds, int tid, int wave, int lane) {
    LAS float* s = (LAS float*)lds;
    LAS float* red = s + NVEC * D;
    for (int i = tid; i < NVEC * D; i += NWAVES * 64) { const int v = i / D, k = i % D; const float c = (v == 0) ? a.in[I_CCTX][k] : a.in[I_C][(v - 1) * D + k]; s[i] = c / (1.f + __expf(-c)); }
    __syncthreads();
    float* modv = (float*)(a.ws + WS_MODV);
    const int cl = tid & 15, ks = tid >> 4;
    for (int item = blockIdx.x; item < DEPTH * (NMODC / 64); item += gridDim.x) {
        const int l = item / (NMODC / 64), n0 = (item % (NMODC / 64)) * 64;
        float acc[NVEC][4];
#pragma unroll
        for (int v = 0; v < NVEC; ++v) { acc[v][0] = 0.f; acc[v][1] = 0.f; acc[v][2] = 0.f; acc[v][3] = 0.f; }
        const float* wp = a.in[I_WADA] + ((size_t)l * D + ks * 64) * NMODC + n0 + 4 * cl;
        const LAS float* sp = s + ks * 64;
#pragma unroll 8
        for (int kk = 0; kk < 64; ++kk) {
            const f32x4 w = *(const f32x4*)(wp + (size_t)kk * NMODC);
#pragma unroll
            for (int v = 0; v < NVEC; ++v) { const float sv = sp[v * D + kk]; acc[v][0] += sv * w[0]; acc[v][1] += sv * w[1]; acc[v][2] += sv * w[2]; acc[v][3] += sv * w[3]; }
        }
#pragma unroll
        for (int v = 0; v < NVEC; ++v)
#pragma unroll
            for (int e = 0; e < 4; ++e) { float t = acc[v][e]; t += __shfl_xor(t, 16); t += __shfl_xor(t, 32); if (lane < 16) red[(wave * 16 + cl) * 36 + v * 4 + e] = t; }
        __syncthreads();
        for (int o = tid; o < NVEC * 64; o += NWAVES * 64) {
            const int v = o >> 6, col = o & 63;
            float sum = 0.f;
#pragma unroll
            for (int w = 0; w < NWAVES; ++w) sum += red[(w * 16 + (col >> 2)) * 36 + v * 4 + (col & 3)];
            const int n = n0 + col, q = n / D, j = n % D;
            const float val = sum + a.in[I_BADA][l * NMODC + n];
            const float* ng = a.in[I_NORMG] + (size_t)l * 4 * D;
            int slot; float r;
            if (q == 0) { slot = 1; r = val; }
            else if (q == 1) { slot = 0; r = ng[0 * D + j] * (1.f + val); }
            else if (q == 2) { slot = 2; r = val * ng[1 * D + j]; }
            else if (q == 3) { slot = 4; r = val; }
            else if (q == 4) { slot = 3; r = ng[2 * D + j] * (1.f + val); }
            else { slot = 5; r = val * ng[3 * D + j]; }
            modv[((size_t)(l * NVEC + v) * 6 + slot) * D + j] = r;
        }
        __syncthreads();
    }
}

template <bool XSRC_F32, bool HAS_RES, int XW, bool HAS_U>
__device__ __forceinline__ void resnorm_rows(const Args& a, LAS unsigned char* lds, int tid, int wave, int lane, int l_res, int slot_res, int l_u, int su) {
    const float* modv = (const float*)(a.ws + WS_MODV);
    bf16* U = (bf16*)(a.ws + WS_A);
    bf16* X = (bf16*)(a.ws + WS_X);
    const bf16* Y = (const bf16*)(a.ws + WS_Y);
    const bf16* Y2 = (const bf16*)(a.ws + WS_Y2);
    const bool split_tail = (gridDim.x == 256);
    const int rpb = (M + (int)gridDim.x - 1) / (int)gridDim.x, r_lo = (int)blockIdx.x * rpb, r_hi = (r_lo + rpb < M) ? r_lo + rpb : M;
    if (r_lo >= M) return;
    const int v_lo = (r_lo < M_CTX) ? 0 : 1 + ((r_lo - M_CTX) >> 12);
    LAS float* vl = (LAS float*)lds;
    for (int i = tid; i < 2 * 3 * (D / 4); i += NWAVES * 64) {
        const int e4 = i % (D / 4), k = (i / (D / 4)) % 3, vv = i / (3 * (D / 4));
        const int v = (v_lo + vv < NVEC) ? v_lo + vv : NVEC - 1;
        const float* src = (k == 0) ? modv + ((size_t)(l_res * NVEC + v) * 6 + slot_res) * D : modv + ((size_t)(l_u * NVEC + v) * 6 + su + (k - 1)) * D;
        f32x4 val = (f32x4){0.f, 0.f, 0.f, 0.f};
        if ((k == 0 && HAS_RES) || (k > 0 && HAS_U)) val = *(const GAS f32x4*)(src + 4 * e4);
        *(LAS f32x4*)(vl + (size_t)(vv * 3 + k) * D + 4 * e4) = val;
    }
    __syncthreads();
    v4u rx[4], ry[4], ry2[4]; f32x4 fx[8];
    auto issue = [&](int m) {
        if (XSRC_F32) { const float* xs = (m < M_CTX) ? a.in[I_XP] + (size_t)m * D : a.in[I_XS] + (size_t)(m - M_CTX) * D;
#pragma unroll
            for (int j = 0; j < 4; ++j) { fx[2 * j] = __builtin_nontemporal_load((const GAS f32x4*)(xs + 8 * (lane + 64 * j))); fx[2 * j + 1] = __builtin_nontemporal_load((const GAS f32x4*)(xs + 8 * (lane + 64 * j) + 4)); } }
        else {
#pragma unroll
            for (int j = 0; j < 4; ++j) rx[j] = __builtin_nontemporal_load((const GAS v4u*)(X + (size_t)m * D + 8 * (lane + 64 * j))); }
        if (HAS_RES) {
#pragma unroll
            for (int j = 0; j < 4; ++j) ry[j] = __builtin_nontemporal_load((const GAS v4u*)(Y + (size_t)m * D + 8 * (lane + 64 * j)));
            if (split_tail && m >= M_MAIN) {
#pragma unroll
                for (int j = 0; j < 4; ++j) ry2[j] = __builtin_nontemporal_load((const GAS v4u*)(Y2 + (size_t)(m - M_MAIN) * D + 8 * (lane + 64 * j))); }
        }
    };
    int m = r_lo + wave;
    if (m < r_hi) issue(m);
    for (; m < r_hi; m += NWAVES) {
        const int v = (m < M_CTX) ? 0 : 1 + ((m - M_CTX) >> 12);
        const LAS float* vb = vl + (size_t)((v - v_lo) * 3) * D;
        float xv[4][8];
        if (XSRC_F32) {
#pragma unroll
            for (int j = 0; j < 4; ++j) { const f32x4 p = fx[2 * j], q = fx[2 * j + 1];
                xv[j][0] = p.x; xv[j][1] = p.y; xv[j][2] = p.z; xv[j][3] = p.w; xv[j][4] = q.x; xv[j][5] = q.y; xv[j][6] = q.z; xv[j][7] = q.w; }
        } else {
#pragma unroll
            for (int j = 0; j < 4; ++j) { const v4u p = rx[j];
                xv[j][0] = bflo(p.x); xv[j][1] = bfhi(p.x); xv[j][2] = bflo(p.y); xv[j][3] = bfhi(p.y); xv[j][4] = bflo(p.z); xv[j][5] = bfhi(p.z); xv[j][6] = bflo(p.w); xv[j][7] = bfhi(p.w); }
        }
        float yv[4][8];
        if (HAS_RES) {
#pragma unroll
            for (int j = 0; j < 4; ++j) { const v4u p = ry[j];
                yv[j][0] = bflo(p.x); yv[j][1] = bfhi(p.x); yv[j][2] = bflo(p.y); yv[j][3] = bfhi(p.y); yv[j][4] = bflo(p.z); yv[j][5] = bfhi(p.z); yv[j][6] = bflo(p.w); yv[j][7] = bfhi(p.w); }
            if (split_tail && m >= M_MAIN) {
#pragma unroll
                for (int j = 0; j < 4; ++j) { const v4u p = ry2[j];
                    yv[j][0] += bflo(p.x); yv[j][1] += bfhi(p.x); yv[j][2] += bflo(p.y); yv[j][3] += bfhi(p.y); yv[j][4] += bflo(p.z); yv[j][5] += bfhi(p.z); yv[j][6] += bflo(p.w); yv[j][7] += bfhi(p.w); }
            }
        }
        if (m + NWAVES < r_hi) issue(m + NWAVES);
        if (HAS_RES) {
            float ss = 0.f;
#pragma unroll
            for (int j = 0; j < 4; ++j)
#pragma unroll
                for (int e = 0; e < 8; ++e) ss += yv[j][e] * yv[j][e];
            const float rstd = 1.f / sqrtf(wave_sum(ss) * (1.f / D) + EPS);
#pragma unroll
            for (int j = 0; j < 4; ++j) { const f32x4 g0 = *(const LAS f32x4*)(vb + 8 * (lane + 64 * j)), g1 = *(const LAS f32x4*)(vb + 8 * (lane + 64 * j) + 4);
                xv[j][0] += g0.x * yv[j][0] * rstd; xv[j][1] += g0.y * yv[j][1] * rstd; xv[j][2] += g0.z * yv[j][2] * rstd; xv[j][3] += g0.w * yv[j][3] * rstd;
                xv[j][4] += g1.x * yv[j][4] * rstd; xv[j][5] += g1.y * yv[j][5] * rstd; xv[j][6] += g1.z * yv[j][6] * rstd; xv[j][7] += g1.w * yv[j][7] * rstd; }
        }
        if (XW == 1) {
#pragma unroll
            for (int j = 0; j < 4; ++j) { v4u o; o.x = pkbf(xv[j][0], xv[j][1]); o.y = pkbf(xv[j][2], xv[j][3]); o.z = pkbf(xv[j][4], xv[j][5]); o.w = pkbf(xv[j][6], xv[j][7]);
                __builtin_nontemporal_store(o, (GAS v4u*)(X + (size_t)m * D + 8 * (lane + 64 * j))); }
        } else if (XW == 2) {
#pragma unroll
            for (int j = 0; j < 4; ++j) { float* xo = a.out + (size_t)m * D + 8 * (lane + 64 * j);
                *(GAS f32x4*)xo = (f32x4){xv[j][0], xv[j][1], xv[j][2], xv[j][3]}; *(GAS f32x4*)(xo + 4) = (f32x4){xv[j][4], xv[j][5], xv[j][6], xv[j][7]}; }
        }
        if (HAS_U) {
            float ss = 0.f;
#pragma unroll
            for (int j = 0; j < 4; ++j)
#pragma unroll
                for (int e = 0; e < 8; ++e) ss += xv[j][e] * xv[j][e];
            const float rstd = 1.f / sqrtf(wave_sum(ss) * (1.f / D) + EPS);
            const LAS float* gn = vb + D; const LAS float* bn = vb + 2 * D;
#pragma unroll
            for (int j = 0; j < 4; ++j) { const int e0 = 8 * (lane + 64 * j);
                const f32x4 g0 = *(const LAS f32x4*)(gn + e0), g1 = *(const LAS f32x4*)(gn + e0 + 4), b0 = *(const LAS f32x4*)(bn + e0), b1 = *(const LAS f32x4*)(bn + e0 + 4);
                v4u o; o.x = pkbf(xv[j][0] * rstd * g0.x + b0.x, xv[j][1] * rstd * g0.y + b0.y); o.y = pkbf(xv[j][2] * rstd * g0.z + b0.z, xv[j][3] * rstd * g0.w + b0.w);
                o.z = pkbf(xv[j][4] * rstd * g1.x + b1.x, xv[j][5] * rstd * g1.y + b1.y); o.w = pkbf(xv[j][6] * rstd * g1.z + b1.z, xv[j][7] * rstd * g1.w + b1.w);
                *(GAS v4u*)(U + blk_off(m, e0, D)) = o; }
        }
    }
}

struct SeqInfo { int base, L, s0, b, cfirst, clast; bool col, ctx; };
__device__ __forceinline__ SeqInfo seq_info(int c, int layer) {
    SeqInfo q;
    if (c < 64) { q.b = c >> 2; q.s0 = (c & 3) * 64; q.L = L_CTX; q.base = q.b * L_CTX; q.col = false; q.ctx = true; q.cfirst = c & ~3; q.clast = q.cfirst + 3; }
    else { const int cc = c - 64; q.b = cc >> 6; q.s0 = (cc & 63) * 64; q.L = L_LAT; q.base = M_CTX + q.b * L_LAT; q.col = (layer & 1) != 0; q.ctx = false; q.cfirst = 64 + (cc & ~63); q.clast = q.cfirst + 63; }
    return q;
}
__device__ __forceinline__ int tok_of(const SeqInfo& q, int s) { return q.base + (q.col ? (((s & 63) << 6) | (s >> 6)) : s); }

typedef float f32x16 __attribute__((ext_vector_type(16)));
typedef short bf16x8v __attribute__((ext_vector_type(8)));
constexpr int XROW = 144;
constexpr int XT_BYTES = 10240;
constexpr int HT_BYTES = 9216;
constexpr int WAVE_LDS = XT_BYTES + HT_BYTES;

__device__ __forceinline__ void stage_tile(const bf16* src, const SeqInfo& q, int pos0, int nrows, LAS unsigned char* xt, int lane) {
    const int sub = lane & 7, rsel = lane >> 3;
    v4u val[9];
#pragma unroll
    for (int i = 0; i < 9; ++i) {
        const int s = pos0 + 8 * i + rsel, sc = s < 0 ? 0 : (s >= q.L ? q.L - 1 : s);
        val[i] = *(const v4u*)(src + (size_t)tok_of(q, sc) * DIN + sub * 8);
    }
    if (pos0 >= 0 && pos0 + nrows <= q.L) {
#pragma unroll
        for (int i = 0; i < 9; ++i) { const int rr = 8 * i + rsel; if (rr < nrows) *(LAS v4u*)(xt + rr * XROW + sub * 16) = val[i]; }
        return;
    }
#pragma unroll
    for (int i = 0; i < 9; ++i) {
        const int rr = 8 * i + rsel, s = pos0 + rr; const bool ok = (s >= 0 && s < q.L);
        v4u v = val[i]; v.x = ok ? v.x : 0u; v.y = ok ? v.y : 0u; v.z = ok ? v.z : 0u; v.w = ok ? v.w : 0u;
        if (rr < nrows) *(LAS v4u*)(xt + rr * XROW + sub * 16) = v;
    }
}

template <bool FINAL, int DIR>
__device__ __forceinline__ void scan_dir(const Args& a, int layer, int h, int c, const SeqInfo& q, LAS unsigned char* xt, LAS unsigned char* hft, int lane, float hin0, float hin1) {
    const int ld = layer * 2 + DIR, r = lane & 31, hh = lane >> 5;
    bf16x8v afr[2][4];
#pragma unroll
    for (int ks = 0; ks < 4; ++ks) {
        const int i0 = 16 * ks + 8 * hh;
        const float* cw = a.in[I_RCW] + (size_t)(ld * 4) * DRNN + h * 64 + i0;
        f32x4 w[4][2];
#pragma unroll
        for (int k = 0; k < 4; ++k) { w[k][0] = *(const f32x4*)(cw + k * DRNN); w[k][1] = *(const f32x4*)(cw + k * DRNN + 4); }
        const f32x4 b0 = *(const f32x4*)(a.in[I_RCB] + ld * DRNN + h * 64 + i0), b1 = *(const f32x4*)(a.in[I_RCB] + ld * DRNN + h * 64 + i0 + 4);
#pragma unroll
        for (int tb = 0; tb < 2; ++tb) {
            const int t = tb * 32 + r;
            f32x4 a0 = b0, a1 = b1;
#pragma unroll
            for (int k = 0; k < 4; ++k) {
                const int rr = DIR ? (t + 6 - k) : (t + k);
                const v4u raw = *(const LAS v4u*)(xt + rr * XROW + i0 * 2);
                a0 += w[k][0] * (f32x4){bflo(raw.x), bfhi(raw.x), bflo(raw.y), bfhi(raw.y)};
                a1 += w[k][1] * (f32x4){bflo(raw.z), bfhi(raw.z), bflo(raw.w), bfhi(raw.w)};
            }
            v4u p; p.x = pkbf(a0.x, a0.y); p.y = pkbf(a0.z, a0.w); p.z = pkbf(a1.x, a1.y); p.w = pkbf(a1.z, a1.w);
            afr[tb][ks] = __builtin_bit_cast(bf16x8v, p);
        }
    }
    const bf16* gatew = (const bf16*)(a.ws + WS_GATEW);
    f32x2* summ = (f32x2*)(a.ws + WS_SUMM);
    float* nstate = a.out + (size_t)M * D;
#pragma unroll
    for (int cb = 0; cb < 2; ++cb) {
        const int chh = cb * 32 + r, ch = h * 64 + chh;
        bf16x8v bfr[2][4];
#pragma unroll
        for (int gate = 0; gate < 2; ++gate)
#pragma unroll
            for (int ks = 0; ks < 4; ++ks) bfr[gate][ks] = *(const bf16x8v*)(gatew + ((size_t)((ld * 2 + gate) * NH + h) * 64 + chh) * 64 + 16 * ks + 8 * hh);
        const float nba = -1.4426950408889634f * a.in[I_RBA][ld * DRNN + ch], nbx = -1.4426950408889634f * a.in[I_RBX][ld * DRNN + ch];
        const float c8l2 = -8.f * 1.4426950408889634f * log1pf(__expf(-a.in[I_RLAM][ld * DRNN + ch]));
        bf16x8v self[2];
#pragma unroll
        for (int s2 = 0; s2 < 2; ++s2) { const int idx = r - 16 * s2 - 8 * hh; v4u p;
            p.x = (idx == 0 ? 0x3F80u : 0u) | (idx == 1 ? 0x3F800000u : 0u); p.y = (idx == 2 ? 0x3F80u : 0u) | (idx == 3 ? 0x3F800000u : 0u);
            p.z = (idx == 4 ? 0x3F80u : 0u) | (idx == 5 ? 0x3F800000u : 0u); p.w = (idx == 6 ? 0x3F80u : 0u) | (idx == 7 ? 0x3F800000u : 0u);
            self[s2] = __builtin_bit_cast(bf16x8v, p); }
        float hstate = FINAL ? (cb ? hin1 : hin0) : 0.f, Atot = 1.f;
        const bool first_mine = (hh == DIR);
#pragma unroll
        for (int tbi = 0; tbi < 2; ++tbi) {
            const int tb = DIR ? 1 - tbi : tbi;
            f32x16 accr, acci, accx;
#pragma unroll
            for (int i = 0; i < 16; ++i) { accr[i] = 0.f; acci[i] = 0.f; accx[i] = 0.f; }
#pragma unroll
            for (int ks = 0; ks < 4; ++ks) {
                accr = __builtin_amdgcn_mfma_f32_32x32x16_bf16(afr[tb][ks], bfr[0][ks], accr, 0, 0, 0);
                acci = __builtin_amdgcn_mfma_f32_32x32x16_bf16(afr[tb][ks], bfr[1][ks], acci, 0, 0, 0);
            }
            accx = __builtin_amdgcn_mfma_f32_32x32x16_bf16(afr[tb][2 * cb], self[0], accx, 0, 0, 0);
            accx = __builtin_amdgcn_mfma_f32_32x32x16_bf16(afr[tb][2 * cb + 1], self[1], accx, 0, 0, 0);
            float av[16], vv[16];
#pragma unroll
            for (int qi = 0; qi < 16; qi += 2) {
                const f32x2 tr = (f32x2){accr[qi], accr[qi + 1]} * -1.4426950408889634f + nba, ti = (f32x2){acci[qi], acci[qi + 1]} * -1.4426950408889634f + nbx;
                f32x2 dr, di; dr.x = __builtin_amdgcn_exp2f(tr.x); dr.y = __builtin_amdgcn_exp2f(tr.y); di.x = __builtin_amdgcn_exp2f(ti.x); di.y = __builtin_amdgcn_exp2f(ti.y);
                dr = dr + 1.f; di = di + 1.f;
                f32x2 rg, ig; rg.x = __builtin_amdgcn_rcpf(dr.x); rg.y = __builtin_amdgcn_rcpf(dr.y); ig.x = __builtin_amdgcn_rcpf(di.x); ig.y = __builtin_amdgcn_rcpf(di.y);
                const f32x2 la = rg * c8l2;
                f32x2 aa; aa.x = __builtin_amdgcn_exp2f(la.x); aa.y = __builtin_amdgcn_exp2f(la.y);
                f32x2 w = 1.f - aa * aa;
                f32x2 sq; sq.x = __builtin_amdgcn_sqrtf(fmaxf(0.f, w.x)); sq.y = __builtin_amdgcn_sqrtf(fmaxf(0.f, w.y));
                const f32x2 vq = sq * (ig * (f32x2){accx[qi], accx[qi + 1]});
                av[qi] = aa.x; av[qi + 1] = aa.y; vv[qi] = vq.x; vv[qi + 1] = vq.y;
            }
            float Ao[4], Ho[4], pA[4], pH[4];
#pragma unroll
            for (int gq = 0; gq < 4; ++gq) {
                float A_ = 1.f, H_ = 0.f;
#pragma unroll
                for (int ei = 0; ei < 4; ++ei) { const int qi = 4 * gq + (DIR ? 3 - ei : ei); H_ = av[qi] * H_ + vv[qi]; A_ *= av[qi]; }
                Ao[gq] = A_; Ho[gq] = H_; pA[gq] = __shfl_xor(A_, 32); pH[gq] = __shfl_xor(H_, 32);
            }
#pragma unroll
            for (int gqi = 0; gqi < 4; ++gqi) {
                const int gq = DIR ? 3 - gqi : gqi;
                const float pre = first_mine ? hstate : (pA[gq] * hstate + pH[gq]);
                float post;
                if (FINAL) {
                    float hs = pre;
#pragma unroll
                    for (int ei = 0; ei < 4; ++ei) { const int e = DIR ? 3 - ei : ei, qi = 4 * gq + e; hs = av[qi] * hs + vv[qi]; vv[qi] = hs; }
                    post = hs;
                } else { post = Ao[gq] * pre + Ho[gq]; Atot *= Ao[gq] * pA[gq]; }
                hstate = first_mine ? (pA[gq] * post + pH[gq]) : post;
            }
            if (FINAL) {
                float hold[16];
                if (DIR == 1) {
#pragma unroll
                    for (int qi = 0; qi < 16; ++qi) hold[qi] = bf2f(*(const LAS unsigned short*)(hft + (tb * 32 + (qi & 3) + 8 * (qi >> 2) + 4 * hh) * XROW + chh * 2));
                }
#pragma unroll
                for (int qi = 0; qi < 16; ++qi) {
                    LAS unsigned short* hp = (LAS unsigned short*)(hft + (tb * 32 + (qi & 3) + 8 * (qi >> 2) + 4 * hh) * XROW + chh * 2);
                    *hp = (unsigned short)pkbf(DIR == 1 ? hold[qi] + vv[qi] : vv[qi], 0.f);
                }
            }
        }
        if (!FINAL) { if (hh == 0) summ[(size_t)(c * 2 + DIR) * DRNN + ch] = (f32x2){Atot, hstate}; }
        else if (q.ctx && hh == 0 && c == (DIR ? q.cfirst : q.clast)) nstate[((size_t)(q.b * DEPTH + layer) * 2 + DIR) * DRNN + ch] = hstate;
    }
}

__device__ __forceinline__ void p2_reduce(unsigned char* ws, int gtid, int nthreads) {
    constexpr int NC = DIN - P2_NMAIN, CPR = NC / 8, NR = M - M_MAIN;
    bf16* proj = (bf16*)(ws + WS_BIG); const bf16* px = (const bf16*)(ws + WS_Y2);
    for (int id = gtid; id < NR * CPR; id += nthreads) {
        const int row = id / CPR, cc = id % CPR;
        bf16* dst = proj + (size_t)(M_MAIN + row) * DIN + P2_NMAIN + cc * 8;
        const v4u a = *(const v4u*)dst, b = *(const v4u*)(px + (size_t)row * NC + cc * 8), c = *(const v4u*)(px + (size_t)(NR + row) * NC + cc * 8), d = *(const v4u*)(px + (size_t)(2 * NR + row) * NC + cc * 8);
        v4u o;
        o.x = pkbf(bflo(a.x) + bflo(b.x) + bflo(c.x) + bflo(d.x), bfhi(a.x) + bfhi(b.x) + bfhi(c.x) + bfhi(d.x)); o.y = pkbf(bflo(a.y) + bflo(b.y) + bflo(c.y) + bflo(d.y), bfhi(a.y) + bfhi(b.y) + bfhi(c.y) + bfhi(d.y));
        o.z = pkbf(bflo(a.z) + bflo(b.z) + bflo(c.z) + bflo(d.z), bfhi(a.z) + bfhi(b.z) + bfhi(c.z) + bfhi(d.z)); o.w = pkbf(bflo(a.w) + bflo(b.w) + bflo(c.w) + bflo(d.w), bfhi(a.w) + bfhi(b.w) + bfhi(c.w) + bfhi(d.w));
        *(v4u*)dst = o;
    }
}
__device__ __forceinline__ void scan_summary_item(const Args& a, int layer, int item, int lane, LAS unsigned char* xt) {
    const int d = item & 1, h = (item >> 1) & 15, c = item >> 5;
    const SeqInfo q = seq_info(c, layer);
    stage_tile((const bf16*)(a.ws + WS_BIG) + 3 * DCONV + h * 64, q, q.s0 - 3, 70, xt, lane);
    if (d == 0) scan_dir<false, 0>(a, layer, h, c, q, xt, xt, lane, 0.f, 0.f);
    else scan_dir<false, 1>(a, layer, h, c, q, xt, xt, lane, 0.f, 0.f);
}

__device__ __forceinline__ void carry_phase(const Args& a, int layer, int gtid, int nthreads) {
    const f32x2* summ = (const f32x2*)(a.ws + WS_SUMM);
    float* hin = (float*)(a.ws + WS_HIN);
    for (int it = gtid; it < (NB_CTX + NB_LAT) * 2 * DRNN; it += nthreads) {
        const int ch = it & (DRNN - 1), d = (it >> 10) & 1, sq = it >> 11;
        const bool ctx = sq < NB_CTX; const int b = ctx ? sq : sq - NB_CTX;
        const int cfirst = ctx ? 4 * b : 64 + 64 * b, n = ctx ? 4 : 64;
        float h = ctx ? 0.f : a.in[I_STATE][((size_t)(b * DEPTH + layer) * 2 + d) * DRNN + ch];
        for (int i0 = 0; i0 < n; i0 += 4) {
            f32x2 t[4];
#pragma unroll
            for (int k = 0; k < 4; ++k) { const int cc = d ? (cfirst + n - 1 - (i0 + k)) : (cfirst + i0 + k); t[k] = summ[(size_t)(cc * 2 + d) * DRNN + ch]; }
#pragma unroll
            for (int k = 0; k < 4; ++k) { const int cc = d ? (cfirst + n - 1 - (i0 + k)) : (cfirst + i0 + k); hin[(size_t)(cc * 2 + d) * DRNN + ch] = h; h = t[k].x * h + t[k].y; }
        }
    }
}

__device__ __forceinline__ void mixb_item(const Args& a, int layer, int item, int lane, LAS unsigned char* xt) {
    const int h = item & 15, c = item >> 4, r = lane & 31, hh = lane >> 5;
    const SeqInfo q = seq_info(c, layer);
    const bf16* proj = (const bf16*)(a.ws + WS_BIG);
    stage_tile(proj + 3 * DCONV + h * 64, q, q.s0 - 3, 70, xt, lane);
    LAS unsigned char* hft = xt + XT_BYTES;
    {
        const float hl = ((const float*)(a.ws + WS_HIN))[(size_t)(c * 2 + 0) * DRNN + h * 64 + lane];
        scan_dir<true, 0>(a, layer, h, c, q, xt, hft, lane, __shfl(hl, r), __shfl(hl, 32 + r));
    }
    {
        const float hl = ((const float*)(a.ws + WS_HIN))[(size_t)(c * 2 + 1) * DRNN + h * 64 + lane];
        scan_dir<true, 1>(a, layer, h, c, q, xt, hft, lane, __shfl(hl, r), __shfl(hl, 32 + r));
    }
    stage_tile(proj + 3 * DCONV + DRNN + h * 64, q, q.s0, 64, xt, lane);
    bf16* ymix0 = (bf16*)(a.ws + WS_A);
    const int sub = lane & 7, rsel = lane >> 3;
#pragma unroll
    for (int r0 = 0; r0 < 64; r0 += 8) {
        const int rr = r0 + rsel;
        const v4u hv = *(const LAS v4u*)(hft + rr * XROW + sub * 16), gv = *(const LAS v4u*)(xt + rr * XROW + sub * 16);
        v4u val;
        val.x = pkbf(bflo(hv.x) * gelu_tanh(bflo(gv.x)), bfhi(hv.x) * gelu_tanh(bfhi(gv.x))); val.y = pkbf(bflo(hv.y) * gelu_tanh(bflo(gv.y)), bfhi(hv.y) * gelu_tanh(bfhi(gv.y)));
        val.z = pkbf(bflo(hv.z) * gelu_tanh(bflo(gv.z)), bfhi(hv.z) * gelu_tanh(bfhi(gv.z))); val.w = pkbf(bflo(hv.w) * gelu_tanh(bflo(gv.w)), bfhi(hv.w) * gelu_tanh(bfhi(gv.w)));
        *(v4u*)(ymix0 + blk_off(tok_of(q, q.s0 + rr), DCONV + h * 64 + sub * 8, D)) = val;
    }
}

__device__ __forceinline__ void mixa_item(const Args& a, int layer, int item, int lane) {
    const int g4 = item & 3, c16 = item >> 2, ch0 = g4 * 256 + lane * 4;
    const SeqInfo q = seq_info(c16 >> 2, layer);
    const int sb = q.s0 + 16 * (c16 & 3);
    const bf16* proj = (const bf16*)(a.ws + WS_BIG) + ch0;
    bf16* ymix = (bf16*)(a.ws + WS_A);
    const f32x4 w0 = *(const f32x4*)(a.in[I_CONVA] + (size_t)(layer * 3 + 0) * DCONV + ch0);
    const f32x4 w1 = *(const f32x4*)(a.in[I_CONVA] + (size_t)(layer * 3 + 1) * DCONV + ch0);
    const f32x4 w2 = *(const f32x4*)(a.in[I_CONVA] + (size_t)(layer * 3 + 2) * DCONV + ch0);
    v2u cgr[18], xar[18], bgr[16];
#pragma unroll
    for (int i = 0; i < 18; ++i) { const int s = sb - 1 + i, sc = s < 0 ? 0 : (s >= q.L ? q.L - 1 : s); const bf16* row = proj + (size_t)tok_of(q, sc) * DIN;
        cgr[i] = *(const v2u*)(row + DCONV); xar[i] = *(const v2u*)(row + 2 * DCONV); if (i >= 1 && i <= 16) bgr[i - 1] = *(const v2u*)row; }
    f32x4 cx[18];
#pragma unroll
    for (int i = 0; i < 18; ++i) { const int s = sb - 1 + i; const float ok = (s >= 0 && s < q.L) ? 1.f : 0.f;
        cx[i] = (f32x4){bflo(cgr[i].x) * bflo(xar[i].x), bfhi(cgr[i].x) * bfhi(xar[i].x), bflo(cgr[i].y) * bflo(xar[i].y), bfhi(cgr[i].y) * bfhi(xar[i].y)} * ok; }
#pragma unroll
    for (int e = 0; e < 16; ++e) {
        const f32x4 hv = w0 * cx[e] + w1 * cx[e + 1] + w2 * cx[e + 2];
        const f32x4 bv = (f32x4){bflo(bgr[e].x), bfhi(bgr[e].x), bflo(bgr[e].y), bfhi(bgr[e].y)};
        const f32x4 o = bv * hv;
        v2u ov; ov.x = pk2(o.x, o.y); ov.y = pk2(o.z, o.w);
        *(v2u*)(ymix + blk_off(tok_of(q, sb + e), ch0, D)) = ov;
    }
}

__device__ __forceinline__ void convgate_item(const Args& a, int layer, int chunk, int item, int lane) {
    const int cgp = item % 12, rb = item / 12, r0 = rb * 8, ch0 = cgp * 512 + lane * 8;
    const int seqlen = (chunk == 0) ? L_CTX : L_LAT;
    const bf16* hp = (const bf16*)(a.ws + WS_HPRE) + (size_t)((ch0 >> 7) * 256 + (ch0 & 127));
    bf16* act = (bf16*)(a.ws + WS_BIG) + (size_t)(chunk * 4096) * DFF + ch0;
    const float* cw = a.in[I_FCW] + (size_t)layer * 3 * NUP;
    float wg[3][8], wv[3][8];
#pragma unroll
    for (int t = 0; t < 3; ++t)
#pragma unroll
        for (int e = 0; e < 8; ++e) { wg[t][e] = cw[t * NUP + ch0 + e]; wv[t][e] = cw[t * NUP + DFF + ch0 + e]; }
    v4u rg[10], rv[10];
#pragma unroll
    for (int i = 0; i < 10; ++i) {
        const int r = r0 - 1 + i;
        const bool ok = (i == 0) ? ((r0 % seqlen) != 0) : (i == 9) ? (((r0 + 8) % seqlen) != 0) : true;
        if (ok) { rg[i] = *(const v4u*)(hp + (size_t)r * NUP); rv[i] = *(const v4u*)(hp + (size_t)r * NUP + 128); }
        else { rg[i] = (v4u){0u, 0u, 0u, 0u}; rv[i] = (v4u){0u, 0u, 0u, 0u}; }
    }
#pragma unroll
    for (int i = 1; i <= 8; ++i) {
        float o[8];
#pragma unroll
        for (int e2 = 0; e2 < 4; ++e2) {
            const unsigned gm = rg[i - 1][e2], gc = rg[i][e2], gn = rg[i + 1][e2], vm = rv[i - 1][e2], vc = rv[i][e2], vn = rv[i + 1][e2];
            const float hg0 = wg[0][2 * e2] * bflo(gm) + wg[1][2 * e2] * bflo(gc) + wg[2][2 * e2] * bflo(gn);
            const float hg1 = wg[0][2 * e2 + 1] * bfhi(gm) + wg[1][2 * e2 + 1] * bfhi(gc) + wg[2][2 * e2 + 1] * bfhi(gn);
            const float hv0 = wv[0][2 * e2] * bflo(vm) + wv[1][2 * e2] * bflo(vc) + wv[2][2 * e2] * bflo(vn);
            const float hv1 = wv[0][2 * e2 + 1] * bfhi(vm) + wv[1][2 * e2 + 1] * bfhi(vc) + wv[2][2 * e2 + 1] * bfhi(vn);
            o[2 * e2] = gelu_tanh(hg0) * hv0; o[2 * e2 + 1] = gelu_tanh(hg1) * hv1;
        }
        v4u ov; ov.x = pk2(o[0], o[1]); ov.y = pk2(o[2], o[3]); ov.z = pk2(o[4], o[5]); ov.w = pk2(o[6], o[7]);
        *(v4u*)(act + (size_t)(r0 + i - 1) * DFF) = ov;
    }
}

__device__ __forceinline__ void ffn_fixup(const Args& a, int layer, int gtid, int nthreads) {
    const float* edge = (const float*)(a.ws + WS_EDGE);
    const float* cw = a.in[I_FCW] + (size_t)layer * 3 * NUP;
    bf16* act = (bf16*)(a.ws + WS_BIG);
    for (int it = gtid; it < NB_LAT * 15 * (DFF / 4) * 2; it += nthreads) {
        const int which = it & 1, cq = (it >> 1) % (DFF / 4), bi = (it >> 1) / (DFF / 4);
        const int pm = 16 + (bi / 15) * 16 + (bi % 15), chn = 4 * cq, ug = (chn >> 7) * 256 + (chn & 127);
        const float* e0 = edge + (size_t)pm * 4 * NUP, * e1 = edge + (size_t)(pm + 1) * 4 * NUP;
        const float* pp = which ? e0 + 3 * (size_t)NUP : e0 + 2 * (size_t)NUP;
        const float* pc = which ? e1 : e0 + 3 * (size_t)NUP;
        const float* pn = which ? e1 + NUP : e1;
        f32x4 hg = *(const f32x4*)(cw + chn) * *(const f32x4*)(pp + ug) + *(const f32x4*)(cw + NUP + chn) * *(const f32x4*)(pc + ug) + *(const f32x4*)(cw + 2 * (size_t)NUP + chn) * *(const f32x4*)(pn + ug);
        f32x4 hv = *(const f32x4*)(cw + DFF + chn) * *(const f32x4*)(pp + ug + 128) + *(const f32x4*)(cw + NUP + DFF + chn) * *(const f32x4*)(pc + ug + 128) + *(const f32x4*)(cw + 2 * (size_t)NUP + DFF + chn) * *(const f32x4*)(pn + ug + 128);
        const size_t R = (size_t)pm * 256 + 255 + which;
        v2u o; o.x = pk2(gelu_tanh(hg.x) * hv.x, gelu_tanh(hg.y) * hv.y); o.y = pk2(gelu_tanh(hg.z) * hv.z, gelu_tanh(hg.w) * hv.w);
        *(v2u*)(act + blk_off((int)R, chn, DFF)) = o;
    }
}

constexpr int PH_PRE = 0, PH_NORM0 = 1, PH_LAYER0 = 2, NPL = 10, N_PHASES = PH_LAYER0 + DEPTH * NPL;

typedef __attribute__((address_space(4))) const Args* KArgsPtr;
__device__ __forceinline__ KArgsPtr phase_args() { KArgsPtr p = (KArgsPtr)__builtin_amdgcn_kernarg_segment_ptr(); asm volatile("" : "+s"(p)); return p; }
__global__ void __launch_bounds__(NWAVES * 64, 2) fwd_kernel(Args args) {
    extern __shared__ __attribute__((aligned(16))) unsigned char lds_raw[];
    LAS unsigned char* lds = (LAS unsigned char*)lds_raw;
    volatile LAS unsigned* MISC = (volatile LAS unsigned*)(lds + MISC_OFF);
    const int G = gridDim.x, NGW = G * NWAVES;
    const int lo = args.ph_lo, hi = args.ph_hi;
#if PROBE_DUP
#define REPS(i) args.rep[i]
#else
#define REPS(i) 1
#endif
#define PHASE_ARGS const KArgsPtr kap_ = phase_args(); const Args& A_ = *(const Args*)kap_; unsigned char* const ws = kap_->ws; (void)ws;
    const int wave_s = __builtin_amdgcn_readfirstlane((int)threadIdx.x >> 6);
#define PHASE_IDS PHASE_ARGS int z_ = 0; asm volatile("" : "+s"(z_)); const int lane = (int)__builtin_amdgcn_mbcnt_hi(~0u, __builtin_amdgcn_mbcnt_lo(~0u, (unsigned)z_)); int wave = wave_s; asm volatile("" : "+s"(wave)); const int tid = wave * 64 + lane, gw = blockIdx.x * NWAVES + wave; (void)lane; (void)gw; (void)tid;
    if (threadIdx.x < 32) MISC[threadIdx.x] = 0u;
    __syncthreads();
    XcdBarrier bar; bar.bar = (unsigned*)(args.ws + WS_CTL) + CW_BAR; bar.x = 0; bar.st = nullptr; bar.wave = wave_s;
    if (MK_SINGLE || hi - lo > 1) bar = xcd_barrier_post((unsigned*)(args.ws + WS_CTL) + CW_BAR, MISC + 8, wave_s);
#if MK_SINGLE
#define IN(k) true
#else
#define IN(k) (lo <= (k) && (k) < hi)
#endif
#define SEAM(k) do { if (IN(k) && IN((k) + 1)) { for (int rb_ = 0; rb_ < REPS(7); ++rb_) xcd_barrier(bar); } } while (0)

    if (IN(PH_PRE)) { for (int rep = 0; rep < REPS(4); ++rep) { PHASE_IDS pre_transposes(A_, lds, gw, NGW, wave, lane); __syncthreads(); pre_mod(A_, lds, tid, wave, lane); __syncthreads(); } }
    SEAM(PH_PRE);
    if (IN(PH_NORM0)) { PHASE_IDS resnorm_rows<true, false, 0, true>(A_, lds, tid, wave, lane, 0, 0, 0, 0); }
    SEAM(PH_NORM0);

    for (int l = 0; l < DEPTH; ++l) {
        const int pb = PH_LAYER0 + l * NPL;
#define wl ((const bf16*)(ws + WS_W + (size_t)l * W_LAYER))
        if (IN(pb + 0)) for (int rep = 0; rep < REPS(0); ++rep) { PHASE_ARGS
            if (G == 256) {
                { int bid_ = (int)blockIdx.x; asm volatile("" : "+s"(bid_));
                  const int x = bid_ & 7, li = bid_ >> 3, ks = li & 3, j = x * 8 + (li >> 2);
                  pg8::Gemm g{(const bf16*)(ws + WS_A), (const bf16*)((const unsigned char*)wl + W_IN_OFF), M, DIN, D, D};
                  pg8::WithTail<pg8::TwoRectOrder> S; S.m.a.init(M_MAIN, DIN, G, bid_); S.m.b.init(M - M_MAIN, P2_NMAIN, G, bid_); S.m.r1 = (M_MAIN / 256) * (DIN / 256) / 256; S.m.pm2 = M_MAIN / 256;
                  S.r_main = S.m.r1 + 1; S.tail = pg8::Unit{M_MAIN / 256 + (j >> 2), P2_NMAIN / 256 + (j & 3), ks * (D / 4 / 64), D / 4 / 64, ks};
                  pg8::EpiBf16Store E{(bf16*)(ws + WS_BIG), DIN, (bf16*)(ws + WS_Y2) - (size_t)M_MAIN * (DIN - P2_NMAIN) - P2_NMAIN, DIN - P2_NMAIN, (size_t)(M - M_MAIN) * (DIN - P2_NMAIN)};
                  pg8::gemm_phase<pg8::EpiBf16Store, pg8::WithTail<pg8::TwoRectOrder>, false, true>(lds, lds + RING_BYTES, g, S, E, wave_s); }
            } else {
            pg8::Gemm g{(const bf16*)(ws + WS_A), (const bf16*)((const unsigned char*)wl + W_IN_OFF), M, DIN, D, D}; pg8::StaticOrder S; S.init(M, DIN, G, (int)blockIdx.x);
            pg8::EpiBf16Store E{(bf16*)(ws + WS_BIG), DIN};
            pg8::gemm_phase<pg8::EpiBf16Store, pg8::StaticOrder, true, true>(lds, lds + RING_BYTES, g, S, E, wave_s);
            }
        }
        SEAM(pb + 0);
        if (IN(pb + 1)) for (int rep = 0; rep < REPS(1); ++rep) { PHASE_IDS LAS unsigned char* xt = lds + wave * WAVE_LDS; if (G == 256) p2_reduce(ws, (int)blockIdx.x * (NWAVES * 64) + tid, G * NWAVES * 64); for (int it = gw; it < NCHUNK * NH * 2; it += NGW) scan_summary_item(A_, l, it, lane, xt); }
        SEAM(pb + 1);
        if (IN(pb + 2)) { PHASE_IDS carry_phase(A_, l, blockIdx.x * (NWAVES * 64) + tid, G * NWAVES * 64); }
        SEAM(pb + 2);
        if (IN(pb + 3)) for (int rep = 0; rep < REPS(2); ++rep) {
            PHASE_IDS
            LAS unsigned char* xt = lds + wave * WAVE_LDS;
            constexpr int NB = NCHUNK * NH, NA = NCHUNK * 4 * 4;
            for (int k = 0; ; ++k) {
                const int idx = (k >> 1) * NGW + gw;
                if (!(k & 1)) { if (idx < NB) mixb_item(A_, l, idx, lane, xt); }
                else { if (idx < NA) mixa_item(A_, l, idx, lane); }
                if ((k >> 1) * NGW >= NB && (k >> 1) * NGW >= NA) break;
            }
        }
        SEAM(pb + 3);
        if (IN(pb + 4)) for (int rep = 0; rep < REPS(3); ++rep) { PHASE_ARGS
            if (G == 256) {
                { int bid_ = (int)blockIdx.x; asm volatile("" : "+s"(bid_));
                  const int xi = bid_ >> 3, kh = xi & 1, j = ((2 * (bid_ & 7) + (xi >> 4)) << 3) | ((xi >> 1) & 7);
                  pg8::Gemm g{(const bf16*)(ws + WS_A), (const bf16*)((const unsigned char*)wl + W_OUT_OFF), M, D, D, D};
                  pg8::WithTail<pg8::StaticOrder> S; S.m.init(M_MAIN, D, G, bid_); S.r_main = (M_MAIN / 256) * (D / 256) / 256; S.tail = pg8::Unit{M_MAIN / 256 + (j >> 3), j & 7, kh * (D / 2 / 64), D / 2 / 64, kh};
                  pg8::EpiBf16Store E{(bf16*)(ws + WS_Y), D, (bf16*)(ws + WS_Y2) - (size_t)M_MAIN * D, D, 0};
                  pg8::gemm_phase<pg8::EpiBf16Store, pg8::WithTail<pg8::StaticOrder>, false, true>(lds, lds + RING_BYTES, g, S, E, wave_s); }
            } else {
            pg8::Gemm g{(const bf16*)(ws + WS_A), (const bf16*)((const unsigned char*)wl + W_OUT_OFF), M, D, D, D}; pg8::StaticOrder S; S.init(M, D, G, (int)blockIdx.x);
            pg8::EpiBf16Store E{(bf16*)(ws + WS_Y), D};
            pg8::gemm_phase<pg8::EpiBf16Store, pg8::StaticOrder, true, true>(lds, lds + RING_BYTES, g, S, E, wave_s);
            }
        }
        SEAM(pb + 4);
        if (IN(pb + 5)) { PHASE_IDS if (l == 0) resnorm_rows<true, true, 1, true>(A_, lds, tid, wave, lane, l, 2, l, 3); else resnorm_rows<false, true, 1, true>(A_, lds, tid, wave, lane, l, 2, l, 3); }
#if PROBE_NORM
        if (IN(pb + 5)) { __syncthreads(); asm volatile("s_waitcnt vmcnt(0)" ::: "memory"); PHASE_IDS resnorm_rows<false, false, 1, true>(A_, lds, tid, wave, lane, l, 2, l, 3); }
#endif
        SEAM(pb + 5);
        if (IN(pb + 6)) for (int rep = 0; rep < REPS(5); ++rep) { PHASE_ARGS
            pg8::Gemm g{(const bf16*)(ws + WS_A), (const bf16*)((const unsigned char*)wl + W_UP_OFF), M, NUP, D, D}; pg8::StaticOrder S; S.init(M, NUP, G, (int)blockIdx.x);
            pg8::EpiConvGate E{(bf16*)(ws + WS_BIG), DFF, A_.in[I_FCW] + (size_t)l * 3 * NUP, (float*)(ws + WS_EDGE), NUP, DFF};
            pg8::gemm_phase<pg8::EpiConvGate, pg8::StaticOrder, true, true>(lds, lds + RING_BYTES, g, S, E, wave_s);
        }
        SEAM(pb + 6);
        if (IN(pb + 7)) { PHASE_IDS ffn_fixup(A_, l, blockIdx.x * (NWAVES * 64) + tid, G * NWAVES * 64); }
        SEAM(pb + 7);
        if (IN(pb + 8)) for (int rep = 0; rep < REPS(6); ++rep) { PHASE_ARGS
            if (G == 256) {
                { int bid_ = (int)blockIdx.x; asm volatile("" : "+s"(bid_));
                  const int xi = bid_ >> 3, kh = xi & 1, j = ((2 * (bid_ & 7) + (xi >> 4)) << 3) | ((xi >> 1) & 7);
                  pg8::Gemm g{(const bf16*)(ws + WS_BIG), (const bf16*)((const unsigned char*)wl + W_DOWN_OFF), M, D, DFF, DFF};
                  pg8::WithTail<pg8::StaticOrder> S; S.m.init(M_MAIN, D, G, bid_); S.r_main = (M_MAIN / 256) * (D / 256) / 256; S.tail = pg8::Unit{M_MAIN / 256 + (j >> 3), j & 7, kh * (DFF / 2 / 64), DFF / 2 / 64, kh};
                  pg8::EpiBf16Store E{(bf16*)(ws + WS_Y), D, (bf16*)(ws + WS_Y2) - (size_t)M_MAIN * D, D, 0};
                  pg8::gemm_phase<pg8::EpiBf16Store, pg8::WithTail<pg8::StaticOrder>, false, true>(lds, lds + RING_BYTES, g, S, E, wave_s); }
            } else {
            pg8::Gemm g{(const bf16*)(ws + WS_BIG), (const bf16*)((const unsigned char*)wl + W_DOWN_OFF), M, D, DFF, DFF}; pg8::StaticOrder S; S.init(M, D, G, (int)blockIdx.x);
            pg8::EpiBf16Store E{(bf16*)(ws + WS_Y), D};
            pg8::gemm_phase<pg8::EpiBf16Store, pg8::StaticOrder, true, true>(lds, lds + RING_BYTES, g, S, E, wave_s);
            }
        }
        SEAM(pb + 8);
#if PROBE_GEMM
        if (IN(pb + 8)) { PHASE_ARGS
            pg8::Gemm g{(const bf16*)(ws + WS_BIG), (const bf16*)((const unsigned char*)wl + W_DOWN_OFF), M_MAIN, D, DFF, DFF}; pg8::StaticOrder S; S.init(M_MAIN, D, G, (int)blockIdx.x);
            pg8::EpiBf16Store E{(bf16*)(ws + 1328 * MiB), D};
#if PROBE_GEMM == 6
            pg8::Gemm g6{(const bf16*)(ws + WS_A), (const bf16*)((const unsigned char*)wl + W_UP_OFF), M, NUP, D, D}; pg8::StaticOrder S6; S6.init(M, NUP, G, (int)blockIdx.x);
            pg8::EpiBf16Scratch E6{{(bf16*)(ws + 1328 * MiB), 256}};
            pg8::gemm_phase<pg8::EpiBf16Scratch, pg8::StaticOrder, true, true, 0>(lds, lds + RING_BYTES, g6, S6, E6, wave_s);
#elif PROBE_GEMM == 5
            pg8::ConstOrder S5{4};
            pg8::gemm_phase<pg8::EpiBf16Store, pg8::ConstOrder, true, true, 0>(lds, lds + RING_BYTES, g, S5, E, wave_s);
#else
            pg8::gemm_phase<pg8::EpiBf16Store, pg8::StaticOrder, true, true, PROBE_GEMM - 1>(lds, lds + RING_BYTES, g, S, E, wave_s);
#endif
        }
#endif
        if (IN(pb + 9)) {
            PHASE_IDS
            if (l + 1 < DEPTH) resnorm_rows<false, true, 1, true>(A_, lds, tid, wave, lane, l, 5, l + 1, 0);
            else resnorm_rows<false, true, 2, false>(A_, lds, tid, wave, lane, l, 5, l, 0);
        }
        if (l + 1 < DEPTH) SEAM(pb + 9);
    }
#undef IN
#undef SEAM
}

extern "C" void kernel_launch(void* const* d_in, const int* in_sizes, int n_in, void* d_out, int out_size, void* d_ws, size_t ws_size, hipStream_t stream) {
    static int grid = 0;
    if (grid == 0) {
        if (n_in != 21 || ws_size < WS_END) { fprintf(stderr, "kernel_launch: expected 21 inputs and >= %zu bytes of workspace; got n_in %d, ws %zu\n", (size_t)WS_END, n_in, ws_size); grid = -1; return; }
        int dev = 0, cus = 0, per_cu = 0;
        if (hipGetDevice(&dev) != hipSuccess || hipDeviceGetAttribute(&cus, hipDeviceAttributeMultiprocessorCount, dev) != hipSuccess) { grid = -1; return; }
        if (hipFuncSetAttribute((const void*)fwd_kernel, hipFuncAttributeMaxDynamicSharedMemorySize, LDS_BYTES) != hipSuccess) { fprintf(stderr, "kernel_launch: hipFuncSetAttribute failed\n"); grid = -1; return; }
        if (hipOccupancyMaxActiveBlocksPerMultiprocessor(&per_cu, (const void*)fwd_kernel, NWAVES * 64, LDS_BYTES) != hipSuccess || per_cu < 1) { fprintf(stderr, "kernel_launch: occupancy query reports %d blocks per CU\n", per_cu); }
        (void)hipGetLastError();
        grid = cus;
    }
    if (grid < 0) return;
    (void)hipMemsetAsync((char*)d_ws + WS_CTL, 0, CTL_ZERO_BYTES, stream);
    Args a{};
    for (int i = 0; i < 21; ++i) a.in[i] = (const float*)d_in[i];
    a.out = (float*)d_out; a.ws = (unsigned char*)d_ws;
    for (int i = 0; i < 8; ++i) a.rep[i] = ((PROBE_DUP >> i) & 1) ? 2 : 1;
#if MK_SINGLE
    a.ph_lo = 0; a.ph_hi = N_PHASES;
    hipLaunchKernelGGL(fwd_kernel, dim3(grid), dim3(NWAVES * 64), LDS_BYTES, stream, a);
#else
    for (int p = 0; p < N_PHASES; ++p) { a.ph_lo = p; a.ph_hi = p + 1; hipLaunchKernelGGL(fwd_kernel, dim3(grid), dim3(NWAVES * 64), LDS_BYTES, stream, a); }
#endif
}
```

```cpp
#include <hip/hip_runtime.h>
#include <cstdio>
#include <cstdint>

#ifndef PROBE_DUP
#define PROBE_DUP 0
#endif
#ifndef STAGE_ASM
#define STAGE_ASM 1
#endif
#ifndef GEMM_STAGGER
#define GEMM_STAGGER 0
#endif
#ifndef PROBE_NORM
#define PROBE_NORM 0
#endif
#ifndef PROBE_GEMM
#define PROBE_GEMM 0
#endif
#ifndef MK_SINGLE
#define MK_SINGLE 1
#endif

__host__ __device__ __forceinline__ size_t blk_off(int m, int k, int K) { return ((size_t)((m >> 8) * (K >> 6) + (k >> 6)) * 256 + (m & 255)) * 64 + (k & 63); }
namespace pg8 {
#define PG8_LAS __attribute__((address_space(3)))
typedef unsigned short bf16_t;
typedef short bf16x8 __attribute__((ext_vector_type(8)));
typedef float f32x4 __attribute__((ext_vector_type(4)));
typedef unsigned u32x4 __attribute__((ext_vector_type(4)));
typedef float f32x2 __attribute__((ext_vector_type(2)));
constexpr int BM = 256, BK = 64, HALF = 128, HTB = HALF * BK * 2, STAGE_BYTES = 8 * HTB, NXCD = 8, WGM = 4;

__host__ __device__ __forceinline__ int lds_byte(int r, int c) { const int st = (r >> 4) * 2 + (c >> 5), rr = r & 15, cc = c & 31, ob = rr * 64 + cc * 2; return st * 1024 + (ob ^ (((ob >> 9) & 1) << 5)); }
__host__ __device__ __forceinline__ void stage_rc(int b, int& R, int& C) { const int st = b / 1024, sb = b % 1024, swz = sb ^ (((sb >> 9) & 1) << 5); R = (st >> 1) * 16 + swz / 64; C = (st & 1) * 32 + (swz % 64) / 2; }
__host__ __device__ __forceinline__ int perm32(int rho) { const int n = rho >> 4, i = rho & 15; return 8 * (i >> 2) + 4 * n + (i & 3); }

struct Unit { int pm, pn, kt0, nt, slice; };
struct Gemm { const bf16_t* A; const bf16_t* Bt; int M, N, K, KL; };

struct StaticOrder {
    int nM, nN, nwg, G, c;
    __host__ __device__ void init(int M, int N, int G_, int c_) { nM = M / BM; nN = N / BM; nwg = nM * nN; G = G_; c = c_; }
    __host__ __device__ bool next(int i, Unit& u) const {
        const long L = (long)i * G + c; if (L >= nwg) return false;
        int wgid = (int)L; { const int q = nwg / NXCD, r = nwg % NXCD, xcd = wgid % NXCD, off = wgid / NXCD; wgid = (xcd < r ? xcd * (q + 1) : r * (q + 1) + (xcd - r) * q) + off; }
        const int nig = WGM * nN, gid = wgid / nig, fm = gid * WGM, gsz = (nM - fm) < WGM ? (nM - fm) : WGM;
        u.pm = fm + ((wgid % nig) % gsz); u.pn = (wgid % nig) / gsz; return true;
    }
    __device__ __forceinline__ void a_ready(const Unit&) const {}
    __device__ __forceinline__ void done(const Unit&) const {}
};

struct TwoRectOrder {
    StaticOrder a, b; int r1, pm2;
    __host__ __device__ bool next(int i, Unit& u) const { if (i < r1) return a.next(i, u); if (!b.next(i - r1, u)) return false; u.pm += pm2; return true; }
    __device__ __forceinline__ void a_ready(const Unit&) const {}
    __device__ __forceinline__ void done(const Unit&) const {}
};
template <class Main> struct WithTail {
    Main m; int r_main; Unit tail;
    __host__ __device__ bool next(int i, Unit& u) const { if (i < r_main) { if (!m.next(i, u)) return false; u.kt0 = 0; u.nt = 0; u.slice = 0; return true; } if (i > r_main) return false; u = tail; return true; }
    __device__ __forceinline__ void a_ready(const Unit&) const {}
    __device__ __forceinline__ void done(const Unit&) const {}
};
struct ConstOrder {
    int n;
    __host__ __device__ bool next(int i, Unit& u) const { if (i >= n) return false; u.pm = 0; u.pn = 0; return true; }
    __device__ __forceinline__ void a_ready(const Unit&) const {}
    __device__ __forceinline__ void done(const Unit&) const {}
};
struct OneUnit {
    int pm, pn;
    __host__ __device__ bool next(int i, Unit& u) const { if (i != 0) return false; u.pm = pm; u.pn = pn; return true; }
    __device__ __forceinline__ void a_ready(const Unit&) const {}
    __device__ __forceinline__ void done(const Unit&) const {}
};
__device__ __forceinline__ unsigned cvt_pk_bf16(float lo, float hi) { unsigned r; asm volatile("v_cvt_pk_bf16_f32 %0, %1, %2" : "=v"(r) : "v"(lo), "v"(hi)); return r; }

struct EpiBf16Store {
    static constexpr bool PERM = true, AFTER_DRAIN = false, PREFETCH = false, ROWPERM = false;
    bf16_t* O; int ldc; bf16_t* O2; int ldc2; size_t sstride;
    __device__ __forceinline__ void operator()(const f32x4 (&acc)[2][2][4][2], const Unit& u, int wr, int wc, int fr, int fq, PG8_LAS unsigned char*) const {
        const int row0 = u.pm * BM + wr * 64 + fr, col0 = u.pn * BM + wc * 32 + 8 * fq;
        bf16_t* const Ob = u.slice ? O2 + (size_t)(u.slice - 1) * sstride : O; const int ld = u.slice ? ldc2 : ldc;
#pragma unroll
        for (int ai = 0; ai < 2; ++ai)
#pragma unroll
            for (int m = 0; m < 4; ++m) { bf16_t* rowp = Ob + (size_t)(row0 + ai * HALF + m * 16) * ld + col0;
#pragma unroll
                for (int bj = 0; bj < 2; ++bj) { const f32x4 v0 = acc[ai][bj][m][0], v1 = acc[ai][bj][m][1];
                    u32x4 w; w.x = cvt_pk_bf16(v0[0], v0[1]); w.y = cvt_pk_bf16(v0[2], v0[3]); w.z = cvt_pk_bf16(v1[0], v1[1]); w.w = cvt_pk_bf16(v1[2], v1[3]);
                    *(u32x4*)(rowp + bj * HALF) = w; } }
    }
};
struct EpiBf16Scratch {
    static constexpr bool PERM = true, AFTER_DRAIN = false, PREFETCH = false, ROWPERM = false;
    EpiBf16Store e;
    __device__ __forceinline__ void operator()(const f32x4 (&acc)[2][2][4][2], const Unit&, int wr, int wc, int fr, int fq, PG8_LAS unsigned char* x) const { const Unit z{0, 0, 0, 0, 0}; e(acc, z, wr, wc, fr, fq, x); }
};
struct EpiF32Store {
    static constexpr bool PERM = false, AFTER_DRAIN = false, PREFETCH = false, ROWPERM = false;
    float* C; int ldc;
    __device__ __forceinline__ void operator()(const f32x4 (&acc)[2][2][4][2], const Unit& u, int wr, int wc, int fr, int fq, PG8_LAS unsigned char*) const {
        const int row0 = u.pm * BM + wr * 64 + fr, col0 = u.pn * BM + wc * 32 + 4 * fq;
#pragma unroll
        for (int ai = 0; ai < 2; ++ai)
#pragma unroll
            for (int m = 0; m < 4; ++m) { float* rowp = C + (size_t)(row0 + ai * HALF + m * 16) * ldc + col0;
#pragma unroll
                for (int bj = 0; bj < 2; ++bj)
#pragma unroll
                    for (int n = 0; n < 2; ++n) *(f32x4*)(rowp + bj * HALF + n * 16) = acc[ai][bj][m][n]; }
    }
};


#ifndef EPI_DPP
#define EPI_DPP 1
#endif
__device__ __forceinline__ float rotr1_16(float x, int lane) {
#if EPI_DPP
    return __builtin_bit_cast(float, __builtin_amdgcn_update_dpp(0, __builtin_bit_cast(int, x), 0x121, 0xF, 0xF, false));
#else
    return __shfl(x, (lane & 48) | ((lane + 15) & 15));
#endif
}
__device__ __forceinline__ float rotl1_16(float x, int lane) {
#if EPI_DPP
    return __builtin_bit_cast(float, __builtin_amdgcn_update_dpp(0, __builtin_bit_cast(int, x), 0x12F, 0xF, 0xF, false));
#else
    return __shfl(x, (lane & 48) | ((lane + 1) & 15));
#endif
}
__device__ __forceinline__ float gelu_tanh_f(float x) { const float u = 1.5957691216057308f * (x + 0.044715f * x * x * x); return x * __builtin_amdgcn_rcpf(1.f + __builtin_amdgcn_exp2f(-1.4426950408889634f * u)); }
struct EpiConvGate {
    static constexpr bool PERM = true, AFTER_DRAIN = false, PREFETCH = true, ROWPERM = true;
    static constexpr int XBLK = 3072 + 8192;
    bf16_t* act; int ldc; const float* cw; float* edge; int nup, dff;
    static constexpr int ZOFF = 2 * XBLK;
    __device__ __forceinline__ void prefetch(const Unit& u, PG8_LAS unsigned char* xb, int wid, int lane, bool first) const {
        if (wid < 3) { const int gv = lane >> 5, c4 = lane & 31;
            __builtin_amdgcn_global_load_lds((const unsigned*)(cw + (size_t)wid * nup + gv * dff + u.pn * 128 + 4 * c4), (PG8_LAS unsigned*)(xb + wid * 1024), 16, 0, 0); }
        if (first && wid == 3) { float z = 0.f; asm volatile("" : "+v"(z)); *(PG8_LAS f32x4*)(xb + ZOFF + lane * 16) = (f32x4){z, z, z, z}; }
    }
    __device__ __forceinline__ void operator()(const f32x4 (&acc)[2][2][4][2], const Unit& u, int wr, int wc, int fr, int fq, PG8_LAS unsigned char* xlds, PG8_LAS unsigned char* zlds) const {
        PG8_LAS float* ex = (PG8_LAS float*)(xlds + 3072);
        const int ucol = wc * 32 + 8 * fq;
#pragma unroll
        for (int ai = 0; ai < 2; ++ai)
#pragma unroll
            for (int bj = 0; bj < 2; ++bj)
#pragma unroll
                for (int n = 0; n < 2; ++n) {
                    if (fr == 0)  *(PG8_LAS f32x4*)(ex + (2 * (2 * ai + wr) + 0) * 256 + 128 * bj + ucol + 4 * n) = acc[ai][bj][0][n];
                    if (fr == 15) *(PG8_LAS f32x4*)(ex + (2 * (2 * ai + wr) + 1) * 256 + 128 * bj + ucol + 4 * n) = acc[ai][bj][3][n];
                }
        float* eb = edge + (size_t)u.pm * 4 * nup + u.pn * 256 + ucol;
        if (wr == 0 && fr == 0) {
#pragma unroll
            for (int bj = 0; bj < 2; ++bj)
#pragma unroll
                for (int n = 0; n < 2; ++n) { *(f32x4*)(eb + 128 * bj + 4 * n) = acc[0][bj][0][n]; *(f32x4*)(eb + (size_t)nup + 128 * bj + 4 * n) = acc[0][bj][1][n]; }
        }
        if (wr == 1 && fr == 15) {
#pragma unroll
            for (int bj = 0; bj < 2; ++bj)
#pragma unroll
                for (int n = 0; n < 2; ++n) { *(f32x4*)(eb + (size_t)2 * nup + 128 * bj + 4 * n) = acc[1][bj][2][n]; *(f32x4*)(eb + (size_t)3 * nup + 128 * bj + 4 * n) = acc[1][bj][3][n]; }
        }
        const PG8_LAS float* wb = (const PG8_LAS float*)xlds;
        asm volatile("s_waitcnt lgkmcnt(0)" ::: "memory"); __builtin_amdgcn_s_barrier(); asm volatile("" ::: "memory");
        const int chn0 = u.pn * 128 + ucol;
        const int row0 = u.pm * BM + wr * 64 + 4 * fr;
#define EPI_FMAC(te, x, w, CTRL) asm("v_fmac_f32_dpp %0, %1, %2 " CTRL " row_mask:0xf bank_mask:0xf" : "+v"(te) : "v"(x), "v"(w))
        const PG8_LAS float* pprev[2]; const PG8_LAS float* pnext[2];
#pragma unroll
        for (int ai = 0; ai < 2; ++ai) {
            const int sp = 2 * (2 * ai + wr) - 1, sn = 2 * (2 * ai + wr) + 2;
            pprev[ai] = (fr == 0 && sp >= 0) ? ex + sp * 256 + ucol : (const PG8_LAS float*)zlds;
            pnext[ai] = (fr == 15 && sn <= 7) ? ex + sn * 256 + ucol : (const PG8_LAS float*)zlds;
        }
        f32x4 nw0, nw1, nw2, nbp, nbn;
#define EPI_LOADOPS(g_) do { const int ai_ = (g_) >> 2, n_ = ((g_) >> 1) & 1, bj_ = (g_) & 1; \
            nw0 = *(const PG8_LAS f32x4*)(wb + (0 * 2 + bj_) * 128 + ucol + 4 * n_); nw1 = *(const PG8_LAS f32x4*)(wb + (1 * 2 + bj_) * 128 + ucol + 4 * n_); nw2 = *(const PG8_LAS f32x4*)(wb + (2 * 2 + bj_) * 128 + ucol + 4 * n_); \
            nbp = *(const PG8_LAS f32x4*)(pprev[ai_] + 128 * bj_ + 4 * n_); nbn = *(const PG8_LAS f32x4*)(pnext[ai_] + 128 * bj_ + 4 * n_); } while (0)
        EPI_LOADOPS(0);
        unsigned o0[4][2];
        f32x4 hg[4];
#pragma unroll
        for (int g = 0; g < 8; ++g) {
            const int ai = g >> 2, n = (g >> 1) & 1, bj = g & 1;
            const f32x4 w0 = nw0, w1 = nw1, w2 = nw2, bprev = nbp, bnext = nbn;
            const f32x4 X0 = acc[ai][bj][0][n], X1 = acc[ai][bj][1][n], X2 = acc[ai][bj][2][n], X3 = acc[ai][bj][3][n];
            f32x4 t[4];
            t[0] = w1 * X0 + w2 * X1 + w0 * bprev;
            t[1] = w1 * X1 + w0 * X0 + w2 * X2;
            t[2] = w1 * X2 + w0 * X1 + w2 * X3;
            t[3] = w1 * X3 + w0 * X2 + w2 * bnext;
#pragma unroll
            for (int e = 0; e < 4; ++e) {
                float ta = t[0][e], tb = t[3][e]; const float x3 = X3[e], x0 = X0[e], w0e = w0[e], w2e = w2[e];
                EPI_FMAC(ta, x3, w0e, "row_shr:1");
                EPI_FMAC(tb, x0, w2e, "row_shl:1");
                t[0][e] = ta; t[3][e] = tb;
            }
            __builtin_amdgcn_sched_barrier(0);
            if (g < 7) EPI_LOADOPS(g + 1);
            __builtin_amdgcn_sched_barrier(0);
#pragma unroll
            for (int m = 0; m < 4; ++m) {
                const f32x4 tm = t[m];
                if (bj == 0) {
                    const f32x4 z = tm * ((tm * tm) * (-0.10294324f) + (-2.30220820f));
                    f32x4 d; d.x = __builtin_amdgcn_exp2f(z.x); d.y = __builtin_amdgcn_exp2f(z.y); d.z = __builtin_amdgcn_exp2f(z.z); d.w = __builtin_amdgcn_exp2f(z.w);
                    d = d + 1.f;
                    f32x4 r; r.x = __builtin_amdgcn_rcpf(d.x); r.y = __builtin_amdgcn_rcpf(d.y); r.z = __builtin_amdgcn_rcpf(d.z); r.w = __builtin_amdgcn_rcpf(d.w);
                    hg[m] = tm * r;
                } else {
                    const f32x4 pv = hg[m] * tm;
                    const unsigned p0 = cvt_pk_bf16(pv.x, pv.y), p1 = cvt_pk_bf16(pv.z, pv.w);
                    if (n == 0) { o0[m][0] = p0; o0[m][1] = p1; }
                    else { u32x4 w4; w4.x = o0[m][0]; w4.y = o0[m][1]; w4.z = p0; w4.w = p1; *(u32x4*)(act + blk_off(row0 + ai * HALF + m, chn0, ldc)) = w4; }
                }
            }
            __builtin_amdgcn_sched_barrier(0);
        }
#undef EPI_LOADOPS
#undef EPI_FMAC
    }
};

template <class Epi, class Sched, bool ALIGN_EPI = false, bool SP2 = false, int VARIANT = 0>
__device__ __forceinline__ void gemm_phase(PG8_LAS unsigned char* lds, PG8_LAS unsigned char* xlds, const Gemm g, const Sched& S, const Epi& E, const int wave_id) {
    int zz_ = 0; asm volatile("" : "+s"(zz_));
    const int lane = (int)__builtin_amdgcn_mbcnt_hi(~0u, __builtin_amdgcn_mbcnt_lo(~0u, (unsigned)zz_));
    int wid = wave_id; asm volatile("" : "+s"(wid));
    const int tid = wid * 64 + lane, wr = wid >> 2, wc = wid & 3, fr = lane & 15, fq = lane >> 4;
    const int K = g.K, nt_def = g.KL / BK;
    unsigned voffA[2], voffB[2];
#pragma unroll
    for (int i = 0; i < 2; ++i) { int R, C; stage_rc(tid * 16 + i * 8192, R, C); const int Rb = Epi::PERM ? ((R & ~31) + perm32(R & 31)) : R;
        const int Ra = Epi::ROWPERM ? ((R & ~63) + 4 * (R & 15) + ((R >> 4) & 3)) : R;
        voffA[i] = (unsigned)(Ra * BK + C) * 2u; voffB[i] = (unsigned)(Rb * BK + C) * 2u; }
    const size_t kstep = (size_t)BM * BK * 2;
    const size_t hstep = (size_t)HALF * BK * 2;
    const size_t tstep = (size_t)(K / BK) * kstep;
    const unsigned ldsw = (unsigned)wid * 1024u;
    const unsigned ldsb = (unsigned)(size_t)lds + ldsw; (void)ldsb;
    const int aoff = lds_byte(wr * 64 + fr, fq * 8), boff = lds_byte(wc * 32 + fr, fq * 8);
#define PG8_SA(b, h) (((b) * 2 + (h)) * HTB)
#define PG8_SB(b, h) ((4 + (b) * 2 + (h)) * HTB)
#if STAGE_ASM
#define PG8_STAGE(bufoff, gbase, voff) do { if (VARIANT != 2) _Pragma("unroll") for (int _i = 0; _i < 2; ++_i) \
        asm volatile("s_mov_b32 m0, %2\n\ts_nop 4\n\tglobal_load_lds_dwordx4 %0, %1" :: "v"((voff)[_i]), "s"((const char*)(gbase)), "s"(ldsb + (unsigned)((bufoff) + _i * 8192)) : "memory", "m0"); } while (0)
#else
#define PG8_STAGE(bufoff, gbase, voff) do { if (VARIANT != 2) _Pragma("unroll") for (int _i = 0; _i < 2; ++_i) \
        __builtin_amdgcn_global_load_lds((const unsigned*)((const char*)(gbase) + (voff)[_i]), (PG8_LAS unsigned*)(lds + (bufoff) + ldsw + _i * 8192), 16, 0, 0); } while (0)
#endif
#define PG8_LDA(dst, b, h) do { if (VARIANT != 3) _Pragma("unroll") for (int m = 0; m < 4; ++m) _Pragma("unroll") for (int k = 0; k < 2; ++k) dst[m][k] = *(const PG8_LAS bf16x8*)(lds + PG8_SA(b, h) + aoff + m * 2048 + k * 1024); } while (0)
#define PG8_LDB(dst, b, h) do { if (VARIANT != 3) _Pragma("unroll") for (int n = 0; n < 2; ++n) _Pragma("unroll") for (int k = 0; k < 2; ++k) dst[n][k] = *(const PG8_LAS bf16x8*)(lds + PG8_SB(b, h) + boff + n * 2048 + k * 1024); } while (0)
#define PG8_MMA(ai, bj, At, Bt) do { __builtin_amdgcn_s_setprio(1); if (VARIANT != 1) _Pragma("unroll") for (int m = 0; m < 4; ++m) _Pragma("unroll") for (int n = 0; n < 2; ++n) _Pragma("unroll") for (int k = 0; k < 2; ++k) \
        acc[ai][bj][m][n] = __builtin_amdgcn_mfma_f32_16x16x32_bf16(Bt[n][k], At[m][k], acc[ai][bj][m][n], 0, 0, 0); __builtin_amdgcn_s_setprio(0); } while (0)
#define PG8_MMA0(ai, bj, At, Bt) do { __builtin_amdgcn_s_setprio(1); if (VARIANT != 1) { _Pragma("unroll") for (int m = 0; m < 4; ++m) _Pragma("unroll") for (int n = 0; n < 2; ++n) \
        acc[ai][bj][m][n] = __builtin_amdgcn_mfma_f32_16x16x32_bf16(Bt[n][0], At[m][0], (f32x4){0.f, 0.f, 0.f, 0.f}, 0, 0, 0); \
        _Pragma("unroll") for (int m = 0; m < 4; ++m) _Pragma("unroll") for (int n = 0; n < 2; ++n) \
        acc[ai][bj][m][n] = __builtin_amdgcn_mfma_f32_16x16x32_bf16(Bt[n][1], At[m][1], acc[ai][bj][m][n], 0, 0, 0); } __builtin_amdgcn_s_setprio(0); } while (0)
#define PG8_WAIT_V(n) asm volatile("s_waitcnt vmcnt(" #n ")" ::: "memory")
#define PG8_WAIT_L(n) asm volatile("s_waitcnt lgkmcnt(" #n ")" ::: "memory")
#define PG8_WAIT_VG(gf) asm volatile("s_cmp_lg_u32 %0, 0\n\ts_cbranch_scc1 1f\n\ts_waitcnt vmcnt(8)\n1:\n\ts_waitcnt vmcnt(24)" :: "s"(gf) : "memory", "scc")
#define PG8_BAR __builtin_amdgcn_s_barrier()
#define PG8_SCHED __builtin_amdgcn_sched_barrier(0)
    Unit cur{}, nxt{}; int ui = 0;
    if (!S.next(0, cur)) return;
    int nt = cur.nt ? cur.nt : nt_def;
#if GEMM_STAGGER
    {
        const unsigned long long t0 = __builtin_amdgcn_s_memrealtime(); const unsigned long long d = (unsigned long long)(((blockIdx.x >> 6) & 3) * GEMM_STAGGER);
        while (__builtin_amdgcn_s_memrealtime() - t0 < d) __builtin_amdgcn_s_sleep(8);
    }
#endif
    f32x4 acc[2][2][4][2];
    if constexpr (!SP2) {
#pragma unroll
    for (int a = 0; a < 2; ++a)
#pragma unroll
        for (int b = 0; b < 2; ++b)
#pragma unroll
            for (int m = 0; m < 4; ++m)
#pragma unroll
                for (int n = 0; n < 2; ++n) acc[a][b][m][n] = (f32x4){0.f, 0.f, 0.f, 0.f};
    }
    bf16x8 At[4][2], B0[2][2], B1[2][2];
    if (VARIANT == 3) { _Pragma("unroll") for (int m = 0; m < 4; ++m) _Pragma("unroll") for (int k = 0; k < 2; ++k) { At[m][k] = (bf16x8){(short)0x3c00, 1, 2, 3, 4, 5, 6, (short)(tid & 255)}; } _Pragma("unroll") for (int n = 0; n < 2; ++n) _Pragma("unroll") for (int k = 0; k < 2; ++k) { B0[n][k] = At[n][k]; B1[n][k] = At[n + 2][k]; } }
    const char* cA = (const char*)g.A + (size_t)cur.pm * tstep + (size_t)cur.kt0 * kstep; const char* cB = (const char*)g.Bt + (size_t)cur.pn * tstep + (size_t)cur.kt0 * kstep;
    S.a_ready(cur);
    if constexpr (Epi::PREFETCH) E.prefetch(cur, xlds, wid, lane, true);
    if constexpr (SP2) {
        PG8_STAGE(PG8_SB(0, 0), cB, voffB); PG8_STAGE(PG8_SB(0, 1), cB + hstep, voffB); PG8_STAGE(PG8_SA(0, 0), cA, voffA); PG8_STAGE(PG8_SA(0, 1), cA + hstep, voffA);
        if (wr == 1) PG8_BAR;
        PG8_WAIT_V(2); PG8_BAR;
        PG8_STAGE(PG8_SB(1, 0), cB + kstep, voffB); PG8_STAGE(PG8_SA(1, 0), cA + kstep, voffA); PG8_STAGE(PG8_SB(1, 1), cB + hstep + kstep, voffB);
        PG8_WAIT_V(6); PG8_BAR;
    } else {
        PG8_STAGE(PG8_SB(0, 0), cB, voffB); PG8_STAGE(PG8_SA(0, 0), cA, voffA); PG8_STAGE(PG8_SB(0, 1), cB + hstep, voffB); PG8_STAGE(PG8_SA(0, 1), cA + hstep, voffA);
        if (wr == 1) PG8_BAR;
        PG8_WAIT_V(4); PG8_BAR;
        PG8_STAGE(PG8_SB(1, 0), cB + kstep, voffB); PG8_STAGE(PG8_SA(1, 0), cA + kstep, voffA); PG8_STAGE(PG8_SB(1, 1), cB + hstep + kstep, voffB);
        PG8_WAIT_V(6); PG8_BAR;
    }
    for (;;) {
        const bool has_next = S.next(ui + 1, nxt);
        const char* nA = has_next ? (const char*)g.A + (size_t)nxt.pm * tstep + (size_t)nxt.kt0 * kstep : cA; const char* nB = has_next ? (const char*)g.Bt + (size_t)nxt.pn * tstep + (size_t)nxt.kt0 * kstep : cB;
        {
            constexpr int t = 0;
            const int gf = __builtin_amdgcn_readfirstlane(ui > 0 ? 1 : 0);
            const bool last = (t == nt - 2);
            const char* a1 = cA + (size_t)(t + 1) * kstep;
            const char* a2 = last ? nA : cA + (size_t)(t + 2) * kstep; const char* b2 = last ? nB : cB + (size_t)(t + 2) * kstep;
            const char* a3 = a2 + kstep; const char* b3 = b2 + kstep;
            if (last && has_next) S.a_ready(nxt);
            if constexpr (SP2) {
            PG8_LDB(B0, 0, 0); PG8_LDB(B1, 0, 1); PG8_SCHED; PG8_LDA(At, 0, 0); PG8_STAGE(PG8_SA(1, 1), a1 + hstep, voffA);
            PG8_WAIT_VG(gf); PG8_WAIT_L(0); PG8_BAR; PG8_MMA0(0, 0, At, B0); PG8_MMA0(0, 1, At, B1); PG8_BAR; PG8_SCHED;
            PG8_LDA(At, 0, 1); PG8_STAGE(PG8_SB(0, 0), b2, voffB); PG8_STAGE(PG8_SB(0, 1), b2 + hstep, voffB); PG8_STAGE(PG8_SA(0, 0), a2, voffA);
            PG8_WAIT_VG(gf); PG8_WAIT_L(0); PG8_BAR; PG8_MMA0(1, 0, At, B0); PG8_MMA0(1, 1, At, B1); PG8_BAR; PG8_SCHED;
            PG8_LDB(B0, 1, 0); PG8_LDB(B1, 1, 1); PG8_SCHED; PG8_LDA(At, 1, 0); PG8_STAGE(PG8_SA(0, 1), a2 + hstep, voffA);
            PG8_WAIT_V(8); PG8_WAIT_L(0); PG8_BAR; PG8_MMA(0, 0, At, B0); PG8_MMA(0, 1, At, B1); PG8_BAR; PG8_SCHED;
            PG8_LDA(At, 1, 1); PG8_STAGE(PG8_SB(1, 0), b3, voffB); PG8_STAGE(PG8_SB(1, 1), b3 + hstep, voffB); PG8_STAGE(PG8_SA(1, 0), a3, voffA);
            PG8_WAIT_V(8); PG8_WAIT_L(0); PG8_BAR; PG8_MMA(1, 0, At, B0); PG8_MMA(1, 1, At, B1); PG8_BAR; PG8_SCHED;
            } else {
            PG8_LDB(B0, 0, 0); PG8_SCHED; PG8_LDA(At, 0, 0); PG8_STAGE(PG8_SA(1, 1), a1 + hstep, voffA);
            PG8_WAIT_L(8); PG8_BAR; PG8_WAIT_L(0); PG8_MMA(0, 0, At, B0); PG8_BAR; PG8_SCHED;
            PG8_LDB(B1, 0, 1); PG8_STAGE(PG8_SB(0, 0), b2, voffB);
            PG8_BAR; PG8_WAIT_L(0); PG8_MMA(0, 1, At, B1); PG8_BAR;
            PG8_LDA(At, 0, 1); PG8_STAGE(PG8_SA(0, 0), a2, voffA);
            PG8_BAR; PG8_WAIT_L(0); PG8_MMA(1, 0, At, B0); PG8_BAR; PG8_SCHED;
            PG8_STAGE(PG8_SB(0, 1), b2 + hstep, voffB);
            PG8_WAIT_V(6); PG8_BAR; PG8_MMA(1, 1, At, B1); PG8_BAR;
            PG8_LDB(B0, 1, 0); PG8_SCHED; PG8_LDA(At, 1, 0); PG8_STAGE(PG8_SA(0, 1), a2 + hstep, voffA);
            PG8_WAIT_L(8); PG8_BAR; PG8_WAIT_L(0); PG8_MMA(0, 0, At, B0); PG8_BAR; PG8_SCHED;
            PG8_LDB(B1, 1, 1); PG8_STAGE(PG8_SB(1, 0), b3, voffB);
            PG8_BAR; PG8_WAIT_L(0); PG8_MMA(0, 1, At, B1); PG8_BAR;
            PG8_LDA(At, 1, 1); PG8_STAGE(PG8_SA(1, 0), a3, voffA);
            PG8_BAR; PG8_WAIT_L(0); PG8_MMA(1, 0, At, B0); PG8_BAR; PG8_SCHED;
            PG8_STAGE(PG8_SB(1, 1), b3 + hstep, voffB);
            PG8_WAIT_V(6); PG8_BAR; PG8_MMA(1, 1, At, B1); PG8_BAR;
            }
                }
        for (int t = 2; t < nt; t += 2) {
            const bool last = (t == nt - 2);
            const char* a1 = cA + (size_t)(t + 1) * kstep;
            const char* a2 = last ? nA : cA + (size_t)(t + 2) * kstep; const char* b2 = last ? nB : cB + (size_t)(t + 2) * kstep;
            const char* a3 = a2 + kstep; const char* b3 = b2 + kstep;
            if (last && has_next) S.a_ready(nxt);
            if constexpr (SP2) {
            PG8_LDB(B0, 0, 0); PG8_LDB(B1, 0, 1); PG8_SCHED; PG8_LDA(At, 0, 0); PG8_STAGE(PG8_SA(1, 1), a1 + hstep, voffA);
            PG8_WAIT_V(8); PG8_WAIT_L(0); PG8_BAR; PG8_MMA(0, 0, At, B0); PG8_MMA(0, 1, At, B1); PG8_BAR; PG8_SCHED;
            PG8_LDA(At, 0, 1); PG8_STAGE(PG8_SB(0, 0), b2, voffB); PG8_STAGE(PG8_SB(0, 1), b2 + hstep, voffB); PG8_STAGE(PG8_SA(0, 0), a2, voffA);
            PG8_WAIT_V(8); PG8_WAIT_L(0); PG8_BAR; PG8_MMA(1, 0, At, B0); PG8_MMA(1, 1, At, B1); PG8_BAR; PG8_SCHED;
            PG8_LDB(B0, 1, 0); PG8_LDB(B1, 1, 1); PG8_SCHED; PG8_LDA(At, 1, 0); PG8_STAGE(PG8_SA(0, 1), a2 + hstep, voffA);
            PG8_WAIT_V(8); PG8_WAIT_L(0); PG8_BAR; PG8_MMA(0, 0, At, B0); PG8_MMA(0, 1, At, B1); PG8_BAR; PG8_SCHED;
            PG8_LDA(At, 1, 1); PG8_STAGE(PG8_SB(1, 0), b3, voffB); PG8_STAGE(PG8_SB(1, 1), b3 + hstep, voffB); PG8_STAGE(PG8_SA(1, 0), a3, voffA);
            PG8_WAIT_V(8); PG8_WAIT_L(0); PG8_BAR; PG8_MMA(1, 0, At, B0); PG8_MMA(1, 1, At, B1); PG8_BAR; PG8_SCHED;
            } else {
            PG8_LDB(B0, 0, 0); PG8_SCHED; PG8_LDA(At, 0, 0); PG8_STAGE(PG8_SA(1, 1), a1 + hstep, voffA);
            PG8_WAIT_L(8); PG8_BAR; PG8_WAIT_L(0); PG8_MMA(0, 0, At, B0); PG8_BAR; PG8_SCHED;
            PG8_LDB(B1, 0, 1); PG8_STAGE(PG8_SB(0, 0), b2, voffB);
            PG8_BAR; PG8_WAIT_L(0); PG8_MMA(0, 1, At, B1); PG8_BAR;
            PG8_LDA(At, 0, 1); PG8_STAGE(PG8_SA(0, 0), a2, voffA);
            PG8_BAR; PG8_WAIT_L(0); PG8_MMA(1, 0, At, B0); PG8_BAR; PG8_SCHED;
            PG8_STAGE(PG8_SB(0, 1), b2 + hstep, voffB);
            PG8_WAIT_V(6); PG8_BAR; PG8_MMA(1, 1, At, B1); PG8_BAR;
            PG8_LDB(B0, 1, 0); PG8_SCHED; PG8_LDA(At, 1, 0); PG8_STAGE(PG8_SA(0, 1), a2 + hstep, voffA);
            PG8_WAIT_L(8); PG8_BAR; PG8_WAIT_L(0); PG8_MMA(0, 0, At, B0); PG8_BAR; PG8_SCHED;
            PG8_LDB(B1, 1, 1); PG8_STAGE(PG8_SB(1, 0), b3, voffB);
            PG8_BAR; PG8_WAIT_L(0); PG8_MMA(0, 1, At, B1); PG8_BAR;
            PG8_LDA(At, 1, 1); PG8_STAGE(PG8_SA(1, 0), a3, voffA);
            PG8_BAR; PG8_WAIT_L(0); PG8_MMA(1, 0, At, B0); PG8_BAR; PG8_SCHED;
            PG8_STAGE(PG8_SB(1, 1), b3 + hstep, voffB);
            PG8_WAIT_V(6); PG8_BAR; PG8_MMA(1, 1, At, B1); PG8_BAR;
            }
                }
        if constexpr (ALIGN_EPI) { if (wr == 0) PG8_BAR; }
        if constexpr (Epi::PREFETCH) { E(acc, cur, wr, wc, fr, fq, xlds + (ui & 1) * Epi::XBLK, xlds + Epi::ZOFF); if (has_next) E.prefetch(nxt, xlds + ((ui + 1) & 1) * Epi::XBLK, wid, lane, false); }
        else E(acc, cur, wr, wc, fr, fq, xlds);
        S.done(cur);
        if (!has_next) break;
        if constexpr (!SP2) {
#pragma unroll
        for (int a = 0; a < 2; ++a)
#pragma unroll
            for (int b = 0; b < 2; ++b)
#pragma unroll
                for (int m = 0; m < 4; ++m)
#pragma unroll
                    for (int n = 0; n < 2; ++n) acc[a][b][m][n] = (f32x4){0.f, 0.f, 0.f, 0.f};
        }
        cur = nxt; cA = nA; cB = nB; ++ui; nt = cur.nt ? cur.nt : nt_def;
        if constexpr (ALIGN_EPI) { if (wr == 1) PG8_BAR; }
    }
    PG8_WAIT_V(0);
    if constexpr (!ALIGN_EPI) { if (wr == 0) PG8_BAR; }
    PG8_BAR;
#undef PG8_SA
#undef PG8_SB
#undef PG8_STAGE
#undef PG8_LDA
#undef PG8_LDB
#undef PG8_MMA
#undef PG8_WAIT_V
#undef PG8_MMA0
#undef PG8_WAIT_L
#undef PG8_WAIT_VG
#undef PG8_BAR
#undef PG8_SCHED
}
}

constexpr int NWAVES = 8;
constexpr int D = 2048, DEPTH = 4;
constexpr int NB_CTX = 16, L_CTX = 256, NB_LAT = 8, L_LAT = 4096;
constexpr int M_CTX = NB_CTX * L_CTX, M_LAT = NB_LAT * L_LAT, M = M_CTX + M_LAT;
constexpr int DCONV = 1024, DRNN = 1024, NH = 16, HD = 64, DIN = 5120, DFF = 6144, NUP = 12288;
constexpr int NVEC = 9;
constexpr int NMODC = 6 * D;
constexpr float EPS = 1e-6f;
constexpr int P2_NMAIN = 4096;
constexpr int M_MAIN = 32768;
constexpr int NCHUNK = M / 64;

constexpr size_t MiB = 1u << 20;
constexpr size_t WS_CTL = 0, CTL_ZERO_BYTES = 64 * 1024;
constexpr size_t WS_MODV = 1 * MiB;
constexpr size_t WS_SUMM = 3 * MiB;
constexpr size_t WS_HIN = 43 * MiB;
constexpr size_t WS_GATEW = 13 * MiB;
constexpr size_t WS_EDGE = 16 * MiB;
constexpr size_t WS_W = 48 * MiB;
constexpr size_t W_LAYER = 100 * MiB, W_IN_OFF = 0, W_OUT_OFF = 20 * MiB, W_UP_OFF = 28 * MiB, W_DOWN_OFF = 76 * MiB;
constexpr size_t WS_A = 448 * MiB;
constexpr size_t WS_BIG = 592 * MiB;
constexpr size_t WS_Y = 1024 * MiB;
constexpr size_t WS_Y2 = 1312 * MiB;
constexpr size_t WS_X = 1168 * MiB;
constexpr size_t WS_HPRE = 1312 * MiB;
constexpr size_t WS_END = 1408 * MiB;
constexpr int CW_BAR = 1024;

constexpr int RING_BYTES = 131072;
constexpr int MISC_OFF = 155648;
constexpr int LDS_BYTES = 156160;

#define GAS __attribute__((address_space(1)))
#define LAS __attribute__((address_space(3)))
typedef unsigned short bf16;
typedef unsigned v4u __attribute__((ext_vector_type(4)));
typedef unsigned v2u __attribute__((ext_vector_type(2)));
typedef float f32x4 __attribute__((ext_vector_type(4)));
typedef float f32x2 __attribute__((ext_vector_type(2)));
#define LDS_WAIT() asm volatile("s_waitcnt lgkmcnt(0)" ::: "memory")
__device__ __forceinline__ unsigned f2bf(float f) { unsigned u = __builtin_bit_cast(unsigned, f); return (u + 0x7fffu + ((u >> 16) & 1u)) >> 16; }
__device__ __forceinline__ unsigned pk2(float lo, float hi) { return f2bf(lo) | (f2bf(hi) << 16); }
typedef __bf16 bf16v2 __attribute__((ext_vector_type(2)));
__device__ __forceinline__ unsigned pkbf(float lo, float hi) { const bf16v2 t = __builtin_convertvector((f32x2){lo, hi}, bf16v2); return __builtin_bit_cast(unsigned, t); }
__device__ __forceinline__ float bf2f(unsigned short b) { return __builtin_bit_cast(float, ((unsigned)b) << 16); }
__device__ __forceinline__ float bflo(unsigned w) { return __builtin_bit_cast(float, w << 16); }
__device__ __forceinline__ float bfhi(unsigned w) { return __builtin_bit_cast(float, w & 0xffff0000u); }
__device__ __forceinline__ float sigmoidf_(float x) { return 1.f / (1.f + __expf(-x)); }
__device__ __forceinline__ float gelu_tanh(float x) { const float u = 1.5957691216057308f * (x + 0.044715f * x * x * x); return x / (1.f + __expf(-u)); }
__device__ __forceinline__ float wave_sum(float v) {
#pragma unroll
    for (int o = 1; o < 64; o <<= 1) v += __shfl_xor(v, o);
    return v;
}

#define XB_TMO      128
#define XB_XCNT(j)  (256  + 64 * (j))
#define XB_XSUB(j)  (1280 + 64 * (j))
#define XB_XGEN(j)  (2304 + 64 * (j))
#define XB_TOP      3328
#define XB_TOPGEN   3392
#define XCD_BAR_WORDS 3456
#define XB_SPIN_CAP (1u << 18)
__device__ __forceinline__ unsigned xb_ld(unsigned* p)              { return __hip_atomic_load(p, __ATOMIC_RELAXED, __HIP_MEMORY_SCOPE_AGENT); }
__device__ __forceinline__ unsigned xb_add(unsigned* p, unsigned v) { return __hip_atomic_fetch_add(p, v, __ATOMIC_RELAXED, __HIP_MEMORY_SCOPE_AGENT); }
__device__ __forceinline__ unsigned xb_xcc_id() { return (unsigned)__builtin_amdgcn_s_getreg((3 << 11) | 20) & 0xFu; }
#define XB_SPIN(cond, bar) do { unsigned _sp = 0; while (cond) { __builtin_amdgcn_s_sleep(1); \
    if ((++_sp & 255u) == 0u) { if (xb_ld(&(bar)[XB_TMO])) break; if (_sp > XB_SPIN_CAP) { atomicAdd(&(bar)[XB_TMO], 1u); break; } } } } while (0)
struct XcdBarrier { unsigned* bar; unsigned x; volatile LAS unsigned* st; int wave; };
__device__ __forceinline__ bool xb_thread0(int wave) { int z = 0; asm volatile("" : "+s"(z)); return wave == 0 && __builtin_amdgcn_mbcnt_hi(~0u, __builtin_amdgcn_mbcnt_lo(~0u, (unsigned)z)) == 0u; }
__device__ __forceinline__ XcdBarrier xcd_barrier_post(unsigned* bar, volatile LAS unsigned* st, int wave) {
    XcdBarrier b; b.bar = bar; b.x = xb_xcc_id(); b.st = st; b.wave = wave;
    if (xb_thread0(wave)) (void)xb_add(&bar[XB_XCNT(b.x)], 1u);
    return b;
}
__device__ __forceinline__ void xcd_barrier_complete(unsigned* bar, unsigned x, unsigned& nloc, unsigned& nx) {
    const unsigned G = gridDim.x * gridDim.y * gridDim.z;
    unsigned sum, cnt, mine, sp = 0u;
    for (;;) {
        sum = 0u; cnt = 0u; mine = 0u;
#pragma unroll
        for (unsigned j = 0; j < 16; ++j) { const unsigned c = xb_ld(&bar[XB_XCNT(j)]); sum += c; cnt += (c > 0u) ? 1u : 0u; mine = (j == x) ? c : mine; }
        if (sum == G) break;
        __builtin_amdgcn_s_sleep(1);
        if ((++sp & 255u) == 0u) { if (xb_ld(&bar[XB_TMO])) break; if (sp > XB_SPIN_CAP) { atomicAdd(&bar[XB_TMO], 1u); break; } }
    }
    nloc = mine > 0u ? mine : 1u; nx = cnt > 0u ? cnt : 1u;
}
__device__ __forceinline__ void xcd_barrier(const XcdBarrier& b) {
    asm volatile("s_waitcnt vmcnt(0)" ::: "memory");
    __syncthreads();
    if (xb_thread0(b.wave)) {
        unsigned* bar = b.bar; asm volatile("" : "+s"(bar));
        __builtin_amdgcn_s_waitcnt(0);
        unsigned nloc = b.st[0], nx = b.st[1];
        if (nloc == 0u) { xcd_barrier_complete(bar, b.x, nloc, nx); b.st[0] = nloc; b.st[1] = nx; }
        const unsigned old = xb_add(&bar[XB_XSUB(b.x)], 1u);
        const unsigned gen = old / nloc;
        if (old + 1u == (gen + 1u) * nloc) {
            __builtin_amdgcn_fence(__ATOMIC_RELEASE, "agent");
            asm volatile("s_waitcnt vmcnt(0)" ::: "memory");
            const unsigned og = xb_add(&bar[XB_TOP], 1u);
            const unsigned tg = og / nx;
            if (og + 1u == (tg + 1u) * nx) xb_add(&bar[XB_TOPGEN], 1u);
            else XB_SPIN(xb_ld(&bar[XB_TOPGEN]) == tg, bar);
            __builtin_amdgcn_fence(__ATOMIC_ACQUIRE, "agent");
            xb_add(&bar[XB_XGEN(b.x)], 1u);
            asm volatile("s_waitcnt vmcnt(0)" ::: "memory");
        } else {
            XB_SPIN(xb_ld(&bar[XB_XGEN(b.x)]) == gen, bar);
            __builtin_amdgcn_fence(__ATOMIC_ACQUIRE, "agent");
            asm volatile("s_waitcnt vmcnt(0)" ::: "memory");
        }
    }
    __syncthreads();
}

struct Args {
    const float* in[21];
    float* out; unsigned char* ws;
    int ph_lo, ph_hi;
    int rep[8];
};
enum { I_XP = 0, I_XS, I_STATE, I_C, I_CCTX, I_WADA, I_BADA, I_NORMG, I_WIN, I_CONVA, I_RCW, I_RCB, I_RWA, I_RBA, I_RWX, I_RBX, I_RLAM, I_WOUT, I_FUP, I_FCW, I_FDOWN };

__device__ __forceinline__ void transpose_item(const float* W, int K, int N, bf16* WT, int k0, int n0, int dst_row0, LAS float* scr, int lane) {
#pragma unroll 8
    for (int i = 0; i < 32; ++i) { const int kk = 2 * i + (lane >> 5); scr[kk * 33 + (lane & 31)] = W[(size_t)(k0 + kk) * N + n0 + (lane & 31)]; }
    LDS_WAIT(); asm volatile("" ::: "memory");
    const int c = lane & 7;
#pragma unroll
    for (int j = 0; j < 4; ++j) { const int n = (lane >> 3) + 8 * j; const LAS float* s = scr + (8 * c) * 33 + n;
        v4u o; o.x = pk2(s[0 * 33], s[1 * 33]); o.y = pk2(s[2 * 33], s[3 * 33]); o.z = pk2(s[4 * 33], s[5 * 33]); o.w = pk2(s[6 * 33], s[7 * 33]);
        *(GAS v4u*)(WT + blk_off(dst_row0 + n, k0 + 8 * c, K)) = o; }
    LDS_WAIT(); asm volatile("" ::: "memory");
}
constexpr int TI_IN = (D / 64) * (DIN / 32), TI_OUT = (D / 64) * (D / 32), TI_UP = (D / 64) * (NUP / 32), TI_DOWN = (DFF / 64) * (D / 32);
constexpr int TI_LAYER = TI_IN + TI_OUT + TI_UP + TI_DOWN;

__device__ __forceinline__ void pre_transposes(const Args& a, LAS unsigned char* lds, int gw, int NGW, int wave, int lane) {
    LAS float* scr = (LAS float*)(lds + wave * 16384);
    for (int it = gw; it < DEPTH * 2 * 2 * NH * 2; it += NGW) {
        const int half = it & 1, mat = it >> 1, hd = mat & 15, gate = (mat >> 4) & 1, ld = mat >> 5;
        const float* W = (gate ? a.in[I_RWX] : a.in[I_RWA]) + (size_t)(ld * NH + hd) * 64 * 64;
        transpose_item(W, 64, 64, (bf16*)(a.ws + WS_GATEW) + (size_t)((ld * 2 + gate) * NH + hd) * 64 * 64, 0, 32 * half, 32 * half, scr, lane);
    }
    for (int it = gw; it < DEPTH * TI_LAYER; it += NGW) {
        const int l = it / TI_LAYER; int r = it % TI_LAYER;
        bf16* wl = (bf16*)(a.ws + WS_W + (size_t)l * W_LAYER);
        if (r < TI_IN) { const int nblk = DIN / 32, kb = r / nblk, nb = r % nblk;
            transpose_item(a.in[I_WIN] + (size_t)l * D * DIN, D, DIN, (bf16*)((unsigned char*)wl + W_IN_OFF), 64 * kb, 32 * nb, 32 * nb, scr, lane); continue; }
        r -= TI_IN;
        if (r < TI_OUT) { const int nblk = D / 32, kb = r / nblk, nb = r % nblk;
            transpose_item(a.in[I_WOUT] + (size_t)l * D * D, D, D, (bf16*)((unsigned char*)wl + W_OUT_OFF), 64 * kb, 32 * nb, 32 * nb, scr, lane); continue; }
        r -= TI_OUT;
        if (r < TI_UP) { const int nblk = NUP / 32, kb = r / nblk, nb = r % nblk; const int n0 = 32 * nb;
            const int dst = (n0 < DFF) ? ((n0 >> 7) * 256 + (n0 & 127)) : ((((n0 - DFF) >> 7) * 256) + 128 + ((n0 - DFF) & 127));
            transpose_item(a.in[I_FUP] + (size_t)l * D * NUP, D, NUP, (bf16*)((unsigned char*)wl + W_UP_OFF), 64 * kb, n0, dst, scr, lane); continue; }
        r -= TI_UP;
        { const int nblk = D / 32, kb = r / nblk, nb = r % nblk;
            transpose_item(a.in[I_FDOWN] + (size_t)l * DFF * D, DFF, D, (bf16*)((unsigned char*)wl + W_DOWN_OFF), 64 * kb, 32 * nb, 32 * nb, scr, lane); }
    }
}

__device__ __forceinline__ void pre_mod(const Args& a, LAS unsigned char* lds, int tid, int wave, int lane) {
    LAS float* s = (LAS float*)lds;
    LAS float* red = s + NVEC * D;
    for (int i = tid; i < NVEC * D; i += NWAVES * 64) { const int v = i / D, k = i % D; const float c = (v == 0) ? a.in[I_CCTX][k] : a.in[I_C][(v - 1) * D + k]; s[i] = c / (1.f + __expf(-c)); }
    __syncthreads();
    float* modv = (float*)(a.ws + WS_MODV);
    const int cl = tid & 15, ks = tid >> 4;
    for (int item = blockIdx.x; item < DEPTH * (NMODC / 64); item += gridDim.x) {
        const int l = item / (NMODC / 64), n0 = (item % (NMODC / 64)) * 64;
        float acc[NVEC][4];
#pragma unroll
        for (int v = 0; v < NVEC; ++v) { acc[v][0] = 0.f; acc[v][1] = 0.f; acc[v][2] = 0.f; acc[v][3] = 0.f; }
        const float* wp = a.in[I_WADA] + ((size_t)l * D + ks * 64) * NMODC + n0 + 4 * cl;
        const LAS float* sp = s + ks * 64;
#pragma unroll 8
        for (int kk = 0; kk < 64; ++kk) {
            const f32x4 w = *(const f32x4*)(wp + (size_t)kk * NMODC);
#pragma unroll
            for (int v = 0; v < NVEC; ++v) { const float sv = sp[v * D + kk]; acc[v][0] += sv * w[0]; acc[v][1] += sv * w[1]; acc[v][2] += sv * w[2]; acc[v][3] += sv * w[3]; }
        }
#pragma unroll
        for (int v = 0; v < NVEC; ++v)
#pragma unroll
            for (int e = 0; e < 4; ++e) { float t = acc[v][e]; t += __shfl_xor(t, 16); t += __shfl_xor(t, 32); if (lane < 16) red[(wave * 16 + cl) * 36 + v * 4 + e] = t; }
        __syncthreads();
        for (int o = tid; o < NVEC * 64; o += NWAVES * 64) {
            const int v = o >> 6, col = o & 63;
            float sum = 0.f;
#pragma unroll
            for (int w = 0; w < NWAVES; ++w) sum += red[(w * 16 + (col >> 2)) * 36 + v * 4 + (col & 3)];
            const int n = n0 + col, q = n / D, j = n % D;
            const float val = sum + a.in[I_BADA][l * NMODC + n];
            const float* ng = a.in[I_NORMG] + (size_t)l * 4 * D;
            int slot; float r;
            if (q == 0) { slot = 1; r = val; }
            else if (q == 1) { slot = 0; r = ng[0 * D + j] * (1.f + val); }
            else if (q == 2) { slot = 2; r = val * ng[1 * D + j]; }
            else if (q == 3) { slot = 4; r = val; }
            else if (q == 4) { slot = 3; r = ng[2 * D + j] * (1.f + val); }
            else { slot = 5; r = val * ng[3 * D + j]; }
            modv[((size_t)(l * NVEC + v) * 6 + slot) * D + j] = r;
        }
        __syncthreads();
    }
}

template <bool XSRC_F32, bool HAS_RES, int XW, bool HAS_U>
__device__ __forceinline__ void resnorm_rows(const Args& a, LAS unsigned char* lds, int tid, int wave, int lane, int l_res, int slot_res, int l_u, int su) {
    const float* modv = (const float*)(a.ws + WS_MODV);
    bf16* U = (bf16*)(a.ws + WS_A);
    bf16* X = (bf16*)(a.ws + WS_X);
    const bf16* Y = (const bf16*)(a.ws + WS_Y);
    const bf16* Y2 = (const bf16*)(a.ws + WS_Y2);
    const bool split_tail = (gridDim.x == 256);
    const int rpb = (M + (int)gridDim.x - 1) / (int)gridDim.x, r_lo = (int)blockIdx.x * rpb, r_hi = (r_lo + rpb < M) ? r_lo + rpb : M;
    if (r_lo >= M) return;
    const int v_lo = (r_lo < M_CTX) ? 0 : 1 + ((r_lo - M_CTX) >> 12);
    LAS float* vl = (LAS float*)lds;
    for (int i = tid; i < 2 * 3 * (D / 4); i += NWAVES * 64) {
        const int e4 = i % (D / 4), k = (i / (D / 4)) % 3, vv = i / (3 * (D / 4));
        const int v = (v_lo + vv < NVEC) ? v_lo + vv : NVEC - 1;
        const float* src = (k == 0) ? modv + ((size_t)(l_res * NVEC + v) * 6 + slot_res) * D : modv + ((size_t)(l_u * NVEC + v) * 6 + su + (k - 1)) * D;
        f32x4 val = (f32x4){0.f, 0.f, 0.f, 0.f};
        if ((k == 0 && HAS_RES) || (k > 0 && HAS_U)) val = *(const GAS f32x4*)(src + 4 * e4);
        *(LAS f32x4*)(vl + (size_t)(vv * 3 + k) * D + 4 * e4) = val;
    }
    __syncthreads();
    v4u rx[4], ry[4], ry2[4]; f32x4 fx[8];
    auto issue = [&](int m) {
        if (XSRC_F32) { const float* xs = (m < M_CTX) ? a.in[I_XP] + (size_t)m * D : a.in[I_XS] + (size_t)(m - M_CTX) * D;
#pragma unroll
            for (int j = 0; j < 4; ++j) { fx[2 * j] = __builtin_nontemporal_load((const GAS f32x4*)(xs + 8 * (lane + 64 * j))); fx[2 * j + 1] = __builtin_nontemporal_load((const GAS f32x4*)(xs + 8 * (lane + 64 * j) + 4)); } }
        else {
#pragma unroll
            for (int j = 0; j < 4; ++j) rx[j] = __builtin_nontemporal_load((const GAS v4u*)(X + (size_t)m * D + 8 * (lane + 64 * j))); }
        if (HAS_RES) {
#pragma unroll
            for (int j = 0; j < 4; ++j) ry[j] = __builtin_nontemporal_load((const GAS v4u*)(Y + (size_t)m * D + 8 * (lane + 64 * j)));
            if (split_tail && m >= M_MAIN) {
#pragma unroll
                for (int j = 0; j < 4; ++j) ry2[j] = __builtin_nontemporal_load((const GAS v4u*)(Y2 + (size_t)(m - M_MAIN) * D + 8 * (lane + 64 * j))); }
        }
    };
    int m = r_lo + wave;
    if (m < r_hi) issue(m);
    for (; m < r_hi; m += NWAVES) {
        const int v = (m < M_CTX) ? 0 : 1 + ((m - M_CTX) >> 12);
        const LAS float* vb = vl + (size_t)((v - v_lo) * 3) * D;
        float xv[4][8];
        if (XSRC_F32) {
#pragma unroll
            for (int j = 0; j < 4; ++j) { const f32x4 p = fx[2 * j], q = fx[2 * j + 1];
                xv[j][0] = p.x; xv[j][1] = p.y; xv[j][2] = p.z; xv[j][3] = p.w; xv[j][4] = q.x; xv[j][5] = q.y; xv[j][6] = q.z; xv[j][7] = q.w; }
        } else {
#pragma unroll
            for (int j = 0; j < 4; ++j) { const v4u p = rx[j];
                xv[j][0] = bflo(p.x); xv[j][1] = bfhi(p.x); xv[j][2] = bflo(p.y); xv[j][3] = bfhi(p.y); xv[j][4] = bflo(p.z); xv[j][5] = bfhi(p.z); xv[j][6] = bflo(p.w); xv[j][7] = bfhi(p.w); }
        }
        float yv[4][8];
        if (HAS_RES) {
#pragma unroll
            for (int j = 0; j < 4; ++j) { const v4u p = ry[j];
                yv[j][0] = bflo(p.x); yv[j][1] = bfhi(p.x); yv[j][2] = bflo(p.y); yv[j][3] = bfhi(p.y); yv[j][4] = bflo(p.z); yv[j][5] = bfhi(p.z); yv[j][6] = bflo(p.w); yv[j][7] = bfhi(p.w); }
            if (split_tail && m >= M_MAIN) {
#pragma unroll
                for (int j = 0; j < 4; ++j) { const v4u p = ry2[j];
                    yv[j][0] += bflo(p.x); yv[j][1] += bfhi(p.x); yv[j][2] += bflo(p.y); yv[j][3] += bfhi(p.y); yv[j][4] += bflo(p.z); yv[j][5] += bfhi(p.z); yv[j][6] += bflo(p.w); yv[j][7] += bfhi(p.w); }
            }
        }
        if (m + NWAVES < r_hi) issue(m + NWAVES);
        if (HAS_RES) {
            float ss = 0.f;
#pragma unroll
            for (int j = 0; j < 4; ++j)
#pragma unroll
                for (int e = 0; e < 8; ++e) ss += yv[j][e] * yv[j][e];
            const float rstd = 1.f / sqrtf(wave_sum(ss) * (1.f / D) + EPS);
#pragma unroll
            for (int j = 0; j < 4; ++j) { const f32x4 g0 = *(const LAS f32x4*)(vb + 8 * (lane + 64 * j)), g1 = *(const LAS f32x4*)(vb + 8 * (lane + 64 * j) + 4);
                xv[j][0] += g0.x * yv[j][0] * rstd; xv[j][1] += g0.y * yv[j][1] * rstd; xv[j][2] += g0.z * yv[j][2] * rstd; xv[j][3] += g0.w * yv[j][3] * rstd;
                xv[j][4] += g1.x * yv[j][4] * rstd; xv[j][5] += g1.y * yv[j][5] * rstd; xv[j][6] += g1.z * yv[j][6] * rstd; xv[j][7] += g1.w * yv[j][7] * rstd; }
        }
        if (XW == 1) {
#pragma unroll
            for (int j = 0; j < 4; ++j) { v4u o; o.x = pkbf(xv[j][0], xv[j][1]); o.y = pkbf(xv[j][2], xv[j][3]); o.z = pkbf(xv[j][4], xv[j][5]); o.w = pkbf(xv[j][6], xv[j][7]);
                __builtin_nontemporal_store(o, (GAS v4u*)(X + (size_t)m * D + 8 * (lane + 64 * j))); }
        } else if (XW == 2) {
#pragma unroll
            for (int j = 0; j < 4; ++j) { float* xo = a.out + (size_t)m * D + 8 * (lane + 64 * j);
                *(GAS f32x4*)xo = (f32x4){xv[j][0], xv[j][1], xv[j][2], xv[j][3]}; *(GAS f32x4*)(xo + 4) = (f32x4){xv[j][4], xv[j][5], xv[j][6], xv[j][7]}; }
        }
        if (HAS_U) {
            float ss = 0.f;
#pragma unroll
            for (int j = 0; j < 4; ++j)
#pragma unroll
                for (int e = 0; e < 8; ++e) ss += xv[j][e] * xv[j][e];
            const float rstd = 1.f / sqrtf(wave_sum(ss) * (1.f / D) + EPS);
            const LAS float* gn = vb + D; const LAS float* bn = vb + 2 * D;
#pragma unroll
            for (int j = 0; j < 4; ++j) { const int e0 = 8 * (lane + 64 * j);
                const f32x4 g0 = *(const LAS f32x4*)(gn + e0), g1 = *(const LAS f32x4*)(gn + e0 + 4), b0 = *(const LAS f32x4*)(bn + e0), b1 = *(const LAS f32x4*)(bn + e0 + 4);
                v4u o; o.x = pkbf(xv[j][0] * rstd * g0.x + b0.x, xv[j][1] * rstd * g0.y + b0.y); o.y = pkbf(xv[j][2] * rstd * g0.z + b0.z, xv[j][3] * rstd * g0.w + b0.w);
                o.z = pkbf(xv[j][4] * rstd * g1.x + b1.x, xv[j][5] * rstd * g1.y + b1.y); o.w = pkbf(xv[j][6] * rstd * g1.z + b1.z, xv[j][7] * rstd * g1.w + b1.w);
                *(GAS v4u*)(U + blk_off(m, e0, D)) = o; }
        }
    }
}

struct SeqInfo { int base, L, s0, b, cfirst, clast; bool col, ctx; };
__device__ __forceinline__ SeqInfo seq_info(int c, int layer) {
    SeqInfo q;
    if (c < 64) { q.b = c >> 2; q.s0 = (c & 3) * 64; q.L = L_CTX; q.base = q.b * L_CTX; q.col = false; q.ctx = true; q.cfirst = c & ~3; q.clast = q.cfirst + 3; }
    else { const int cc = c - 64; q.b = cc >> 6; q.s0 = (cc & 63) * 64; q.L = L_LAT; q.base = M_CTX + q.b * L_LAT; q.col = (layer & 1) != 0; q.ctx = false; q.cfirst = 64 + (cc & ~63); q.clast = q.cfirst + 63; }
    return q;
}
__device__ __forceinline__ int tok_of(const SeqInfo& q, int s) { return q.base + (q.col ? (((s & 63) << 6) | (s >> 6)) : s); }

typedef float f32x16 __attribute__((ext_vector_type(16)));
typedef short bf16x8v __attribute__((ext_vector_type(8)));
constexpr int XROW = 144;
constexpr int XT_BYTES = 10240;
constexpr int HT_BYTES = 9216;
constexpr int WAVE_LDS = XT_BYTES + HT_BYTES;

__device__ __forceinline__ void stage_tile(const bf16* src, const SeqInfo& q, int pos0, int nrows, LAS unsigned char* xt, int lane) {
    const int sub = lane & 7, rsel = lane >> 3;
    v4u val[9];
#pragma unroll
    for (int i = 0; i < 9; ++i) {
        const int s = pos0 + 8 * i + rsel, sc = s < 0 ? 0 : (s >= q.L ? q.L - 1 : s);
        val[i] = *(const v4u*)(src + (size_t)tok_of(q, sc) * DIN + sub * 8);
    }
    if (pos0 >= 0 && pos0 + nrows <= q.L) {
#pragma unroll
        for (int i = 0; i < 9; ++i) { const int rr = 8 * i + rsel; if (rr < nrows) *(LAS v4u*)(xt + rr * XROW + sub * 16) = val[i]; }
        return;
    }
#pragma unroll
    for (int i = 0; i < 9; ++i) {
        const int rr = 8 * i + rsel, s = pos0 + rr; const bool ok = (s >= 0 && s < q.L);
        v4u v = val[i]; v.x = ok ? v.x : 0u; v.y = ok ? v.y : 0u; v.z = ok ? v.z : 0u; v.w = ok ? v.w : 0u;
        if (rr < nrows) *(LAS v4u*)(xt + rr * XROW + sub * 16) = v;
    }
}

template <bool FINAL, int DIR>
__device__ __forceinline__ void scan_dir(const Args& a, int layer, int h, int c, const SeqInfo& q, LAS unsigned char* xt, LAS unsigned char* hft, int lane, float hin0, float hin1) {
    const int ld = layer * 2 + DIR, r = lane & 31, hh = lane >> 5;
    bf16x8v afr[2][4];
#pragma unroll
    for (int ks = 0; ks < 4; ++ks) {
        const int i0 = 16 * ks + 8 * hh;
        const float* cw = a.in[I_RCW] + (size_t)(ld * 4) * DRNN + h * 64 + i0;
        f32x4 w[4][2];
#pragma unroll
        for (int k = 0; k < 4; ++k) { w[k][0] = *(const f32x4*)(cw + k * DRNN); w[k][1] = *(const f32x4*)(cw + k * DRNN + 4); }
        const f32x4 b0 = *(const f32x4*)(a.in[I_RCB] + ld * DRNN + h * 64 + i0), b1 = *(const f32x4*)(a.in[I_RCB] + ld * DRNN + h * 64 + i0 + 4);
#pragma unroll
        for (int tb = 0; tb < 2; ++tb) {
            const int t = tb * 32 + r;
            f32x4 a0 = b0, a1 = b1;
#pragma unroll
            for (int k = 0; k < 4; ++k) {
                const int rr = DIR ? (t + 6 - k) : (t + k);
                const v4u raw = *(const LAS v4u*)(xt + rr * XROW + i0 * 2);
                a0 += w[k][0] * (f32x4){bflo(raw.x), bfhi(raw.x), bflo(raw.y), bfhi(raw.y)};
                a1 += w[k][1] * (f32x4){bflo(raw.z), bfhi(raw.z), bflo(raw.w), bfhi(raw.w)};
            }
            v4u p; p.x = pkbf(a0.x, a0.y); p.y = pkbf(a0.z, a0.w); p.z = pkbf(a1.x, a1.y); p.w = pkbf(a1.z, a1.w);
            afr[tb][ks] = __builtin_bit_cast(bf16x8v, p);
        }
    }
    const bf16* gatew = (const bf16*)(a.ws + WS_GATEW);
    f32x2* summ = (f32x2*)(a.ws + WS_SUMM);
    float* nstate = a.out + (size_t)M * D;
#pragma unroll
    for (int cb = 0; cb < 2; ++cb) {
        const int chh = cb * 32 + r, ch = h * 64 + chh;
        bf16x8v bfr[2][4];
#pragma unroll
        for (int gate = 0; gate < 2; ++gate)
#pragma unroll
            for (int ks = 0; ks < 4; ++ks) bfr[gate][ks] = *(const bf16x8v*)(gatew + ((size_t)((ld * 2 + gate) * NH + h) * 64 + chh) * 64 + 16 * ks + 8 * hh);
        const float nba = -1.4426950408889634f * a.in[I_RBA][ld * DRNN + ch], nbx = -1.4426950408889634f * a.in[I_RBX][ld * DRNN + ch];
        const float c8l2 = -8.f * 1.4426950408889634f * log1pf(__expf(-a.in[I_RLAM][ld * DRNN + ch]));
        bf16x8v self[2];
#pragma unroll
        for (int s2 = 0; s2 < 2; ++s2) { const int idx = r - 16 * s2 - 8 * hh; v4u p;
            p.x = (idx == 0 ? 0x3F80u : 0u) | (idx == 1 ? 0x3F800000u : 0u); p.y = (idx == 2 ? 0x3F80u : 0u) | (idx == 3 ? 0x3F800000u : 0u);
            p.z = (idx == 4 ? 0x3F80u : 0u) | (idx == 5 ? 0x3F800000u : 0u); p.w = (idx == 6 ? 0x3F80u : 0u) | (idx == 7 ? 0x3F800000u : 0u);
            self[s2] = __builtin_bit_cast(bf16x8v, p); }
        float hstate = FINAL ? (cb ? hin1 : hin0) : 0.f, Atot = 1.f;
        const bool first_mine = (hh == DIR);
#pragma unroll
        for (int tbi = 0; tbi < 2; ++tbi) {
            const int tb = DIR ? 1 - tbi : tbi;
            f32x16 accr, acci, accx;
#pragma unroll
            for (int i = 0; i < 16; ++i) { accr[i] = 0.f; acci[i] = 0.f; accx[i] = 0.f; }
#pragma unroll
            for (int ks = 0; ks < 4; ++ks) {
                accr = __builtin_amdgcn_mfma_f32_32x32x16_bf16(afr[tb][ks], bfr[0][ks], accr, 0, 0, 0);
                acci = __builtin_amdgcn_mfma_f32_32x32x16_bf16(afr[tb][ks], bfr[1][ks], acci, 0, 0, 0);
            }
            accx = __builtin_amdgcn_mfma_f32_32x32x16_bf16(afr[tb][2 * cb], self[0], accx, 0, 0, 0);
            accx = __builtin_amdgcn_mfma_f32_32x32x16_bf16(afr[tb][2 * cb + 1], self[1], accx, 0, 0, 0);
            float av[16], vv[16];
#pragma unroll
            for (int qi = 0; qi < 16; qi += 2) {
                const f32x2 tr = (f32x2){accr[qi], accr[qi + 1]} * -1.4426950408889634f + nba, ti = (f32x2){acci[qi], acci[qi + 1]} * -1.4426950408889634f + nbx;
                f32x2 dr, di; dr.x = __builtin_amdgcn_exp2f(tr.x); dr.y = __builtin_amdgcn_exp2f(tr.y); di.x = __builtin_amdgcn_exp2f(ti.x); di.y = __builtin_amdgcn_exp2f(ti.y);
                dr = dr + 1.f; di = di + 1.f;
                f32x2 rg, ig; rg.x = __builtin_amdgcn_rcpf(dr.x); rg.y = __builtin_amdgcn_rcpf(dr.y); ig.x = __builtin_amdgcn_rcpf(di.x); ig.y = __builtin_amdgcn_rcpf(di.y);
                const f32x2 la = rg * c8l2;
                f32x2 aa; aa.x = __builtin_amdgcn_exp2f(la.x); aa.y = __builtin_amdgcn_exp2f(la.y);
                f32x2 w = 1.f - aa * aa;
                f32x2 sq; sq.x = __builtin_amdgcn_sqrtf(fmaxf(0.f, w.x)); sq.y = __builtin_amdgcn_sqrtf(fmaxf(0.f, w.y));
                const f32x2 vq = sq * (ig * (f32x2){accx[qi], accx[qi + 1]});
                av[qi] = aa.x; av[qi + 1] = aa.y; vv[qi] = vq.x; vv[qi + 1] = vq.y;
            }
            float Ao[4], Ho[4], pA[4], pH[4];
#pragma unroll
            for (int gq = 0; gq < 4; ++gq) {
                float A_ = 1.f, H_ = 0.f;
#pragma unroll
                for (int ei = 0; ei < 4; ++ei) { const int qi = 4 * gq + (DIR ? 3 - ei : ei); H_ = av[qi] * H_ + vv[qi]; A_ *= av[qi]; }
                Ao[gq] = A_; Ho[gq] = H_; pA[gq] = __shfl_xor(A_, 32); pH[gq] = __shfl_xor(H_, 32);
            }
#pragma unroll
            for (int gqi = 0; gqi < 4; ++gqi) {
                const int gq = DIR ? 3 - gqi : gqi;
                const float pre = first_mine ? hstate : (pA[gq] * hstate + pH[gq]);
                float post;
                if (FINAL) {
                    float hs = pre;
#pragma unroll
                    for (int ei = 0; ei < 4; ++ei) { const int e = DIR ? 3 - ei : ei, qi = 4 * gq + e; hs = av[qi] * hs + vv[qi]; vv[qi] = hs; }
                    post = hs;
                } else { post = Ao[gq] * pre + Ho[gq]; Atot *= Ao[gq] * pA[gq]; }
                hstate = first_mine ? (pA[gq] * post + pH[gq]) : post;
            }
            if (FINAL) {
                float hold[16];
                if (DIR == 1) {
#pragma unroll
                    for (int qi = 0; qi < 16; ++qi) hold[qi] = bf2f(*(const LAS unsigned short*)(hft + (tb * 32 + (qi & 3) + 8 * (qi >> 2) + 4 * hh) * XROW + chh * 2));
                }
#pragma unroll
                for (int qi = 0; qi < 16; ++qi) {
                    LAS unsigned short* hp = (LAS unsigned short*)(hft + (tb * 32 + (qi & 3) + 8 * (qi >> 2) + 4 * hh) * XROW + chh * 2);
                    *hp = (unsigned short)pkbf(DIR == 1 ? hold[qi] + vv[qi] : vv[qi], 0.f);
                }
            }
        }
        if (!FINAL) { if (hh == 0) summ[(size_t)(c * 2 + DIR) * DRNN + ch] = (f32x2){Atot, hstate}; }
        else if (q.ctx && hh == 0 && c == (DIR ? q.cfirst : q.clast)) nstate[((size_t)(q.b * DEPTH + layer) * 2 + DIR) * DRNN + ch] = hstate;
    }
}

__device__ __forceinline__ void p2_reduce(unsigned char* ws, int gtid, int nthreads) {
    constexpr int NC = DIN - P2_NMAIN, CPR = NC / 8, NR = M - M_MAIN;
    bf16* proj = (bf16*)(ws + WS_BIG); const bf16* px = (const bf16*)(ws + WS_Y2);
    for (int id = gtid; id < NR * CPR; id += nthreads) {
        const int row = id / CPR, cc = id % CPR;
        bf16* dst = proj + (size_t)(M_MAIN + row) * DIN + P2_NMAIN + cc * 8;
        const v4u a = *(const v4u*)dst, b = *(const v4u*)(px + (size_t)row * NC + cc * 8), c = *(const v4u*)(px + (size_t)(NR + row) * NC + cc * 8), d = *(const v4u*)(px + (size_t)(2 * NR + row) * NC + cc * 8);
        v4u o;
        o.x = pkbf(bflo(a.x) + bflo(b.x) + bflo(c.x) + bflo(d.x), bfhi(a.x) + bfhi(b.x) + bfhi(c.x) + bfhi(d.x)); o.y = pkbf(bflo(a.y) + bflo(b.y) + bflo(c.y) + bflo(d.y), bfhi(a.y) + bfhi(b.y) + bfhi(c.y) + bfhi(d.y));
        o.z = pkbf(bflo(a.z) + bflo(b.z) + bflo(c.z) + bflo(d.z), bfhi(a.z) + bfhi(b.z) + bfhi(c.z) + bfhi(d.z)); o.w = pkbf(bflo(a.w) + bflo(b.w) + bflo(c.w) + bflo(d.w), bfhi(a.w) + bfhi(b.w) + bfhi(c.w) + bfhi(d.w));
        *(v4u*)dst = o;
    }
}
__device__ __forceinline__ void scan_summary_item(const Args& a, int layer, int item, int lane, LAS unsigned char* xt) {
    const int d = item & 1, h = (item >> 1) & 15, c = item >> 5;
    const SeqInfo q = seq_info(c, layer);
    stage_tile((const bf16*)(a.ws + WS_BIG) + 3 * DCONV + h * 64, q, q.s0 - 3, 70, xt, lane);
    if (d == 0) scan_dir<false, 0>(a, layer, h, c, q, xt, xt, lane, 0.f, 0.f);
    else scan_dir<false, 1>(a, layer, h, c, q, xt, xt, lane, 0.f, 0.f);
}

__device__ __forceinline__ void carry_phase(const Args& a, int layer, int gtid, int nthreads) {
    const f32x2* summ = (const f32x2*)(a.ws + WS_SUMM);
    float* hin = (float*)(a.ws + WS_HIN);
    for (int it = gtid; it < (NB_CTX + NB_LAT) * 2 * DRNN; it += nthreads) {
        const int ch = it & (DRNN - 1), d = (it >> 10) & 1, sq = it >> 11;
        const bool ctx = sq < NB_CTX; const int b = ctx ? sq : sq - NB_CTX;
        const int cfirst = ctx ? 4 * b : 64 + 64 * b, n = ctx ? 4 : 64;
        float h = ctx ? 0.f : a.in[I_STATE][((size_t)(b * DEPTH + layer) * 2 + d) * DRNN + ch];
        for (int i0 = 0; i0 < n; i0 += 4) {
            f32x2 t[4];
#pragma unroll
            for (int k = 0; k < 4; ++k) { const int cc = d ? (cfirst + n - 1 - (i0 + k)) : (cfirst + i0 + k); t[k] = summ[(size_t)(cc * 2 + d) * DRNN + ch]; }
#pragma unroll
            for (int k = 0; k < 4; ++k) { const int cc = d ? (cfirst + n - 1 - (i0 + k)) : (cfirst + i0 + k); hin[(size_t)(cc * 2 + d) * DRNN + ch] = h; h = t[k].x * h + t[k].y; }
        }
    }
}

__device__ __forceinline__ void mixb_item(const Args& a, int layer, int item, int lane, LAS unsigned char* xt) {
    const int h = item & 15, c = item >> 4, r = lane & 31, hh = lane >> 5;
    const SeqInfo q = seq_info(c, layer);
    const bf16* proj = (const bf16*)(a.ws + WS_BIG);
    stage_tile(proj + 3 * DCONV + h * 64, q, q.s0 - 3, 70, xt, lane);
    LAS unsigned char* hft = xt + XT_BYTES;
    {
        const float hl = ((const float*)(a.ws + WS_HIN))[(size_t)(c * 2 + 0) * DRNN + h * 64 + lane];
        scan_dir<true, 0>(a, layer, h, c, q, xt, hft, lane, __shfl(hl, r), __shfl(hl, 32 + r));
    }
    {
        const float hl = ((const float*)(a.ws + WS_HIN))[(size_t)(c * 2 + 1) * DRNN + h * 64 + lane];
        scan_dir<true, 1>(a, layer, h, c, q, xt, hft, lane, __shfl(hl, r), __shfl(hl, 32 + r));
    }
    stage_tile(proj + 3 * DCONV + DRNN + h * 64, q, q.s0, 64, xt, lane);
    bf16* ymix0 = (bf16*)(a.ws + WS_A);
    const int sub = lane & 7, rsel = lane >> 3;
#pragma unroll
    for (int r0 = 0; r0 < 64; r0 += 8) {
        const int rr = r0 + rsel;
        const v4u hv = *(const LAS v4u*)(hft + rr * XROW + sub * 16), gv = *(const LAS v4u*)(xt + rr * XROW + sub * 16);
        v4u val;
        val.x = pkbf(bflo(hv.x) * gelu_tanh(bflo(gv.x)), bfhi(hv.x) * gelu_tanh(bfhi(gv.x))); val.y = pkbf(bflo(hv.y) * gelu_tanh(bflo(gv.y)), bfhi(hv.y) * gelu_tanh(bfhi(gv.y)));
        val.z = pkbf(bflo(hv.z) * gelu_tanh(bflo(gv.z)), bfhi(hv.z) * gelu_tanh(bfhi(gv.z))); val.w = pkbf(bflo(hv.w) * gelu_tanh(bflo(gv.w)), bfhi(hv.w) * gelu_tanh(bfhi(gv.w)));
        *(v4u*)(ymix0 + blk_off(tok_of(q, q.s0 + rr), DCONV + h * 64 + sub * 8, D)) = val;
    }
}

__device__ __forceinline__ void mixa_item(const Args& a, int layer, int item, int lane) {
    const int g4 = item & 3, c16 = item >> 2, ch0 = g4 * 256 + lane * 4;
    const SeqInfo q = seq_info(c16 >> 2, layer);
    const int sb = q.s0 + 16 * (c16 & 3);
    const bf16* proj = (const bf16*)(a.ws + WS_BIG) + ch0;
    bf16* ymix = (bf16*)(a.ws + WS_A);
    const f32x4 w0 = *(const f32x4*)(a.in[I_CONVA] + (size_t)(layer * 3 + 0) * DCONV + ch0);
    const f32x4 w1 = *(const f32x4*)(a.in[I_CONVA] + (size_t)(layer * 3 + 1) * DCONV + ch0);
    const f32x4 w2 = *(const f32x4*)(a.in[I_CONVA] + (size_t)(layer * 3 + 2) * DCONV + ch0);
    v2u cgr[18], xar[18], bgr[16];
#pragma unroll
    for (int i = 0; i < 18; ++i) { const int s = sb - 1 + i, sc = s < 0 ? 0 : (s >= q.L ? q.L - 1 : s); const bf16* row = proj + (size_t)tok_of(q, sc) * DIN;
        cgr[i] = *(const v2u*)(row + DCONV); xar[i] = *(const v2u*)(row + 2 * DCONV); if (i >= 1 && i <= 16) bgr[i - 1] = *(const v2u*)row; }
    f32x4 cx[18];
#pragma unroll
    for (int i = 0; i < 18; ++i) { const int s = sb - 1 + i; const float ok = (s >= 0 && s < q.L) ? 1.f : 0.f;
        cx[i] = (f32x4){bflo(cgr[i].x) * bflo(xar[i].x), bfhi(cgr[i].x) * bfhi(xar[i].x), bflo(cgr[i].y) * bflo(xar[i].y), bfhi(cgr[i].y) * bfhi(xar[i].y)} * ok; }
#pragma unroll
    for (int e = 0; e < 16; ++e) {
        const f32x4 hv = w0 * cx[e] + w1 * cx[e + 1] + w2 * cx[e + 2];
        const f32x4 bv = (f32x4){bflo(bgr[e].x), bfhi(bgr[e].x), bflo(bgr[e].y), bfhi(bgr[e].y)};
        const f32x4 o = bv * hv;
        v2u ov; ov.x = pk2(o.x, o.y); ov.y = pk2(o.z, o.w);
        *(v2u*)(ymix + blk_off(tok_of(q, sb + e), ch0, D)) = ov;
    }
}

__device__ __forceinline__ void convgate_item(const Args& a, int layer, int chunk, int item, int lane) {
    const int cgp = item % 12, rb = item / 12, r0 = rb * 8, ch0 = cgp * 512 + lane * 8;
    const int seqlen = (chunk == 0) ? L_CTX : L_LAT;
    const bf16* hp = (const bf16*)(a.ws + WS_HPRE) + (size_t)((ch0 >> 7) * 256 + (ch0 & 127));
    bf16* act = (bf16*)(a.ws + WS_BIG) + (size_t)(chunk * 4096) * DFF + ch0;
    const float* cw = a.in[I_FCW] + (size_t)layer * 3 * NUP;
    float wg[3][8], wv[3][8];
#pragma unroll
    for (int t = 0; t < 3; ++t)
#pragma unroll
        for (int e = 0; e < 8; ++e) { wg[t][e] = cw[t * NUP + ch0 + e]; wv[t][e] = cw[t * NUP + DFF + ch0 + e]; }
    v4u rg[10], rv[10];
#pragma unroll
    for (int i = 0; i < 10; ++i) {
        const int r = r0 - 1 + i;
        const bool ok = (i == 0) ? ((r0 % seqlen) != 0) : (i == 9) ? (((r0 + 8) % seqlen) != 0) : true;
        if (ok) { rg[i] = *(const v4u*)(hp + (size_t)r * NUP); rv[i] = *(const v4u*)(hp + (size_t)r * NUP + 128); }
        else { rg[i] = (v4u){0u, 0u, 0u, 0u}; rv[i] = (v4u){0u, 0u, 0u, 0u}; }
    }
#pragma unroll
    for (int i = 1; i <= 8; ++i) {
        float o[8];
#pragma unroll
        for (int e2 = 0; e2 < 4; ++e2) {
            const unsigned gm = rg[i - 1][e2], gc = rg[i][e2], gn = rg[i + 1][e2], vm = rv[i - 1][e2], vc = rv[i][e2], vn = rv[i + 1][e2];
            const float hg0 = wg[0][2 * e2] * bflo(gm) + wg[1][2 * e2] * bflo(gc) + wg[2][2 * e2] * bflo(gn);
            const float hg1 = wg[0][2 * e2 + 1] * bfhi(gm) + wg[1][2 * e2 + 1] * bfhi(gc) + wg[2][2 * e2 + 1] * bfhi(gn);
            const float hv0 = wv[0][2 * e2] * bflo(vm) + wv[1][2 * e2] * bflo(vc) + wv[2][2 * e2] * bflo(vn);
            const float hv1 = wv[0][2 * e2 + 1] * bfhi(vm) + wv[1][2 * e2 + 1] * bfhi(vc) + wv[2][2 * e2 + 1] * bfhi(vn);
            o[2 * e2] = gelu_tanh(hg0) * hv0; o[2 * e2 + 1] = gelu_tanh(hg1) * hv1;
        }
        v4u ov; ov.x = pk2(o[0], o[1]); ov.y = pk2(o[2], o[3]); ov.z = pk2(o[4], o[5]); ov.w = pk2(o[6], o[7]);
        *(v4u*)(act + (size_t)(r0 + i - 1) * DFF) = ov;
    }
}

__device__ __forceinline__ void ffn_fixup(const Args& a, int layer, int gtid, int nthreads) {
    const float* edge = (const float*)(a.ws + WS_EDGE);
    const float* cw = a.in[I_FCW] + (size_t)layer * 3 * NUP;
    bf16* act = (bf16*)(a.ws + WS_BIG);
    for (int it = gtid; it < NB_LAT * 15 * (DFF / 4) * 2; it += nthreads) {
        const int which = it & 1, cq = (it >> 1) % (DFF / 4), bi = (it >> 1) / (DFF / 4);
        const int pm = 16 + (bi / 15) * 16 + (bi % 15), chn = 4 * cq, ug = (chn >> 7) * 256 + (chn & 127);
        const float* e0 = edge + (size_t)pm * 4 * NUP, * e1 = edge + (size_t)(pm + 1) * 4 * NUP;
        const float* pp = which ? e0 + 3 * (size_t)NUP : e0 + 2 * (size_t)NUP;
        const float* pc = which ? e1 : e0 + 3 * (size_t)NUP;
        const float* pn = which ? e1 + NUP : e1;
        f32x4 hg = *(const f32x4*)(cw + chn) * *(const f32x4*)(pp + ug) + *(const f32x4*)(cw + NUP + chn) * *(const f32x4*)(pc + ug) + *(const f32x4*)(cw + 2 * (size_t)NUP + chn) * *(const f32x4*)(pn + ug);
        f32x4 hv = *(const f32x4*)(cw + DFF + chn) * *(const f32x4*)(pp + ug + 128) + *(const f32x4*)(cw + NUP + DFF + chn) * *(const f32x4*)(pc + ug + 128) + *(const f32x4*)(cw + 2 * (size_t)NUP + DFF + chn) * *(const f32x4*)(pn + ug + 128);
        const size_t R = (size_t)pm * 256 + 255 + which;
        v2u o; o.x = pk2(gelu_tanh(hg.x) * hv.x, gelu_tanh(hg.y) * hv.y); o.y = pk2(gelu_tanh(hg.z) * hv.z, gelu_tanh(hg.w) * hv.w);
        *(v2u*)(act + blk_off((int)R, chn, DFF)) = o;
    }
}

constexpr int PH_PRE = 0, PH_NORM0 = 1, PH_LAYER0 = 2, NPL = 10, N_PHASES = PH_LAYER0 + DEPTH * NPL;

typedef __attribute__((address_space(4))) const Args* KArgsPtr;
__device__ __forceinline__ KArgsPtr phase_args() { KArgsPtr p = (KArgsPtr)__builtin_amdgcn_kernarg_segment_ptr(); asm volatile("" : "+s"(p)); return p; }
__global__ void __launch_bounds__(NWAVES * 64, 2) fwd_kernel(Args args) {
    extern __shared__ __attribute__((aligned(16))) unsigned char lds_raw[];
    LAS unsigned char* lds = (LAS unsigned char*)lds_raw;
    volatile LAS unsigned* MISC = (volatile LAS unsigned*)(lds + MISC_OFF);
    const int G = gridDim.x, NGW = G * NWAVES;
    const int lo = args.ph_lo, hi = args.ph_hi;
#if PROBE_DUP
#define REPS(i) args.rep[i]
#else
#define REPS(i) 1
#endif
#define PHASE_ARGS const KArgsPtr kap_ = phase_args(); const Args& A_ = *(const Args*)kap_; unsigned char* const ws = kap_->ws; (void)ws;
    const int wave_s = __builtin_amdgcn_readfirstlane((int)threadIdx.x >> 6);
#define PHASE_IDS PHASE_ARGS int z_ = 0; asm volatile("" : "+s"(z_)); const int lane = (int)__builtin_amdgcn_mbcnt_hi(~0u, __builtin_amdgcn_mbcnt_lo(~0u, (unsigned)z_)); int wave = wave_s; asm volatile("" : "+s"(wave)); const int tid = wave * 64 + lane, gw = blockIdx.x * NWAVES + wave; (void)lane; (void)gw; (void)tid;
    if (threadIdx.x < 32) MISC[threadIdx.x] = 0u;
    __syncthreads();
    XcdBarrier bar; bar.bar = (unsigned*)(args.ws + WS_CTL) + CW_BAR; bar.x = 0; bar.st = nullptr; bar.wave = wave_s;
    if (MK_SINGLE || hi - lo > 1) bar = xcd_barrier_post((unsigned*)(args.ws + WS_CTL) + CW_BAR, MISC + 8, wave_s);
#if MK_SINGLE
#define IN(k) true
#else
#define IN(k) (lo <= (k) && (k) < hi)
#endif
#define SEAM(k) do { if (IN(k) && IN((k) + 1)) { for (int rb_ = 0; rb_ < REPS(7); ++rb_) xcd_barrier(bar); } } while (0)

    if (IN(PH_PRE)) { for (int rep = 0; rep < REPS(4); ++rep) { PHASE_IDS pre_transposes(A_, lds, gw, NGW, wave, lane); __syncthreads(); pre_mod(A_, lds, tid, wave, lane); __syncthreads(); } }
    SEAM(PH_PRE);
    if (IN(PH_NORM0)) { PHASE_IDS resnorm_rows<true, false, 0, true>(A_, lds, tid, wave, lane, 0, 0, 0, 0); }
    SEAM(PH_NORM0);

    for (int l = 0; l < DEPTH; ++l) {
        const int pb = PH_LAYER0 + l * NPL;
#define wl ((const bf16*)(ws + WS_W + (size_t)l * W_LAYER))
        if (IN(pb + 0)) for (int rep = 0; rep < REPS(0); ++rep) { PHASE_ARGS
            if (G == 256) {
                { int bid_ = (int)blockIdx.x; asm volatile("" : "+s"(bid_));
                  const int x = bid_ & 7, li = bid_ >> 3, ks = li & 3, j = x * 8 + (li >> 2);
                  pg8::Gemm g{(const bf16*)(ws + WS_A), (const bf16*)((const unsigned char*)wl + W_IN_OFF), M, DIN, D, D};
                  pg8::WithTail<pg8::TwoRectOrder> S; S.m.a.init(M_MAIN, DIN, G, bid_); S.m.b.init(M - M_MAIN, P2_NMAIN, G, bid_); S.m.r1 = (M_MAIN / 256) * (DIN / 256) / 256; S.m.pm2 = M_MAIN / 256;
                  S.r_main = S.m.r1 + 1; S.tail = pg8::Unit{M_MAIN / 256 + (j >> 2), P2_NMAIN / 256 + (j & 3), ks * (D / 4 / 64), D / 4 / 64, ks};
                  pg8::EpiBf16Store E{(bf16*)(ws + WS_BIG), DIN, (bf16*)(ws + WS_Y2) - (size_t)M_MAIN * (DIN - P2_NMAIN) - P2_NMAIN, DIN - P2_NMAIN, (size_t)(M - M_MAIN) * (DIN - P2_NMAIN)};
                  pg8::gemm_phase<pg8::EpiBf16Store, pg8::WithTail<pg8::TwoRectOrder>, false, true>(lds, lds + RING_BYTES, g, S, E, wave_s); }
            } else {
            pg8::Gemm g{(const bf16*)(ws + WS_A), (const bf16*)((const unsigned char*)wl + W_IN_OFF), M, DIN, D, D}; pg8::StaticOrder S; S.init(M, DIN, G, (int)blockIdx.x);
            pg8::EpiBf16Store E{(bf16*)(ws + WS_BIG), DIN};
            pg8::gemm_phase<pg8::EpiBf16Store, pg8::StaticOrder, true, true>(lds, lds + RING_BYTES, g, S, E, wave_s);
            }
        }
        SEAM(pb + 0);
        if (IN(pb + 1)) for (int rep = 0; rep < REPS(1); ++rep) { PHASE_IDS LAS unsigned char* xt = lds + wave * WAVE_LDS; if (G == 256) p2_reduce(ws, (int)blockIdx.x * (NWAVES * 64) + tid, G * NWAVES * 64); for (int it = gw; it < NCHUNK * NH * 2; it += NGW) scan_summary_item(A_, l, it, lane, xt); }
        SEAM(pb + 1);
        if (IN(pb + 2)) { PHASE_IDS carry_phase(A_, l, blockIdx.x * (NWAVES * 64) + tid, G * NWAVES * 64); }
        SEAM(pb + 2);
        if (IN(pb + 3)) for (int rep = 0; rep < REPS(2); ++rep) {
            PHASE_IDS
            LAS unsigned char* xt = lds + wave * WAVE_LDS;
            constexpr int NB = NCHUNK * NH, NA = NCHUNK * 4 * 4;
            for (int k = 0; ; ++k) {
                const int idx = (k >> 1) * NGW + gw;
                if (!(k & 1)) { if (idx < NB) mixb_item(A_, l, idx, lane, xt); }
                else { if (idx < NA) mixa_item(A_, l, idx, lane); }
                if ((k >> 1) * NGW >= NB && (k >> 1) * NGW >= NA) break;
            }
        }
        SEAM(pb + 3);
        if (IN(pb + 4)) for (int rep = 0; rep < REPS(3); ++rep) { PHASE_ARGS
            if (G == 256) {
                { int bid_ = (int)blockIdx.x; asm volatile("" : "+s"(bid_));
                  const int xi = bid_ >> 3, kh = xi & 1, j = ((2 * (bid_ & 7) + (xi >> 4)) << 3) | ((xi >> 1) & 7);
                  pg8::Gemm g{(const bf16*)(ws + WS_A), (const bf16*)((const unsigned char*)wl + W_OUT_OFF), M, D, D, D};
                  pg8::WithTail<pg8::StaticOrder> S; S.m.init(M_MAIN, D, G, bid_); S.r_main = (M_MAIN / 256) * (D / 256) / 256; S.tail = pg8::Unit{M_MAIN / 256 + (j >> 3), j & 7, kh * (D / 2 / 64), D / 2 / 64, kh};
                  pg8::EpiBf16Store E{(bf16*)(ws + WS_Y), D, (bf16*)(ws + WS_Y2) - (size_t)M_MAIN * D, D, 0};
                  pg8::gemm_phase<pg8::EpiBf16Store, pg8::WithTail<pg8::StaticOrder>, false, true>(lds, lds + RING_BYTES, g, S, E, wave_s); }
            } else {
            pg8::Gemm g{(const bf16*)(ws + WS_A), (const bf16*)((const unsigned char*)wl + W_OUT_OFF), M, D, D, D}; pg8::StaticOrder S; S.init(M, D, G, (int)blockIdx.x);
            pg8::EpiBf16Store E{(bf16*)(ws + WS_Y), D};
            pg8::gemm_phase<pg8::EpiBf16Store, pg8::StaticOrder, true, true>(lds, lds + RING_BYTES, g, S, E, wave_s);
            }
        }
        SEAM(pb + 4);
        if (IN(pb + 5)) { PHASE_IDS if (l == 0) resnorm_rows<true, true, 1, true>(A_, lds, tid, wave, lane, l, 2, l, 3); else resnorm_rows<false, true, 1, true>(A_, lds, tid, wave, lane, l, 2, l, 3); }
#if PROBE_NORM
        if (IN(pb + 5)) { __syncthreads(); asm volatile("s_waitcnt vmcnt(0)" ::: "memory"); PHASE_IDS resnorm_rows<false, false, 1, true>(A_, lds, tid, wave, lane, l, 2, l, 3); }
#endif
        SEAM(pb + 5);
        if (IN(pb + 6)) for (int rep = 0; rep < REPS(5); ++rep) { PHASE_ARGS
            pg8::Gemm g{(const bf16*)(ws + WS_A), (const bf16*)((const unsigned char*)wl + W_UP_OFF), M, NUP, D, D}; pg8::StaticOrder S; S.init(M, NUP, G, (int)blockIdx.x);
            pg8::EpiConvGate E{(bf16*)(ws + WS_BIG), DFF, A_.in[I_FCW] + (size_t)l * 3 * NUP, (float*)(ws + WS_EDGE), NUP, DFF};
            pg8::gemm_phase<pg8::EpiConvGate, pg8::StaticOrder, true, true>(lds, lds + RING_BYTES, g, S, E, wave_s);
        }
        SEAM(pb + 6);
        if (IN(pb + 7)) { PHASE_IDS ffn_fixup(A_, l, blockIdx.x * (NWAVES * 64) + tid, G * NWAVES * 64); }
        SEAM(pb + 7);
        if (IN(pb + 8)) for (int rep = 0; rep < REPS(6); ++rep) { PHASE_ARGS
            if (G == 256) {
                { int bid_ = (int)blockIdx.x; asm volatile("" : "+s"(bid_));
                  const int xi = bid_ >> 3, kh = xi & 1, j = ((2 * (bid_ & 7) + (xi >> 4)) << 3) | ((xi >> 1) & 7);
                  pg8::Gemm g{(const bf16*)(ws + WS_BIG), (const bf16*)((const unsigned char*)wl + W_DOWN_OFF), M, D, DFF, DFF};
                  pg8::WithTail<pg8::StaticOrder> S; S.m.init(M_MAIN, D, G, bid_); S.r_main = (M_MAIN / 256) * (D / 256) / 256; S.tail = pg8::Unit{M_MAIN / 256 + (j >> 3), j & 7, kh * (DFF / 2 / 64), DFF / 2 / 64, kh};
                  pg8::EpiBf16Store E{(bf16*)(ws + WS_Y), D, (bf16*)(ws + WS_Y2) - (size_t)M_MAIN * D, D, 0};
                  pg8::gemm_phase<pg8::EpiBf16Store, pg8::WithTail<pg8::StaticOrder>, false, true>(lds, lds + RING_BYTES, g, S, E, wave_s); }
            } else {
            pg8::Gemm g{(const bf16*)(ws + WS_BIG), (const bf16*)((const unsigned char*)wl + W_DOWN_OFF), M, D, DFF, DFF}; pg8::StaticOrder S; S.init(M, D, G, (int)blockIdx.x);
            pg8::EpiBf16Store E{(bf16*)(ws + WS_Y), D};
            pg8::gemm_phase<pg8::EpiBf16Store, pg8::StaticOrder, true, true>(lds, lds + RING_BYTES, g, S, E, wave_s);
            }
        }
        SEAM(pb + 8);
#if PROBE_GEMM
        if (IN(pb + 8)) { PHASE_ARGS
            pg8::Gemm g{(const bf16*)(ws + WS_BIG), (const bf16*)((const unsigned char*)wl + W_DOWN_OFF), M_MAIN, D, DFF, DFF}; pg8::StaticOrder S; S.init(M_MAIN, D, G, (int)blockIdx.x);
            pg8::EpiBf16Store E{(bf16*)(ws + 1328 * MiB), D};
#if PROBE_GEMM == 6
            pg8::Gemm g6{(const bf16*)(ws + WS_A), (const bf16*)((const unsigned char*)wl + W_UP_OFF), M, NUP, D, D}; pg8::StaticOrder S6; S6.init(M, NUP, G, (int)blockIdx.x);
            pg8::EpiBf16Scratch E6{{(bf16*)(ws + 1328 * MiB), 256}};
            pg8::gemm_phase<pg8::EpiBf16Scratch, pg8::StaticOrder, true, true, 0>(lds, lds + RING_BYTES, g6, S6, E6, wave_s);
#elif PROBE_GEMM == 5
            pg8::ConstOrder S5{4};
            pg8::gemm_phase<pg8::EpiBf16Store, pg8::ConstOrder, true, true, 0>(lds, lds + RING_BYTES, g, S5, E, wave_s);
#else
            pg8::gemm_phase<pg8::EpiBf16Store, pg8::StaticOrder, true, true, PROBE_GEMM - 1>(lds, lds + RING_BYTES, g, S, E, wave_s);
#endif
        }
#endif
        if (IN(pb + 9)) {
            PHASE_IDS
            if (l + 1 < DEPTH) resnorm_rows<false, true, 1, true>(A_, lds, tid, wave, lane, l, 5, l + 1, 0);
            else resnorm_rows<false, true, 2, false>(A_, lds, tid, wave, lane, l, 5, l, 0);
        }
        if (l + 1 < DEPTH) SEAM(pb + 9);
    }
#undef IN
#undef SEAM
}

extern "C" void kernel_launch(void* const* d_in, const int* in_sizes, int n_in, void* d_out, int out_size, void* d_ws, size_t ws_size, hipStream_t stream) {
    static int grid = 0;
    if (grid == 0) {
        if (n_in != 21 || ws_size < WS_END) { fprintf(stderr, "kernel_launch: expected 21 inputs and >= %zu bytes of workspace; got n_in %d, ws %zu\n", (size_t)WS_END, n_in, ws_size); grid = -1; return; }
        int dev = 0, cus = 0, per_cu = 0;
        if (hipGetDevice(&dev) != hipSuccess || hipDeviceGetAttribute(&cus, hipDeviceAttributeMultiprocessorCount, dev) != hipSuccess) { grid = -1; return; }
        if (hipFuncSetAttribute((const void*)fwd_kernel, hipFuncAttributeMaxDynamicSharedMemorySize, LDS_BYTES) != hipSuccess) { fprintf(stderr, "kernel_launch: hipFuncSetAttribute failed\n"); grid = -1; return; }
        if (hipOccupancyMaxActiveBlocksPerMultiprocessor(&per_cu, (const void*)fwd_kernel, NWAVES * 64, LDS_BYTES) != hipSuccess || per_cu < 1) { fprintf(stderr, "kernel_launch: occupancy query reports %d blocks per CU\n", per_cu); }
        (void)hipGetLastError();
        grid = cus;
    }
    if (grid < 0) return;
    (void)hipMemsetAsync((char*)d_ws + WS_CTL, 0, CTL_ZERO_BYTES, stream);
    Args a{};
    for (int i = 0; i < 21; ++i) a.in[i] = (const float*)d_in[i];
    a.out = (float*)d_out; a.ws = (unsigned char*)d_ws;
    for (int i = 0; i < 8; ++i) a.rep[i] = ((PROBE_DUP >> i) & 1) ? 2 : 1;
#if MK_SINGLE
    a.ph_lo = 0; a.ph_hi = N_PHASES;
    hipLaunchKernelGGL(fwd_kernel, dim3(grid), dim3(NWAVES * 64), LDS_BYTES, stream, a);
#else
    for (int p = 0; p < N_PHASES; ++p) { a.ph_lo = p; a.ph_hi = p + 1; hipLaunchKernelGGL(fwd_kernel, dim3(grid), dim3(NWAVES * 64), LDS_BYTES, stream, a); }
#endif
}
```
